# Optimizing an MI355X kernel written in HIP

```python
import math
import jax
import jax.numpy as jnp
from jax import lax
import numpy as np

D_MODEL = 1024
BATCH = 1
SEQ = 16384
DEPTH = 2

GRID_W = 64
CTX_LEN = 256
N_MOD = 9
D_FF = 2816
POOL_WINDOWS = (2, 4, 8, 16)
POOL_GROUP = D_MODEL // 16
POOL_W = POOL_GROUP * len(POOL_WINDOWS)
SSM_W = D_MODEL // 4
SSM_GROUP = 16
SSM_GROUPS = SSM_W // SSM_GROUP
SSM_STATE = 64
HEAD_DIM = 64
N_Q_HEADS = D_MODEL // 128
N_KV_HEADS = 2
KV_REP = N_Q_HEADS // N_KV_HEADS
Q_W = N_Q_HEADS * HEAD_DIM
KV_W = N_KV_HEADS * HEAD_DIM
QBLOCK = 128
ROPE_THETA = 10000.0
N_BRANCH = 3
IN_SPLITS = (POOL_W, POOL_W + SSM_W, POOL_W + SSM_W + Q_W,
             POOL_W + SSM_W + Q_W + KV_W, POOL_W + SSM_W + Q_W + 2 * KV_W)
IN_W = IN_SPLITS[-1] + N_BRANCH * D_MODEL
EPS = 1e-6

kernel_name = 'hybrid_pool_s5_gqa_prefix_block'


def rmsnorm(x, g):
    xf = x.astype(jnp.float32)
    xf = xf * lax.rsqrt(jnp.mean(xf * xf, axis=-1, keepdims=True) + EPS)
    return (xf * g.astype(jnp.float32)).astype(x.dtype)


def modulate(x, g, shift, scale):
    return rmsnorm(x, g) * (1 + scale) + shift


def adaln(cond_silu, w, b):
    return (cond_silu @ w + b).reshape(cond_silu.shape[0], 1, N_MOD, D_MODEL)


def swiglu(h, w13, w2):
    gt, up = jnp.split(h @ w13, 2, axis=-1)
    return (jax.nn.silu(gt) * up) @ w2


def multiscale_pool(a):
    n = a.shape[1]
    af = a.astype(jnp.float32)
    cs = jnp.concatenate([jnp.zeros_like(af[:, :1]), jnp.cumsum(af, axis=1)], axis=1)
    idx = jnp.arange(n)
    outs = []
    for gi, w in enumerate(POOL_WINDOWS):
        lo = jnp.clip(idx - w // 2, 0, n)
        hi = jnp.clip(idx + (w - 1 - w // 2) + 1, 0, n)
        csg = cs[..., gi * POOL_GROUP:(gi + 1) * POOL_GROUP]
        cnt = (hi - lo).astype(jnp.float32)[None, :, None]
        outs.append((csg[:, hi] - csg[:, lo]) / cnt)
    return (jnp.concatenate(outs, axis=-1) - af).astype(a.dtype)


def pool_branch(a, pool_w, pool_scale, pool_out):
    b, n, _ = a.shape
    y = multiscale_pool(a).reshape(b, n, len(POOL_WINDOWS), POOL_GROUP)
    y = jnp.einsum('bngc,gcd->bngd', y, pool_w).reshape(b, n, POOL_W)
    return (y * pool_scale) @ pool_out


def ssm_discretise(a_re, a_im, log_dt, b_re, b_im):
    lam = lax.complex(a_re.astype(jnp.float32), a_im.astype(jnp.float32))
    dt = jnp.exp(log_dt.astype(jnp.float32))[:, None]
    a_bar = jnp.exp(lam * dt)
    b_c = lax.complex(b_re.astype(jnp.float32), b_im.astype(jnp.float32))
    b_bar = ((a_bar - 1) / lam)[..., None] * b_c
    return a_bar, b_bar


def _lin_combine(left, right):
    a1, b1 = left
    a2, b2 = right
    return a1 * a2, a2 * b1 + b2


def ssm_states(u, a_bar, b_bar, s0):
    bu = lax.complex(jnp.einsum('bngh,gph->bngp', u, b_bar.real),
                     jnp.einsum('bngh,gph->bngp', u, b_bar.imag))
    a = jnp.broadcast_to(a_bar, bu.shape)
    a_cum, s = lax.associative_scan(_lin_combine, (a, bu), axis=1)
    if s0 is not None:
        s = s + a_cum * s0[:, None]
    return s


def ssm_readout(s, c_re, c_im):
    return jnp.einsum('bngp,ghp->bngh', s.real, c_re) - jnp.einsum('bngp,ghp->bngh', s.imag, c_im)


def _rev(t, flip):
    return jnp.flip(t, axis=1) if flip else t


def ssm_glu(y, w_glu):
    za, zb = jnp.split(jax.nn.gelu(y) @ w_glu, 2, axis=-1)
    return za * jax.nn.sigmoid(zb)


def ssm_branch(s_lat, s_ctx, a_re, a_im, log_dt, b_re, b_im, c_re, c_im, d_skip, w_glu, with_ctx_out):
    b, n, _ = s_lat.shape
    lc = s_ctx.shape[1]
    ul = s_lat.astype(jnp.float32).reshape(b, n, SSM_GROUPS, SSM_GROUP)
    uc = s_ctx.astype(jnp.float32).reshape(b, lc, SSM_GROUPS, SSM_GROUP)
    d = d_skip.astype(jnp.float32).reshape(SSM_GROUPS, SSM_GROUP)
    y_lat = ul * d
    y_ctx = uc * d
    for direction in range(2):
        flip = direction == 1
        a_bar, b_bar = ssm_discretise(a_re[direction], a_im[direction], log_dt[direction],
                                      b_re[direction], b_im[direction])
        cr = c_re[direction].astype(jnp.float32)
        ci = c_im[direction].astype(jnp.float32)
        sc = ssm_states(_rev(uc, flip), a_bar, b_bar, None)
        sl = ssm_states(_rev(ul, flip), a_bar, b_bar, sc[:, -1])
        y_lat = y_lat + _rev(ssm_readout(sl, cr, ci), flip)
        if with_ctx_out:
            y_ctx = y_ctx + _rev(ssm_readout(sc, cr, ci), flip)
    out_lat = ssm_glu(y_lat.reshape(b, n, SSM_W).astype(s_lat.dtype), w_glu)
    out_ctx = ssm_glu(y_ctx.reshape(b, lc, SSM_W).astype(s_ctx.dtype), w_glu) if with_ctx_out else None
    return out_lat, out_ctx


def _rope_axis(x, pos):
    r = x.shape[-1]
    inv = ROPE_THETA ** (-jnp.arange(0, r, 2, dtype=jnp.float32) / r)
    ang = pos.astype(jnp.float32)[:, None] * inv[None]
    cos = jnp.cos(ang)[None, :, None]
    sin = jnp.sin(ang)[None, :, None]
    x1, x2 = jnp.split(x, 2, axis=-1)
    return jnp.concatenate([x1 * cos - x2 * sin, x2 * cos + x1 * sin], axis=-1)


def rope_2d(t, rows, cols):
    half = HEAD_DIM // 2
    tf = t.astype(jnp.float32)
    out = jnp.concatenate([_rope_axis(tf[..., :half], rows), _rope_axis(tf[..., half:], cols)], axis=-1)
    return out.astype(t.dtype)


def attend_blocks(q, k, v):
    b, n = q.shape[:2]
    nb = n // QBLOCK
    qb = q.reshape(b, nb, QBLOCK, N_KV_HEADS, KV_REP, HEAD_DIM).transpose(1, 0, 2, 3, 4, 5)
    scale = HEAD_DIM ** -0.5

    def one_block(qblk):
        s = jnp.einsum('bqkrd,bmkd->bkrqm', qblk, k, preferred_element_type=jnp.float32) * scale
        p = jax.nn.softmax(s, axis=-1).astype(v.dtype)
        return jnp.einsum('bkrqm,bmkd->bqkrd', p, v)

    o = lax.map(one_block, qb)
    return o.transpose(1, 0, 2, 3, 4, 5).reshape(b, n, Q_W)


def gated_merge(gates, br_a, br_b, br_c, w_out):
    g = jax.nn.sigmoid(gates.astype(jnp.float32)).astype(br_a.dtype)
    g = g.reshape(*gates.shape[:-1], N_BRANCH, D_MODEL)
    mixed = g[..., 0, :] * br_a + g[..., 1, :] * br_b + g[..., 2, :] * br_c
    return mixed @ w_out


def token_mixer(h, hc, rows, cols, w_in, pool_w, pool_scale, pool_out,
                a_re, a_im, log_dt, b_re, b_im, c_re, c_im, d_skip, w_glu,
                q_g, k_g, attn_out, w_out, with_ctx_out):
    b, n, _ = h.shape
    lc = hc.shape[1]
    a, s, q, k, v, gates = jnp.split(h @ w_in, list(IN_SPLITS), axis=-1)
    ac, sc, qc, kc, vc, gates_c = jnp.split(hc @ w_in, list(IN_SPLITS), axis=-1)
    br_a = pool_branch(a, pool_w, pool_scale, pool_out)
    br_b, br_b_c = ssm_branch(s, sc, a_re, a_im, log_dt, b_re, b_im, c_re, c_im, d_skip, w_glu, with_ctx_out)
    ql = rope_2d(rmsnorm(q.reshape(b, n, N_Q_HEADS, HEAD_DIM), q_g), rows, cols)
    kl = rope_2d(rmsnorm(k.reshape(b, n, N_KV_HEADS, HEAD_DIM), k_g), rows, cols)
    vl = v.reshape(b, n, N_KV_HEADS, HEAD_DIM)
    kcc = rmsnorm(kc.reshape(b, lc, N_KV_HEADS, HEAD_DIM), k_g)
    vcc = vc.reshape(b, lc, N_KV_HEADS, HEAD_DIM)
    k_all = jnp.concatenate([kl, kcc], axis=1)
    v_all = jnp.concatenate([vl, vcc], axis=1)
    br_c = attend_blocks(ql, k_all, v_all) @ attn_out
    out = gated_merge(gates, br_a, br_b, br_c, w_out)
    if not with_ctx_out:
        return out, None
    br_a_c = pool_branch(ac, pool_w, pool_scale, pool_out)
    qcc = rmsnorm(qc.reshape(b, lc, N_Q_HEADS, HEAD_DIM), q_g)
    br_c_c = attend_blocks(qcc, kcc, vcc) @ attn_out
    out_c = gated_merge(gates_c, br_a_c, br_b_c, br_c_c, w_out)
    return out, out_c


def setup_inputs(seed: int = 0) -> dict:
    key = jax.random.key(seed)
    ks = jax.random.split(key, 27)

    def nrm(k, shape, scale):
        return jax.random.normal(k, shape, jnp.float32) * scale

    G, P, H = SSM_GROUPS, SSM_STATE, SSM_GROUP
    n_idx = jnp.arange(P, dtype=jnp.float32)
    return {
        'x': nrm(ks[0], (BATCH, SEQ, D_MODEL), 1.0),
        'c': nrm(ks[1], (BATCH, D_MODEL), 1.0),
        'ctx': nrm(ks[2], (BATCH, CTX_LEN, D_MODEL), 1.0),
        'c_ctx': nrm(ks[3], (D_MODEL,), 1.0),
        'mod_w': nrm(ks[4], (DEPTH, D_MODEL, N_MOD * D_MODEL), 0.5 * D_MODEL ** -0.5),
        'mod_b': nrm(ks[5], (DEPTH, N_MOD * D_MODEL), 0.01),
        'norm_g': 1.0 + nrm(ks[6], (DEPTH, 3, D_MODEL), 0.02),
        'ffn_w13': nrm(ks[7], (DEPTH, 2, D_MODEL, 2 * D_FF), D_MODEL ** -0.5),
        'ffn_w2': nrm(ks[8], (DEPTH, 2, D_FF, D_MODEL), D_FF ** -0.5),
        'w_in': nrm(ks[9], (DEPTH, D_MODEL, IN_W), D_MODEL ** -0.5),
        'pool_w': nrm(ks[10], (DEPTH, len(POOL_WINDOWS), POOL_GROUP, POOL_GROUP), POOL_GROUP ** -0.5),
        'pool_scale': 1.0 + nrm(ks[11], (DEPTH, POOL_W), 0.02),
        'pool_out': nrm(ks[12], (DEPTH, POOL_W, D_MODEL), POOL_W ** -0.5),
        'ssm_a_re': -0.5 + nrm(ks[13], (DEPTH, 2, G, P), 0.01),
        'ssm_a_im': math.pi * n_idx + nrm(ks[14], (DEPTH, 2, G, P), 0.01),
        'ssm_log_dt': jax.random.uniform(ks[15], (DEPTH, 2, G), jnp.float32, math.log(1e-3), math.log(1e-1)),
        'ssm_b_re': nrm(ks[16], (DEPTH, 2, G, P, H), (2 * H) ** -0.5),
        'ssm_b_im': nrm(ks[17], (DEPTH, 2, G, P, H), (2 * H) ** -0.5),
        'ssm_c_re': nrm(ks[18], (DEPTH, 2, G, H, P), P ** -0.5),
        'ssm_c_im': nrm(ks[19], (DEPTH, 2, G, H, P), P ** -0.5),
        'ssm_d': nrm(ks[20], (DEPTH, SSM_W), 1.0),
        'ssm_glu_w': nrm(ks[21], (DEPTH, SSM_W, 2 * D_MODEL), SSM_W ** -0.5),
        'q_norm_g': 1.0 + nrm(ks[22], (DEPTH, HEAD_DIM), 0.02),
        'k_norm_g': 1.0 + nrm(ks[23], (DEPTH, HEAD_DIM), 0.02),
        'attn_out': nrm(ks[24], (DEPTH, Q_W, D_MODEL), Q_W ** -0.5),
        'w_out': nrm(ks[25], (DEPTH, D_MODEL, D_MODEL), D_MODEL ** -0.5),
        'final_norm_g': 1.0 + nrm(ks[26], (D_MODEL,), 0.02),
    }


def reference(x, c, ctx, c_ctx, mod_w, mod_b, norm_g, ffn_w13, ffn_w2, w_in,
              pool_w, pool_scale, pool_out, ssm_a_re, ssm_a_im, ssm_log_dt,
              ssm_b_re, ssm_b_im, ssm_c_re, ssm_c_im, ssm_d, ssm_glu_w,
              q_norm_g, k_norm_g, attn_out, w_out, final_norm_g):
    n = x.shape[1]
    n_rows = n // GRID_W
    rows = jnp.repeat(jnp.arange(n_rows), GRID_W)
    cols = jnp.broadcast_to(jnp.arange(GRID_W), (n_rows, GRID_W)).reshape(-1)
    cs_lat = jax.nn.silu(c)
    cs_ctx = jax.nn.silu(c_ctx)[None]
    for l in range(DEPTH):
        with_ctx_out = l < DEPTH - 1
        m = adaln(cs_lat, mod_w[l], mod_b[l])
        mc = adaln(cs_ctx, mod_w[l], mod_b[l])
        x = x + 0.5 * m[:, :, 2] * swiglu(modulate(x, norm_g[l, 0], m[:, :, 0], m[:, :, 1]),
                                          ffn_w13[l, 0], ffn_w2[l, 0])
        ctx = ctx + 0.5 * mc[:, :, 2] * swiglu(modulate(ctx, norm_g[l, 0], mc[:, :, 0], mc[:, :, 1]),
                                               ffn_w13[l, 0], ffn_w2[l, 0])
        h = modulate(x, norm_g[l, 1], m[:, :, 3], m[:, :, 4])
        hc = modulate(ctx, norm_g[l, 1], mc[:, :, 3], mc[:, :, 4])
        mix, mix_c = token_mixer(h, hc, rows, cols, w_in[l], pool_w[l], pool_scale[l], pool_out[l],
                                 ssm_a_re[l], ssm_a_im[l], ssm_log_dt[l], ssm_b_re[l], ssm_b_im[l],
                                 ssm_c_re[l], ssm_c_im[l], ssm_d[l], ssm_glu_w[l],
                                 q_norm_g[l], k_norm_g[l], attn_out[l], w_out[l], with_ctx_out)
        x = x + m[:, :, 5] * mix
        x = x + 0.5 * m[:, :, 8] * swiglu(modulate(x, norm_g[l, 2], m[:, :, 6], m[:, :, 7]),
                                          ffn_w13[l, 1], ffn_w2[l, 1])
        if with_ctx_out:
            ctx = ctx + mc[:, :, 5] * mix_c
            ctx = ctx + 0.5 * mc[:, :, 8] * swiglu(modulate(ctx, norm_g[l, 2], mc[:, :, 6], mc[:, :, 7]),
                                                   ffn_w13[l, 1], ffn_w2[l, 1])
    return rmsnorm(x, final_norm_g)
```

```cpp
#include <hip/hip_runtime.h>
#include <hip/hip_cooperative_groups.h>
#include <cstdio>
#include <cstdint>
namespace cg = cooperative_groups;

#define DI __device__ __forceinline__
#define LAS __attribute__((address_space(3)))
typedef __attribute__((address_space(3))) char* ldsp;
typedef const __attribute__((address_space(3))) char* cldsp;
typedef unsigned short bf16;
typedef short bf16x8 __attribute__((ext_vector_type(8)));
typedef float f32x16 __attribute__((ext_vector_type(16)));
typedef float f32x4 __attribute__((ext_vector_type(4)));
typedef float f32x2 __attribute__((ext_vector_type(2)));
typedef unsigned u32x4 __attribute__((ext_vector_type(4)));
typedef unsigned u32x2 __attribute__((ext_vector_type(2)));
typedef __bf16 hbf2 __attribute__((ext_vector_type(2)));

#ifndef MK_ONE_LAUNCH
#define MK_ONE_LAUNCH 0
#endif

constexpr int D = 1024, NL = 16384, NC = 256, NT = NL + NC, DFF = 2816, INW = 4352;
constexpr int NCH = NT / 32;

enum { I_X = 0, I_C, I_CTX, I_CCTX, I_MODW, I_MODB, I_NORMG, I_W13, I_W2, I_WIN, I_POOLW, I_POOLS, I_POOLO, I_ARE, I_AIM, I_LOGDT,
       I_BRE, I_BIM, I_CRE, I_CIM, I_SD, I_GLU, I_QG, I_KG, I_AO, I_WO, I_FG };

constexpr size_t al(size_t x) { return (x + 255) & ~(size_t)255; }
constexpr size_t O_BAR = 0;
constexpr size_t O_X = 16384;
constexpr size_t O_H = O_X + al((size_t)NT * D * 4);
constexpr size_t O_BIG = O_H + al((size_t)NT * D * 2);
constexpr size_t O_Q = O_BIG + al((size_t)NT * 3072 * 2);
constexpr size_t O_K = O_Q + al((size_t)NT * 512 * 2);
constexpr size_t O_VT = O_K + al((size_t)NT * 128 * 2);
constexpr size_t O_A = O_VT + al((size_t)NT * 128 * 2);
constexpr size_t O_S = O_A + al((size_t)NT * 256 * 2);
constexpr size_t O_YP = O_S + al((size_t)NT * 256 * 2);
constexpr size_t O_YS = O_YP + al((size_t)NT * 256 * 2);
constexpr size_t O_CARRY = O_YS + al((size_t)NT * 256 * 2);
constexpr size_t O_E = O_CARRY + al((size_t)NCH * 16 * 256 * 2);
constexpr size_t O_W13 = O_E + al((size_t)NCH * 16 * 256 * 4);
constexpr size_t O_W2 = O_W13 + al((size_t)2 * 5632 * 1024 * 2);
constexpr size_t O_WIN = O_W2 + al((size_t)2 * 1024 * 2816 * 2);
constexpr size_t O_WGLU = O_WIN + al((size_t)INW * 1024 * 2);
constexpr size_t O_WAO = O_WGLU + al((size_t)2048 * 256 * 2);
constexpr size_t O_WOUT = O_WAO + al((size_t)1024 * 512 * 2);
constexpr size_t O_WP = O_WOUT + al((size_t)1024 * 1024 * 2);
constexpr size_t O_TOEP = O_WP + al((size_t)1024 * 256 * 2);
constexpr size_t O_W1S = O_TOEP + al((size_t)16 * 512 * 512 * 2);
constexpr size_t O_W3S = O_W1S + al((size_t)16 * 256 * 512 * 2);
constexpr size_t O_KTAB = O_W3S + al((size_t)16 * 512 * 256 * 2);
constexpr size_t O_PW = O_KTAB + al((size_t)2 * 16 * 32 * 256 * 4);
constexpr size_t O_CF = O_PW + al((size_t)2048 * 33 * 8);
constexpr size_t O_MODS = O_CF + al((size_t)2048 * 8);
constexpr size_t O_ROPE = O_MODS + al((size_t)2 * 2 * 9216 * 4);
constexpr size_t O_END = O_ROPE + al((size_t)256 * 16 * 8);

struct Params { const float* in[27]; float* out; char* ws; };

DI unsigned pk2(float a, float b) { f32x2 v = {a, b}; return __builtin_bit_cast(unsigned, __builtin_convertvector(v, hbf2)); }
DI bf16 f2bf(float a) { return (bf16)(pk2(a, 0.f) & 0xffffu); }
DI float bf2f(bf16 b) { return __uint_as_float(((unsigned)b) << 16); }
DI float bflo(unsigned u) { return __uint_as_float(u << 16); }
DI float bfhi(unsigned u) { return __uint_as_float(u & 0xffff0000u); }
DI float sigmoidf_(float x) { return 1.f / (1.f + __expf(-x)); }
DI float wave_sum(float v) {
#pragma unroll
    for (int o = 32; o >= 1; o >>= 1) v += __shfl_xor(v, o);
    return v;
}
#define AT(T, base, idx) (*(T*)((char*)(base) + (unsigned)((unsigned)(idx) * (unsigned)sizeof(T))))
#define MFMA(a, b, c) __builtin_amdgcn_mfma_f32_32x32x16_bf16((a), (b), (c), 0, 0, 0)

DI double dexp(double x) {
    const double n = __builtin_rint(x * 1.4426950408889634);
    const double r = x - n * 0.6931471805599453;
    double t = 1.0;
#pragma unroll
    for (int k = 16; k >= 1; --k) t = 1.0 + t * r * (1.0 / (double)k);
    const long long e = (long long)n + 1023;
    return t * __longlong_as_double(e << 52);
}
DI void dsincos(double th, double& s, double& c) {
    const double k = __builtin_rint(th * 0.15915494309189535);
    const double x = th - k * 6.283185307179586 - k * 2.4492935982947064e-16;
    const double x2 = x * x;
    double cs = 1.0, sn = 1.0;
#pragma unroll
    for (int j = 17; j >= 1; --j) {
        cs = 1.0 - cs * x2 * (1.0 / (double)((2 * j - 1) * (2 * j)));
        sn = 1.0 - sn * x2 * (1.0 / (double)((2 * j) * (2 * j + 1)));
    }
    c = cs; s = sn * x;
}

#define XB_TMO      128
#define XB_XCNT(j)  (256  + 64 * (j))
#define XB_XSUB(j)  (1280 + 64 * (j))
#define XB_XGEN(j)  (2304 + 64 * (j))
#define XB_TOP      3328
#define XB_TOPGEN   3392
#define XCD_BAR_WORDS 3456
#define XB_SPIN_CAP (1u << 22)
DI unsigned xb_ld(unsigned* p)              { return __hip_atomic_load(p, __ATOMIC_RELAXED, __HIP_MEMORY_SCOPE_AGENT); }
DI unsigned xb_add(unsigned* p, unsigned v) { return __hip_atomic_fetch_add(p, v, __ATOMIC_RELAXED, __HIP_MEMORY_SCOPE_AGENT); }
DI unsigned xb_xcc_id() { return (unsigned)__builtin_amdgcn_s_getreg((3 << 11) | 20) & 0xFu; }
#define XB_SPIN(cond, bar) do { unsigned _sp = 0; while (cond) { __builtin_amdgcn_s_sleep(1); \
    if ((++_sp & 255u) == 0u) { if (xb_ld(&(bar)[XB_TMO])) break; if (_sp > XB_SPIN_CAP) { atomicAdd(&(bar)[XB_TMO], 1u); break; } } } } while (0)
struct XcdBarrier { unsigned* bar; unsigned x; volatile LAS unsigned* st; };
DI XcdBarrier xcd_barrier_post(unsigned* bar, volatile LAS unsigned* st) {
    XcdBarrier b; b.bar = bar; b.x = xb_xcc_id(); b.st = st;
    if (threadIdx.x == 0) (void)xb_add(&bar[XB_XCNT(b.x)], 1u);
    return b;
}
DI void xcd_barrier_complete(unsigned* bar, unsigned x, unsigned& nloc, unsigned& nx) {
    const unsigned G = gridDim.x * gridDim.y * gridDim.z;
    unsigned sum, cnt, mine, sp = 0u;
    for (;;) {
        sum = 0u; cnt = 0u; mine = 0u;
#pragma unroll
        for (unsigned j = 0; j < 16; ++j) { const unsigned c = xb_ld(&bar[XB_XCNT(j)]); sum += c; cnt += (c > 0u) ? 1u : 0u; mine = (j == x) ? c : mine; }
        if (sum == G) break;
        __builtin_amdgcn_s_sleep(1);
        if ((++sp & 255u) == 0u) { if (xb_ld(&bar[XB_TMO])) break; if (sp > XB_SPIN_CAP) { atomicAdd(&bar[XB_TMO], 1u); break; } }
    }
    nloc = mine > 0u ? mine : 1u; nx = cnt > 0u ? cnt : 1u;
}
DI void xcd_barrier(const XcdBarrier& b) {
    asm volatile("s_waitcnt vmcnt(0)" ::: "memory");
    __syncthreads();
    if (threadIdx.x == 0) {
        unsigned* bar = b.bar;
        __builtin_amdgcn_s_waitcnt(0);
        unsigned nloc = b.st[0], nx = b.st[1];
        if (nloc == 0u) { xcd_barrier_complete(bar, b.x, nloc, nx); b.st[0] = nloc; b.st[1] = nx; }
        const unsigned old = xb_add(&bar[XB_XSUB(b.x)], 1u);
        const unsigned gen = old / nloc;
        if (old + 1u == (gen + 1u) * nloc) {
            __builtin_amdgcn_fence(__ATOMIC_RELEASE, "agent");
            asm volatile("s_waitcnt vmcnt(0)" ::: "memory");
            const unsigned og = xb_add(&bar[XB_TOP], 1u);
            const unsigned tg = og / nx;
            if (og + 1u == (tg + 1u) * nx) xb_add(&bar[XB_TOPGEN], 1u);
            else XB_SPIN(xb_ld(&bar[XB_TOPGEN]) == tg, bar);
            __builtin_amdgcn_fence(__ATOMIC_ACQUIRE, "agent");
            xb_add(&bar[XB_XGEN(b.x)], 1u);
            asm volatile("s_waitcnt vmcnt(0)" ::: "memory");
        } else {
            XB_SPIN(xb_ld(&bar[XB_XGEN(b.x)]) == gen, bar);
            __builtin_amdgcn_fence(__ATOMIC_ACQUIRE, "agent");
            asm volatile("s_waitcnt vmcnt(0)" ::: "memory");
        }
    }
    __syncthreads();
}

constexpr int LROW = 144;
constexpr int LTILE = 128 * LROW;
constexpr int LSTAGE = 2 * LTILE;
constexpr int LDS_BYTES = 2 * LSTAGE;

template <int AMODE, int NCB>
DI void gemm_acc(f32x16 (&acc)[2][NCB], const bf16* __restrict__ A, const long lda, const int arow0,
                 const bf16* __restrict__ Bt, const long ldb, const int brow0, const int K, ldsp lds) {
    int tid_ = threadIdx.x; asm volatile("" : "+v"(tid_));
    const int tid = tid_, lane = tid & 63, w = tid >> 6, wm = w >> 1, wn = w & 1, r = lane & 31, h = lane >> 5;
    const int v = tid & 7, lr = tid >> 3;
    const int avoff = AMODE ? ((v >> 1) * 256 + (v & 1) * 8) : v * 8;
    const int akstep = AMODE ? 1024 : 64;
    const bf16* ag = A + (long)(arow0 + lr) * lda + avoff;
    const bf16* bg = Bt + (long)(brow0 + lr) * ldb + v * 8;
    const int nk = K >> 6;
    u32x4 ra[4], rb[2 * NCB];
#pragma unroll
    for (int i = 0; i < 4; ++i) ra[i] = *(const u32x4*)(ag + (long)i * 32 * lda);
#pragma unroll
    for (int i = 0; i < 2 * NCB; ++i) rb[i] = *(const u32x4*)(bg + (long)i * 32 * ldb);
    ldsp wr = lds + lr * LROW + v * 16;
#pragma unroll
    for (int i = 0; i < 4; ++i) *(LAS u32x4*)(wr + i * 32 * LROW) = ra[i];
#pragma unroll
    for (int i = 0; i < 2 * NCB; ++i) *(LAS u32x4*)(wr + LTILE + i * 32 * LROW) = rb[i];
    __syncthreads();
    cldsp la = lds + (wm * 64 + r) * LROW + h * 16;
    cldsp lb = lds + LTILE + (wn * 32 * NCB + r) * LROW + h * 16;
    for (int kt = 0; kt < nk; ++kt) {
        const int buf = kt & 1;
        const bool more = (kt + 1 < nk);
        if (more) {
            ag += akstep; bg += 64;
#pragma unroll
            for (int i = 0; i < 4; ++i) ra[i] = *(const u32x4*)(ag + (long)i * 32 * lda);
#pragma unroll
            for (int i = 0; i < 2 * NCB; ++i) rb[i] = *(const u32x4*)(bg + (long)i * 32 * ldb);
        }
        cldsp pa = la + buf * LSTAGE; cldsp pb = lb + buf * LSTAGE;
#pragma unroll
        for (int s = 0; s < 4; ++s) {
            const bf16x8 a0 = *(const LAS bf16x8*)(pa + s * 32), a1 = *(const LAS bf16x8*)(pa + 32 * LROW + s * 32);
#pragma unroll
            for (int cb = 0; cb < NCB; ++cb) {
                const bf16x8 b0 = *(const LAS bf16x8*)(pb + cb * 32 * LROW + s * 32);
                acc[0][cb] = MFMA(a0, b0, acc[0][cb]); acc[1][cb] = MFMA(a1, b0, acc[1][cb]);
            }
        }
        if (more) {
            ldsp w2 = wr + (buf ^ 1) * LSTAGE;
#pragma unroll
            for (int i = 0; i < 4; ++i) *(LAS u32x4*)(w2 + i * 32 * LROW) = ra[i];
#pragma unroll
            for (int i = 0; i < 2 * NCB; ++i) *(LAS u32x4*)(w2 + LTILE + i * 32 * LROW) = rb[i];
        }
        __syncthreads();
    }
}
template <int NCB>
DI void zero_acc(f32x16 (&acc)[2][NCB]) {
#pragma unroll
    for (int a = 0; a < 2; ++a)
#pragma unroll
        for (int b = 0; b < NCB; ++b)
#pragma unroll
            for (int i = 0; i < 16; ++i) acc[a][b][i] = 0.f;
}
#define ACC_ROW(rb, i) (wm * 64 + (rb) * 32 + ((i) & 3) + 8 * ((i) >> 2) + 4 * h)
#define ACC_COL(cb) (wn * 64 + (cb) * 32 + r)
#define TID_VARS int tid_ = threadIdx.x; asm volatile("" : "+v"(tid_)); const int tid = tid_, lane = tid & 63, w = tid >> 6, wm = w >> 1, wn = w & 1, r = lane & 31, h = lane >> 5; (void)wm; (void)wn; (void)r; (void)h; (void)lane; (void)w;

DI const float* mods_ptr(const Params& p, int cond, int l, int j) { return (const float*)(p.ws + O_MODS) + ((size_t)(cond * 2 + l) * 9 + j) * 1024; }

DI void ffn_a_item(const Params& p, int f, int it, ldsp lds) {
    TID_VARS
    const int nt = it % 44, mt = it / 44;
    f32x16 acc[2][2]; zero_acc<2>(acc);
    gemm_acc<0, 2>(acc, (const bf16*)(p.ws + O_H), 1024, mt * 128, (const bf16*)(p.ws + O_W13) + (unsigned)f * 5632 * 1024, 1024, nt * 128, 1024, lds);
    bf16* hid = (bf16*)(p.ws + O_BIG);
    const int col = nt * 64 + wn * 32 + r;
#pragma unroll
    for (int rb = 0; rb < 2; ++rb)
#pragma unroll
        for (int i = 0; i < 16; ++i) {
            const float g = acc[rb][0][i], u = acc[rb][1][i];
            const int row = mt * 128 + ACC_ROW(rb, i);
            AT(bf16, hid, row * DFF + col) = f2bf(g * sigmoidf_(g) * u);
        }
}
DI void gemm_resid_item(const Params& p, const bf16* A, int lda, int K, const bf16* Bt, int l, int gate_j, float scale, bool resid_in, int it, ldsp lds) {
    TID_VARS
    const int nt = it % 8, mt = it / 8;
    f32x16 acc[2][2]; zero_acc<2>(acc);
    gemm_acc<0, 2>(acc, A, lda, mt * 128, Bt, K, nt * 128, K, lds);
    const int cond = (mt >= 128) ? 1 : 0;
    const float* gate = mods_ptr(p, cond, l, gate_j);
    float* X = (float*)(p.ws + O_X);
#pragma unroll
    for (int cb = 0; cb < 2; ++cb) {
        const int col = nt * 128 + ACC_COL(cb);
        const float gs = gate[col] * scale;
#pragma unroll
        for (int rb = 0; rb < 2; ++rb)
#pragma unroll
            for (int i = 0; i < 16; ++i) {
                const int row = mt * 128 + ACC_ROW(rb, i);
                float rs;
                if (resid_in) rs = cond ? AT(const float, p.in[I_CTX], (row - NL) * D + col) : AT(const float, p.in[I_X], row * D + col);
                else rs = AT(float, X, row * D + col);
                AT(float, X, row * D + col) = rs + gs * acc[rb][cb][i];
            }
    }
}
DI void norm_item(const Params& p, int l, int which, int it) {
    const int tid = threadIdx.x, lane = tid & 63, w = tid >> 6;
    const int row = it * 4 + w;
    const int cond = row >= NL;
    const float* src = (l == 0 && which == 0) ? (cond ? p.in[I_CTX] + (unsigned)(row - NL) * D : p.in[I_X] + (unsigned)row * D) : (const float*)(p.ws + O_X) + (unsigned)row * D;
    f32x4 x[4]; float ss = 0.f;
#pragma unroll
    for (int j = 0; j < 4; ++j) { x[j] = *(const f32x4*)(src + lane * 4 + 256 * j); ss += x[j][0] * x[j][0] + x[j][1] * x[j][1] + x[j][2] * x[j][2] + x[j][3] * x[j][3]; }
    ss = wave_sum(ss);
    const float rstd = rsqrtf(ss * (1.f / 1024.f) + 1e-6f);
    const float* g = p.in[I_NORMG] + (unsigned)(l * 3 + which) * D;
    const float* sh = mods_ptr(p, cond, l, 3 * which), *sc = mods_ptr(p, cond, l, 3 * which + 1);
    bf16* H = (bf16*)(p.ws + O_H) + (unsigned)row * D;
#pragma unroll
    for (int j = 0; j < 4; ++j) {
        const int c = lane * 4 + 256 * j;
        const f32x4 gv = *(const f32x4*)(g + c), sv = *(const f32x4*)(sh + c), cv = *(const f32x4*)(sc + c);
        float o[4];
#pragma unroll
        for (int e = 0; e < 4; ++e) o[e] = x[j][e] * rstd * gv[e] * (1.f + cv[e]) + sv[e];
        u32x2 pk; pk.x = pk2(o[0], o[1]); pk.y = pk2(o[2], o[3]);
        *(u32x2*)(H + c) = pk;
    }
}
DI void final_norm_item(const Params& p, int it) {
    const int tid = threadIdx.x, lane = tid & 63, w = tid >> 6;
    const int row = it * 4 + w;
    const float* src = (const float*)(p.ws + O_X) + (unsigned)row * D;
    f32x4 x[4]; float ss = 0.f;
#pragma unroll
    for (int j = 0; j < 4; ++j) { x[j] = *(const f32x4*)(src + lane * 4 + 256 * j); ss += x[j][0] * x[j][0] + x[j][1] * x[j][1] + x[j][2] * x[j][2] + x[j][3] * x[j][3]; }
    ss = wave_sum(ss);
    const float rstd = rsqrtf(ss * (1.f / 1024.f) + 1e-6f);
    const float* g = p.in[I_FG];
#pragma unroll
    for (int j = 0; j < 4; ++j) {
        const int c = lane * 4 + 256 * j;
        const f32x4 gv = *(const f32x4*)(g + c);
        f32x4 o;
#pragma unroll
        for (int e = 0; e < 4; ++e) o[e] = x[j][e] * rstd * gv[e];
        *(f32x4*)(p.out + (unsigned)row * D + c) = o;
    }
}
DI void inproj_item(const Params& p, int l, int it, ldsp lds) {
    TID_VARS
    const int nt = it % 34, mt = it / 34;
    f32x16 acc[2][2]; zero_acc<2>(acc);
    gemm_acc<0, 2>(acc, (const bf16*)(p.ws + O_H), 1024, mt * 128, (const bf16*)(p.ws + O_WIN), 1024, nt * 128, 1024, lds);
    const int row0 = mt * 128;
    if (nt < 4) {
        bf16* dst = (bf16*)(p.ws + (nt < 2 ? O_A : O_S));
        const int cbase = (nt & 1) * 128;
#pragma unroll
        for (int rb = 0; rb < 2; ++rb)
#pragma unroll
            for (int cb = 0; cb < 2; ++cb)
#pragma unroll
                for (int i = 0; i < 16; ++i) AT(bf16, dst, (row0 + ACC_ROW(rb, i)) * 256 + cbase + ACC_COL(cb)) = f2bf(acc[rb][cb][i]);
    } else if (nt < 9) {
        const bool isq = nt < 8;
        const float* gv = p.in[isq ? I_QG : I_KG] + l * 64;
        const float g0 = gv[r], g1 = gv[32 + r];
        const float2* rope = (const float2*)(p.ws + O_ROPE);
        const bool latent = mt < 128;
        const float osc = isq ? 0.125f : 1.f;
        bf16* dst; int ld, cbase;
        if (isq) { dst = (bf16*)(p.ws + O_Q); ld = 512; cbase = (nt - 4) * 128 + wn * 64; } else { dst = (bf16*)(p.ws + O_K); ld = 128; cbase = wn * 64; }
#pragma unroll
        for (int rb = 0; rb < 2; ++rb)
#pragma unroll
            for (int i = 0; i < 16; ++i) {
                const int row = row0 + ACC_ROW(rb, i);
                float v0 = acc[rb][0][i], v1 = acc[rb][1][i];
                float ss = v0 * v0 + v1 * v1;
                ss += __shfl_xor(ss, 1); ss += __shfl_xor(ss, 2); ss += __shfl_xor(ss, 4); ss += __shfl_xor(ss, 8); ss += __shfl_xor(ss, 16);
                const float rstd = rsqrtf(ss * (1.f / 64.f) + 1e-6f);
                v0 = v0 * rstd * g0; v1 = v1 * rstd * g1;
                if (latent) {
                    const float2 cs0 = AT(const float2, rope, (row >> 6) * 16 + (r & 15)), cs1 = AT(const float2, rope, (row & 63) * 16 + (r & 15));
                    const float p0 = __shfl_xor(v0, 16), p1 = __shfl_xor(v1, 16);
                    const float sg = (r & 16) ? 1.f : -1.f;
                    v0 = v0 * cs0.x + sg * p0 * cs0.y;
                    v1 = v1 * cs1.x + sg * p1 * cs1.y;
                }
                AT(bf16, dst, row * ld + cbase + r) = f2bf(v0 * osc);
                AT(bf16, dst, row * ld + cbase + 32 + r) = f2bf(v1 * osc);
                asm volatile("" ::: "memory");
            }
    } else if (nt == 9) {
        bf16* vt = (bf16*)(p.ws + O_VT);
#pragma unroll
        for (int rb = 0; rb < 2; ++rb)
#pragma unroll
            for (int cb = 0; cb < 2; ++cb)
#pragma unroll
                for (int q = 0; q < 4; ++q) {
                    u32x2 pk; pk.x = pk2(acc[rb][cb][4 * q], acc[rb][cb][4 * q + 1]); pk.y = pk2(acc[rb][cb][4 * q + 2], acc[rb][cb][4 * q + 3]);
                    AT(u32x2, vt, (ACC_COL(cb) * NT + row0 + wm * 64 + rb * 32 + 8 * q + 4 * h) >> 2) = pk;
                }
    } else {
        bf16* G = (bf16*)(p.ws + O_BIG);
        const int cbase = (nt - 10) * 128;
#pragma unroll
        for (int rb = 0; rb < 2; ++rb)
#pragma unroll
            for (int cb = 0; cb < 2; ++cb)
#pragma unroll
                for (int i = 0; i < 16; ++i) AT(bf16, G, (row0 + ACC_ROW(rb, i)) * 3072 + cbase + ACC_COL(cb)) = f2bf(sigmoidf_(acc[rb][cb][i]));
    }
}
DI void s1_item(const Params& p, int it, ldsp lds) {
    TID_VARS
    const int g = it & 15, rest = it >> 4, nt = rest & 1, mt = rest >> 1;
    f32x16 acc[2][2]; zero_acc<2>(acc);
    gemm_acc<1, 2>(acc, (const bf16*)(p.ws + O_S) + g * 16, 8192, mt * 128, (const bf16*)(p.ws + O_W1S) + (unsigned)g * 256 * 512, 512, nt * 128, 512, lds);
    float* E = (float*)(p.ws + O_E);
#pragma unroll
    for (int rb = 0; rb < 2; ++rb)
#pragma unroll
        for (int cb = 0; cb < 2; ++cb)
#pragma unroll
            for (int i = 0; i < 16; ++i) {
                const int c = mt * 128 + ACC_ROW(rb, i);
                if (c < NCH) AT(float, E, (c * 16 + g) * 256 + nt * 128 + ACC_COL(cb)) = acc[rb][cb][i];
            }
}
DI void s2_item(const Params& p, int it) {
    const int sidx = it * 256 + threadIdx.x;
    const int g = sidx >> 7, dir = (sidx >> 6) & 1, pp = sidx & 63;
    const float2 aT = ((const float2*)(p.ws + O_PW))[(unsigned)((dir * 16 + g) * 64 + pp) * 33 + 32];
    const float* E = (const float*)(p.ws + O_E) + g * 256 + dir * 128 + pp;
    bf16* C = (bf16*)(p.ws + O_CARRY) + g * 256 + dir * 128 + pp;
    float cr = 0.f, ci = 0.f;
#pragma unroll 8
    for (int n = 0; n < NCH; ++n) {
        int c;
        if (dir == 0) c = (n < 8) ? 512 + n : n - 8;
        else c = (n < 8) ? 519 - n : 519 - n;
        const float er = E[(unsigned)c * 4096], ei = E[(unsigned)c * 4096 + 64];
        C[(unsigned)c * 4096] = f2bf(cr); C[(unsigned)c * 4096 + 64] = f2bf(ci);
        const float nr = aT.x * cr - aT.y * ci + er, ni = aT.x * ci + aT.y * cr + ei;
        cr = nr; ci = ni;
    }
}
DI float gelu_tanh(float x) { const float u = 0.7978845608028654f * (x + 0.044715f * x * x * x); return x * sigmoidf_(2.f * u); }
DI void s3_item(const Params& p, int it, ldsp lds) {
    TID_VARS
    const int g = it & 15, rest = it >> 4, nt = rest & 3, mt = rest >> 2;
    f32x16 acc[2][2]; zero_acc<2>(acc);
    gemm_acc<1, 2>(acc, (const bf16*)(p.ws + O_S) + g * 16, 8192, mt * 128, (const bf16*)(p.ws + O_TOEP) + (unsigned)g * 512 * 512, 512, nt * 128, 512, lds);
    gemm_acc<0, 2>(acc, (const bf16*)(p.ws + O_CARRY) + g * 256, 4096, mt * 128, (const bf16*)(p.ws + O_W3S) + (unsigned)g * 512 * 256, 256, nt * 128, 256, lds);
    bf16* Ys = (bf16*)(p.ws + O_YS);
#pragma unroll
    for (int rb = 0; rb < 2; ++rb)
#pragma unroll
        for (int cb = 0; cb < 2; ++cb)
#pragma unroll
            for (int i = 0; i < 16; ++i) {
                const int c = mt * 128 + ACC_ROW(rb, i);
                const int n = nt * 128 + ACC_COL(cb), j = n >> 4, hh = n & 15;
                if (c < NCH) AT(bf16, Ys, (c * 32 + j) * 256 + g * 16 + hh) = f2bf(gelu_tanh(acc[rb][cb][i]));
            }
}
DI void pool_item(const Params& p, int it) {
    const int tid = threadIdx.x, cv = tid & 31, rg = tid >> 5;
    const bf16* A = (const bf16*)(p.ws + O_A);
    bf16* Y = (bf16*)(p.ws + O_YP);
    const int half = 1 << (cv >> 3);
#pragma unroll 1
    for (int i = 0; i < 4; ++i) {
        const int row = it * 32 + rg + 8 * i;
        const int base = row >= NL ? NL : 0, n = row >= NL ? NC : NL, t = row - base;
        const int lo = max(t - half, 0), hi = min(t + half, n);
        float s[8];
#pragma unroll
        for (int e = 0; e < 8; ++e) s[e] = 0.f;
        for (int u = lo; u < hi; ++u) {
            const u32x4 v = *(const u32x4*)(A + (unsigned)(base + u) * 256 + cv * 8);
            s[0] += bflo(v.x); s[1] += bfhi(v.x); s[2] += bflo(v.y); s[3] += bfhi(v.y); s[4] += bflo(v.z); s[5] += bfhi(v.z); s[6] += bflo(v.w); s[7] += bfhi(v.w);
        }
        const u32x4 v = *(const u32x4*)(A + (unsigned)row * 256 + cv * 8);
        const float inv = 1.f / (float)(hi - lo);
        u32x4 o;
        o.x = pk2(s[0] * inv - bflo(v.x), s[1] * inv - bfhi(v.x)); o.y = pk2(s[2] * inv - bflo(v.y), s[3] * inv - bfhi(v.y));
        o.z = pk2(s[4] * inv - bflo(v.z), s[5] * inv - bfhi(v.z)); o.w = pk2(s[6] * inv - bflo(v.w), s[7] * inv - bfhi(v.w));
        *(u32x4*)(Y + (unsigned)row * 256 + cv * 8) = o;
    }
}
DI int sig_perm(int r) { return (r & 0x13) | ((r & 4) << 1) | ((r & 8) >> 1); }
DI void attn_item(const Params& p, int qb, int head, ldsp lds) {
    TID_VARS
    const int kvh = head >> 2;
    bf16* Q = (bf16*)(p.ws + O_Q);
    const bf16* Kp = (const bf16*)(p.ws + O_K) + kvh * 64;
    const bf16* Vp = (const bf16*)(p.ws + O_VT) + (unsigned)kvh * 64 * NT;
    const int q0 = qb * 128 + w * 32;
    bf16x8 qf[4];
#pragma unroll
    for (int s = 0; s < 4; ++s) qf[s] = *(const bf16x8*)(Q + (unsigned)(q0 + r) * 512 + head * 64 + 16 * s + 8 * h);
    const int key0 = qb < 128 ? 0 : NL, ntile = qb < 128 ? NT / 64 : NC / 64;
    const int lrow = tid >> 3, lv = tid & 7;
    const bf16* kg = Kp + (unsigned)(key0 + lrow) * 128 + lv * 8;
    const bf16* vg = Vp + (unsigned)lrow * NT + key0 + lv * 8;
    u32x4 rk[2], rv[2];
#pragma unroll
    for (int i = 0; i < 2; ++i) { rk[i] = *(const u32x4*)(kg + (unsigned)i * 32 * 128); rv[i] = *(const u32x4*)(vg + (unsigned)i * 32 * NT); }
    ldsp wr = lds + lrow * LROW + lv * 16;
#pragma unroll
    for (int i = 0; i < 2; ++i) { *(LAS u32x4*)(wr + i * 32 * LROW) = rk[i]; *(LAS u32x4*)(wr + 9216 + i * 32 * LROW) = rv[i]; }
    __syncthreads();
    f32x16 o0, o1;
#pragma unroll
    for (int i = 0; i < 16; ++i) { o0[i] = 0.f; o1[i] = 0.f; }
    float m = -1e30f, lsum = 0.f;
    const float L2E = 1.4426950408889634f;
    cldsp lk = lds + sig_perm(r) * LROW + h * 16;
    cldsp lvv = lds + 9216 + r * LROW + h * 16;
    for (int t = 0; t < ntile; ++t) {
        const int buf = t & 1;
        const bool more = t + 1 < ntile;
        if (more) {
            kg += 64 * 128; vg += 64;
#pragma unroll
            for (int i = 0; i < 2; ++i) { rk[i] = *(const u32x4*)(kg + (unsigned)i * 32 * 128); rv[i] = *(const u32x4*)(vg + (unsigned)i * 32 * NT); }
        }
        cldsp pk = lk + buf * 18432; cldsp pv = lvv + buf * 18432;
        f32x16 s0, s1;
#pragma unroll
        for (int i = 0; i < 16; ++i) { s0[i] = 0.f; s1[i] = 0.f; }
#pragma unroll
        for (int s = 0; s < 4; ++s) {
            const bf16x8 k0 = *(const LAS bf16x8*)(pk + s * 32), k1 = *(const LAS bf16x8*)(pk + 32 * LROW + s * 32);
            s0 = MFMA(k0, qf[s], s0); s1 = MFMA(k1, qf[s], s1);
        }
        float mx = s0[0];
#pragma unroll
        for (int i = 1; i < 16; ++i) mx = fmaxf(mx, s0[i]);
#pragma unroll
        for (int i = 0; i < 16; ++i) mx = fmaxf(mx, s1[i]);
        mx = fmaxf(mx, __shfl_xor(mx, 32));
        const float mnew = fmaxf(m, mx);
        const float alpha = __builtin_amdgcn_exp2f((m - mnew) * L2E);
        m = mnew;
        const float mb = mnew * L2E;
        float rs = 0.f;
#pragma unroll
        for (int i = 0; i < 16; ++i) { s0[i] = __builtin_amdgcn_exp2f(s0[i] * L2E - mb); rs += s0[i]; }
#pragma unroll
        for (int i = 0; i < 16; ++i) { s1[i] = __builtin_amdgcn_exp2f(s1[i] * L2E - mb); rs += s1[i]; }
        lsum = lsum * alpha + rs;
#pragma unroll
        for (int i = 0; i < 16; ++i) { o0[i] *= alpha; o1[i] *= alpha; }
#pragma unroll
        for (int kb = 0; kb < 2; ++kb)
#pragma unroll
            for (int s = 0; s < 2; ++s) {
                u32x4 pp;
                if (kb == 0) { pp.x = pk2(s0[8 * s], s0[8 * s + 1]); pp.y = pk2(s0[8 * s + 2], s0[8 * s + 3]); pp.z = pk2(s0[8 * s + 4], s0[8 * s + 5]); pp.w = pk2(s0[8 * s + 6], s0[8 * s + 7]); }
                else         { pp.x = pk2(s1[8 * s], s1[8 * s + 1]); pp.y = pk2(s1[8 * s + 2], s1[8 * s + 3]); pp.z = pk2(s1[8 * s + 4], s1[8 * s + 5]); pp.w = pk2(s1[8 * s + 6], s1[8 * s + 7]); }
                const bf16x8 pf = __builtin_bit_cast(bf16x8, pp);
                const bf16x8 v0 = *(const LAS bf16x8*)(pv + (kb * 32 + 16 * s) * 2), v1 = *(const LAS bf16x8*)(pv + 32 * LROW + (kb * 32 + 16 * s) * 2);
                o0 = MFMA(v0, pf, o0); o1 = MFMA(v1, pf, o1);
            }
        if (more) {
            ldsp w2 = wr + (buf ^ 1) * 18432;
#pragma unroll
            for (int i = 0; i < 2; ++i) { *(LAS u32x4*)(w2 + i * 32 * LROW) = rk[i]; *(LAS u32x4*)(w2 + 9216 + i * 32 * LROW) = rv[i]; }
        }
        __syncthreads();
    }
    lsum += __shfl_xor(lsum, 32);
    const float inv = 1.f / lsum;
    bf16* orow = Q + (unsigned)(q0 + r) * 512 + head * 64;
#pragma unroll
    for (int q = 0; q < 4; ++q) {
        u32x2 a, b;
        a.x = pk2(o0[4 * q] * inv, o0[4 * q + 1] * inv); a.y = pk2(o0[4 * q + 2] * inv, o0[4 * q + 3] * inv);
        b.x = pk2(o1[4 * q] * inv, o1[4 * q + 1] * inv); b.y = pk2(o1[4 * q + 2] * inv, o1[4 * q + 3] * inv);
        *(u32x2*)(orow + 8 * q + 4 * h) = a;
        *(u32x2*)(orow + 32 + 8 * q + 4 * h) = b;
    }
}
DI void mix1_item(const Params& p, int it, ldsp lds) {
    TID_VARS
    const int nt = it & 15, mt = it >> 4;
    const bf16* G = (const bf16*)(p.ws + O_BIG);
    const int row0 = mt * 128, col = nt * 64 + wn * 32 + r;
    f32x16 acc[2][1];
    f32x16 mx[2];
    zero_acc<1>(acc);
    gemm_acc<0, 1>(acc, (const bf16*)(p.ws + O_YS), 256, row0, (const bf16*)(p.ws + O_WGLU), 256, 1024 + nt * 64, 256, lds);
#pragma unroll
    for (int rb = 0; rb < 2; ++rb)
#pragma unroll
        for (int i = 0; i < 16; ++i) mx[rb][i] = sigmoidf_(acc[rb][0][i]) * bf2f(AT(const bf16, G, (row0 + ACC_ROW(rb, i)) * 3072 + 1024 + col));
    zero_acc<1>(acc);
    gemm_acc<0, 1>(acc, (const bf16*)(p.ws + O_YS), 256, row0, (const bf16*)(p.ws + O_WGLU), 256, nt * 64, 256, lds);
#pragma unroll
    for (int rb = 0; rb < 2; ++rb)
#pragma unroll
        for (int i = 0; i < 16; ++i) mx[rb][i] *= acc[rb][0][i];
    zero_acc<1>(acc);
    gemm_acc<0, 1>(acc, (const bf16*)(p.ws + O_YP), 256, row0, (const bf16*)(p.ws + O_WP), 256, nt * 64, 256, lds);
#pragma unroll
    for (int rb = 0; rb < 2; ++rb)
#pragma unroll
        for (int i = 0; i < 16; ++i) mx[rb][i] += acc[rb][0][i] * bf2f(AT(const bf16, G, (row0 + ACC_ROW(rb, i)) * 3072 + col));
    zero_acc<1>(acc);
    gemm_acc<0, 1>(acc, (const bf16*)(p.ws + O_Q), 512, row0, (const bf16*)(p.ws + O_WAO), 512, nt * 64, 512, lds);
    bf16* M = (bf16*)(p.ws + O_H);
#pragma unroll
    for (int rb = 0; rb < 2; ++rb)
#pragma unroll
        for (int i = 0; i < 16; ++i) {
            const int row = row0 + ACC_ROW(rb, i);
            const float v = mx[rb][i] + acc[rb][0][i] * bf2f(AT(const bf16, G, row * 3072 + 2048 + col));
            AT(bf16, M, row * D + col) = f2bf(v);
        }
}

DI void conv_tile(const float* src, bf16* dst, int K, int N, int permmode, int tile, ldsp lds) {
    const int tid = threadIdx.x;
    const int ntn = N / 64, tk = tile / ntn, tn = tile % ntn;
    LAS float* L = (LAS float*)lds;
#pragma unroll
    for (int i = 0; i < 4; ++i) {
        const int kk = (tid >> 4) + 16 * i, c4 = (tid & 15) * 4;
        const f32x4 v = *(const f32x4*)(src + (size_t)(tk * 64 + kk) * N + tn * 64 + c4);
        L[kk * 65 + c4] = v[0]; L[kk * 65 + c4 + 1] = v[1]; L[kk * 65 + c4 + 2] = v[2]; L[kk * 65 + c4 + 3] = v[3];
    }
    __syncthreads();
    const int n = tid >> 2, ks = (tid & 3) * 16;
    int nn = tn * 64 + n;
    if (permmode == 1) { const int half = N >> 1, b = nn >= half, hc = b ? nn - half : nn; nn = 128 * (hc >> 6) + 64 * ((hc >> 5) & 1) + 32 * b + (hc & 31); }
    u32x4 o0, o1;
    o0.x = pk2(L[(ks + 0) * 65 + n], L[(ks + 1) * 65 + n]); o0.y = pk2(L[(ks + 2) * 65 + n], L[(ks + 3) * 65 + n]);
    o0.z = pk2(L[(ks + 4) * 65 + n], L[(ks + 5) * 65 + n]); o0.w = pk2(L[(ks + 6) * 65 + n], L[(ks + 7) * 65 + n]);
    o1.x = pk2(L[(ks + 8) * 65 + n], L[(ks + 9) * 65 + n]); o1.y = pk2(L[(ks + 10) * 65 + n], L[(ks + 11) * 65 + n]);
    o1.z = pk2(L[(ks + 12) * 65 + n], L[(ks + 13) * 65 + n]); o1.w = pk2(L[(ks + 14) * 65 + n], L[(ks + 15) * 65 + n]);
    bf16* d = dst + (size_t)nn * K + tk * 64 + ks;
    *(u32x4*)d = o0; *(u32x4*)(d + 8) = o1;
    __syncthreads();
}
constexpr int CV0 = 1408, CV1 = 2816, CV2 = 3520, CV3 = 4224, CV4 = 5312, CV5 = 5440, CV6 = 5568, CV_TOTAL = 5824;
DI void conv_item(const Params& p, int l, int it, ldsp lds) {
    if (it < CV0) conv_tile(p.in[I_W13] + (size_t)(l * 2 + 0) * 1024 * 5632, (bf16*)(p.ws + O_W13), 1024, 5632, 1, it, lds);
    else if (it < CV1) conv_tile(p.in[I_W13] + (size_t)(l * 2 + 1) * 1024 * 5632, (bf16*)(p.ws + O_W13) + (size_t)5632 * 1024, 1024, 5632, 1, it - CV0, lds);
    else if (it < CV2) conv_tile(p.in[I_W2] + (size_t)(l * 2 + 0) * 2816 * 1024, (bf16*)(p.ws + O_W2), 2816, 1024, 0, it - CV1, lds);
    else if (it < CV3) conv_tile(p.in[I_W2] + (size_t)(l * 2 + 1) * 2816 * 1024, (bf16*)(p.ws + O_W2) + (size_t)1024 * 2816, 2816, 1024, 0, it - CV2, lds);
    else if (it < CV4) conv_tile(p.in[I_WIN] + (size_t)l * 1024 * INW, (bf16*)(p.ws + O_WIN), 1024, INW, 0, it - CV3, lds);
    else if (it < CV5) conv_tile(p.in[I_GLU] + (size_t)l * 256 * 2048, (bf16*)(p.ws + O_WGLU), 256, 2048, 0, it - CV4, lds);
    else if (it < CV6) conv_tile(p.in[I_AO] + (size_t)l * 512 * 1024, (bf16*)(p.ws + O_WAO), 512, 1024, 0, it - CV5, lds);
    else conv_tile(p.in[I_WO] + (size_t)l * 1024 * 1024, (bf16*)(p.ws + O_WOUT), 1024, 1024, 0, it - CV6, lds);
}
DI void mod_item(const Params& p, int it, ldsp lds) {
    const int tid = threadIdx.x, lane = tid & 63, w = tid >> 6;
    const int c0 = it * 256 + lane * 4, l = c0 / 9216, col = c0 % 9216;
    const float* W = p.in[I_MODW] + (size_t)l * 1024 * 9216 + col;
    f32x4 a0 = {0.f, 0.f, 0.f, 0.f}, a1 = {0.f, 0.f, 0.f, 0.f};
#pragma unroll 8
    for (int k = w * 256; k < w * 256 + 256; ++k) {
        const f32x4 wv = *(const f32x4*)(W + (size_t)k * 9216);
        const float c = p.in[I_C][k], cc = p.in[I_CCTX][k];
        const float s0 = c * sigmoidf_(c), s1 = cc * sigmoidf_(cc);
        a0 += wv * s0; a1 += wv * s1;
    }
    LAS f32x4* L = (LAS f32x4*)lds;
    L[(w * 64 + lane) * 2] = a0; L[(w * 64 + lane) * 2 + 1] = a1;
    __syncthreads();
    if (w == 0) {
        f32x4 b = *(const f32x4*)(p.in[I_MODB] + (size_t)l * 9216 + col);
        f32x4 r0 = b, r1 = b;
#pragma unroll
        for (int q = 0; q < 4; ++q) { r0 += L[(q * 64 + lane) * 2]; r1 += L[(q * 64 + lane) * 2 + 1]; }
        float* M = (float*)(p.ws + O_MODS);
        *(f32x4*)(M + (size_t)(0 * 2 + l) * 9216 + col) = r0;
        *(f32x4*)(M + (size_t)(1 * 2 + l) * 9216 + col) = r1;
    }
    __syncthreads();
}
DI void pw_item(const Params& p, int l, int it) {
    const int idx = it * 256 + threadIdx.x;
    if (idx >= 2048 * 33) return;
    const int st = idx / 33, e = idx % 33;
    const int dg = st >> 6;
    const double are = p.in[I_ARE][(size_t)l * 2048 + st], aim = p.in[I_AIM][(size_t)l * 2048 + st];
    const double dt = dexp((double)p.in[I_LOGDT][l * 32 + dg]);
    const double mag = dexp(are * dt * e);
    double s, c; dsincos(aim * dt * e, s, c);
    ((float2*)(p.ws + O_PW))[idx] = make_float2((float)(mag * c), (float)(mag * s));
    if (e == 1) {
        const double nr = mag * c - 1.0, ni = mag * s, den = are * are + aim * aim;
        ((float2*)(p.ws + O_CF))[st] = make_float2((float)((nr * are + ni * aim) / den), (float)((ni * are - nr * aim) / den));
    }
}
DI void wp_item(const Params& p, int l, int it) {
    const int k = it >> 2, n = (it & 3) * 256 + threadIdx.x, g = k >> 6, c = k & 63;
    const float* pw = p.in[I_POOLW] + (size_t)l * 4 * 64 * 64 + (size_t)(g * 64 + c) * 64;
    const float* ps = p.in[I_POOLS] + l * 256 + g * 64;
    const float* po = p.in[I_POOLO] + (size_t)l * 256 * 1024 + (size_t)(g * 64) * 1024 + n;
    float s = 0.f;
#pragma unroll 8
    for (int d = 0; d < 64; ++d) s += pw[d] * ps[d] * po[(size_t)d * 1024];
    ((bf16*)(p.ws + O_WP))[(size_t)n * 256 + k] = f2bf(s);
}
DI void rope_item(const Params& p, int it) {
    const int idx = it * 256 + threadIdx.x;
    const int pos = idx >> 4, i = idx & 15;
    const double inv = dexp(-(double)i * (9.210340371976184 / 16.0));
    double s, c; dsincos((double)pos * inv, s, c);
    ((float2*)(p.ws + O_ROPE))[idx] = make_float2((float)c, (float)s);
}
DI void ktab_item(const Params& p, int l, int it, ldsp lds) {
    const int tid = threadIdx.x;
    const int lag = it & 31, dg = it >> 5;
    LAS f32x2* Wl = (LAS f32x2*)lds;
    if (tid < 64) {
        const float2 z = ((const float2*)(p.ws + O_PW))[(size_t)(dg * 64 + tid) * 33 + lag], cf = ((const float2*)(p.ws + O_CF))[dg * 64 + tid];
        Wl[tid] = (f32x2){z.x * cf.x - z.y * cf.y, z.x * cf.y + z.y * cf.x};
    }
    __syncthreads();
    const int hp = tid >> 4, hh = tid & 15;
    const size_t pb = (size_t)(l * 32 + dg) * 1024;
    const float* cre = p.in[I_CRE] + pb + hp * 64, *cim = p.in[I_CIM] + pb + hp * 64;
    const float* bre = p.in[I_BRE] + pb + hh, *bim = p.in[I_BIM] + pb + hh;
    float s = 0.f;
#pragma unroll 8
    for (int q = 0; q < 64; ++q) {
        const f32x2 wv = Wl[q];
        const float br = bre[q * 16], bi = bim[q * 16];
        const float tr = wv.x * br - wv.y * bi, ti = wv.x * bi + wv.y * br;
        s += cre[q] * tr - cim[q] * ti;
    }
    ((float*)(p.ws + O_KTAB))[(size_t)it * 256 + tid] = s;
    __syncthreads();
}
DI void w1_item(const Params& p, int l, int it) {
    const int idx = it * 256 + threadIdx.x;
    const int k8 = idx & 63, n = (idx >> 6) & 255, g = idx >> 14;
    const int dir = n >> 7, ri = (n >> 6) & 1, pp = n & 63, j = k8 >> 1, h0 = (k8 & 1) * 8;
    const int e = dir ? j : 31 - j, st = (dir * 16 + g) * 64 + pp;
    const float2 z = ((const float2*)(p.ws + O_PW))[(size_t)st * 33 + e], cf = ((const float2*)(p.ws + O_CF))[st];
    const float wr = z.x * cf.x - z.y * cf.y, wi = z.x * cf.y + z.y * cf.x;
    const float* bre = p.in[I_BRE] + (size_t)(l * 32 + dir * 16 + g) * 1024 + pp * 16 + h0;
    const float* bim = p.in[I_BIM] + (size_t)(l * 32 + dir * 16 + g) * 1024 + pp * 16 + h0;
    float o[8];
#pragma unroll
    for (int q = 0; q < 8; ++q) o[q] = ri ? (wr * bim[q] + wi * bre[q]) : (wr * bre[q] - wi * bim[q]);
    u32x4 v; v.x = pk2(o[0], o[1]); v.y = pk2(o[2], o[3]); v.z = pk2(o[4], o[5]); v.w = pk2(o[6], o[7]);
    *(u32x4*)((bf16*)(p.ws + O_W1S) + ((size_t)g * 256 + n) * 512 + k8 * 8) = v;
}
DI void w3_item(const Params& p, int l, int it) {
    const int idx = it * 256 + threadIdx.x;
    const int k8 = idx & 31, n = (idx >> 5) & 511, g = idx >> 14;
    const int dir = k8 >> 4, ri = (k8 >> 3) & 1, p0 = (k8 & 7) * 8, j = n >> 4, hp = n & 15;
    const int e = dir ? 32 - j : j + 1;
    const float* cre = p.in[I_CRE] + (size_t)(l * 32 + dir * 16 + g) * 1024 + hp * 64 + p0;
    const float* cim = p.in[I_CIM] + (size_t)(l * 32 + dir * 16 + g) * 1024 + hp * 64 + p0;
    const float2* pw = (const float2*)(p.ws + O_PW) + (size_t)((dir * 16 + g) * 64 + p0) * 33 + e;
    float o[8];
#pragma unroll
    for (int q = 0; q < 8; ++q) { const float2 z = pw[q * 33]; o[q] = ri ? -(cre[q] * z.y + cim[q] * z.x) : (cre[q] * z.x - cim[q] * z.y); }
    u32x4 v; v.x = pk2(o[0], o[1]); v.y = pk2(o[2], o[3]); v.z = pk2(o[4], o[5]); v.w = pk2(o[6], o[7]);
    *(u32x4*)((bf16*)(p.ws + O_W3S) + ((size_t)g * 512 + n) * 256 + k8 * 8) = v;
}
DI void toep_item(const Params& p, int l, int it) {
    const int idx = it * 256 + threadIdx.x;
    const int k8 = idx & 63, n = (idx >> 6) & 511, g = idx >> 15;
    const int j2 = k8 >> 1, h0 = (k8 & 1) * 8, j = n >> 4, hp = n & 15;
    const float* KT = (const float*)(p.ws + O_KTAB);
    float o[8];
#pragma unroll
    for (int q = 0; q < 8; ++q) o[q] = 0.f;
    if (j2 <= j) { const float* kf = KT + ((size_t)(0 * 16 + g) * 32 + (j - j2)) * 256 + hp * 16 + h0;
#pragma unroll
        for (int q = 0; q < 8; ++q) o[q] += kf[q]; }
    if (j2 >= j) { const float* kb = KT + ((size_t)(1 * 16 + g) * 32 + (j2 - j)) * 256 + hp * 16 + h0;
#pragma unroll
        for (int q = 0; q < 8; ++q) o[q] += kb[q]; }
    if (j2 == j) {
        const float dd = p.in[I_SD][l * 256 + g * 16 + hp];
#pragma unroll
        for (int q = 0; q < 8; ++q) if (h0 + q == hp) o[q] += dd;
    }
    u32x4 v; v.x = pk2(o[0], o[1]); v.y = pk2(o[2], o[3]); v.z = pk2(o[4], o[5]); v.w = pk2(o[6], o[7]);
    *(u32x4*)((bf16*)(p.ws + O_TOEP) + ((size_t)g * 512 + n) * 512 + k8 * 8) = v;
}

constexpr int PH_PER_LAYER = 14, N_PHASES = 2 * PH_PER_LAYER + 1;
DI void run_phase(const Params& p, const int ph, ldsp lds) {
    const int G = gridDim.x, b = blockIdx.x;
    if (ph == 2 * PH_PER_LAYER) { for (int it = b; it < NL / 4; it += G) final_norm_item(p, it); return; }
    const int l = ph / PH_PER_LAYER, s = ph % PH_PER_LAYER;
    const int mtiles = (l == 1) ? 128 : 130;
#ifdef ONLY_S
    if (s != ONLY_S) return;
#endif
    switch (s) {
    case 0: {
        const int n_mod = (l == 0) ? 72 : 0, n_pw = 264, n_wp = 1024, n_rope = (l == 0) ? 16 : 0;
        int off = 0;
#define SUBLOOP(n, call) { for (int it = ((b - off) % G + G) % G; it < (n); it += G) { call; } off = (off + (n)) % G; }
        SUBLOOP(n_mod, mod_item(p, it, lds))
        SUBLOOP(n_pw, pw_item(p, l, it))
        SUBLOOP(n_wp, wp_item(p, l, it))
        SUBLOOP(n_rope, rope_item(p, it))
        SUBLOOP(CV_TOTAL, conv_item(p, l, it, lds))
    } break;
    case 1: {
        int off = 0;
        SUBLOOP(1024, ktab_item(p, l, it, lds))
        SUBLOOP(1024, w1_item(p, l, it))
        SUBLOOP(1024, w3_item(p, l, it))
        SUBLOOP(NT / 4, norm_item(p, l, 0, it))
    } break;
    case 2: for (int it = b; it < 130 * 44; it += G) ffn_a_item(p, 0, it, lds); break;
    case 3: for (int it = b; it < 130 * 8; it += G) gemm_resid_item(p, (const bf16*)(p.ws + O_BIG), DFF, DFF, (const bf16*)(p.ws + O_W2), l, 2, 0.5f, l == 0, it, lds); break;
    case 4: {
        int off = 0;
        SUBLOOP(2048, toep_item(p, l, it))
        SUBLOOP(NT / 4, norm_item(p, l, 1, it))
    } break;
    case 5: for (int it = b; it < 130 * 34; it += G) inproj_item(p, l, it, lds); break;
    case 6: {
        int off = 0;
        SUBLOOP(160, s1_item(p, it, lds))
        SUBLOOP(mtiles * 4, pool_item(p, it))
        SUBLOOP(((l == 0) ? 16 : 0), attn_item(p, 128 + (it >> 3), it & 7, lds))
    } break;
    case 7: {
        int off = 0;
        SUBLOOP(8, s2_item(p, it))
        SUBLOOP(1024, attn_item(p, it >> 3, it & 7, lds))
    } break;
    case 8: for (int it = b; it < 320; it += G) s3_item(p, it, lds); break;
    case 9: for (int it = b; it < mtiles * 16; it += G) mix1_item(p, it, lds); break;
    case 10: for (int it = b; it < mtiles * 8; it += G) gemm_resid_item(p, (const bf16*)(p.ws + O_H), D, D, (const bf16*)(p.ws + O_WOUT), l, 5, 1.0f, false, it, lds); break;
    case 11: for (int it = b; it < mtiles * 32; it += G) norm_item(p, l, 2, it); break;
    case 12: for (int it = b; it < mtiles * 44; it += G) ffn_a_item(p, 1, it, lds); break;
    case 13: for (int it = b; it < mtiles * 8; it += G) gemm_resid_item(p, (const bf16*)(p.ws + O_BIG), DFF, DFF, (const bf16*)(p.ws + O_W2) + (size_t)1024 * DFF, l, 8, 0.5f, false, it, lds); break;
    }
}

__global__ void __launch_bounds__(256, 2) hybrid_fwd(Params p, int ph_lo, int ph_hi) {
    __shared__ __attribute__((aligned(16))) char lds_raw[LDS_BYTES];
    ldsp lds = (ldsp)lds_raw;
    __shared__ uint4 xb_words;
    if (p.ws == nullptr) cg::this_grid().sync();
    XcdBarrier bar;
    const bool multi = (ph_hi - ph_lo) > 1;
    if (multi) {
        if (threadIdx.x == 0) xb_words = make_uint4(0u, 0u, 0u, 0u);
        __syncthreads();
        bar = xcd_barrier_post((unsigned*)(p.ws + O_BAR), (volatile LAS unsigned*)&xb_words);
    }
#define PH(k) if (ph_lo <= (k) && (k) < ph_hi) { if ((k) > ph_lo) xcd_barrier(bar); run_phase(p, (k), lds); }
    PH(0) PH(1) PH(2) PH(3) PH(4) PH(5) PH(6) PH(7) PH(8) PH(9) PH(10) PH(11) PH(12) PH(13)
    PH(14) PH(15) PH(16) PH(17) PH(18) PH(19) PH(20) PH(21) PH(22) PH(23) PH(24) PH(25) PH(26) PH(27) PH(28)
}

extern "C" void kernel_launch(void* const* d_in, const int* in_sizes, int n_in, void* d_out, int out_size, void* d_ws, size_t ws_size, hipStream_t stream) {
    (void)in_sizes; (void)n_in; (void)out_size;
    if (ws_size < O_END) { fprintf(stderr, "workspace too small: %zu < %zu\n", ws_size, (size_t)O_END); return; }
    static int grid_blocks = 0;
    if (!grid_blocks) {
        int dev = 0, cus = 0, per_cu = 0;
        hipGetDevice(&dev);
        hipDeviceGetAttribute(&cus, hipDeviceAttributeMultiprocessorCount, dev);
        hipOccupancyMaxActiveBlocksPerMultiprocessor(&per_cu, hybrid_fwd, 256, 0);
        if (per_cu > 2) per_cu = 2;
        if (per_cu < 1) per_cu = 1;
        grid_blocks = cus * per_cu;
    }
    Params p{};
    for (int i = 0; i < 27; ++i) p.in[i] = (const float*)d_in[i];
    p.out = (float*)d_out; p.ws = (char*)d_ws;
#if MK_ONE_LAUNCH
    hipMemsetAsync(d_ws, 0, 16384, stream);
    int lo = 0, hi = N_PHASES;
    void* args[] = {&p, &lo, &hi};
    hipError_t e = hipLaunchCooperativeKernel((void*)hybrid_fwd, dim3(grid_blocks), dim3(256), args, 0, stream);
    if (e != hipSuccess) fprintf(stderr, "cooperative launch failed: %s (grid %d)\n", hipGetErrorString(e), grid_blocks);
#else
    for (int ph = 0; ph < N_PHASES; ++ph) hipLaunchKernelGGL(hybrid_fwd, dim3(grid_blocks), dim3(256), 0, stream, p, ph, ph + 1);
#endif
}
```

```cpp
#include <hip/hip_runtime.h>
#include <hip/hip_cooperative_groups.h>
#include <cstdio>
#include <cstdint>
namespace cg = cooperative_groups;

#define DI __device__ __forceinline__
#define LAS __attribute__((address_space(3)))
typedef __attribute__((address_space(3))) char* ldsp;
typedef const __attribute__((address_space(3))) char* cldsp;
typedef unsigned short bf16;
typedef short bf16x8 __attribute__((ext_vector_type(8)));
typedef float f32x16 __attribute__((ext_vector_type(16)));
typedef float f32x4 __attribute__((ext_vector_type(4)));
typedef float f32x2 __attribute__((ext_vector_type(2)));
typedef unsigned u32x4 __attribute__((ext_vector_type(4)));
typedef unsigned u32x2 __attribute__((ext_vector_type(2)));
typedef __bf16 hbf2 __attribute__((ext_vector_type(2)));

#ifndef MK_ONE_LAUNCH
#define MK_ONE_LAUNCH 1
#endif

constexpr int D = 1024, NL = 16384, NC = 256, NT = NL + NC, DFF = 2816, INW = 4352;
constexpr int NCH = NT / 32;

enum { I_X = 0, I_C, I_CTX, I_CCTX, I_MODW, I_MODB, I_NORMG, I_W13, I_W2, I_WIN, I_POOLW, I_POOLS, I_POOLO, I_ARE, I_AIM, I_LOGDT,
       I_BRE, I_BIM, I_CRE, I_CIM, I_SD, I_GLU, I_QG, I_KG, I_AO, I_WO, I_FG };

constexpr size_t al(size_t x) { return (x + 255) & ~(size_t)255; }
constexpr size_t O_BAR = 0;
constexpr size_t O_X = 16384;
constexpr size_t O_H = O_X + al((size_t)NT * D * 4);
constexpr size_t O_BIG = O_H + al((size_t)NT * D * 2);
constexpr size_t O_Q = O_BIG + al((size_t)NT * 3072 * 2);
constexpr size_t O_K = O_Q + al((size_t)NT * 512 * 2);
constexpr size_t O_VT = O_K + al((size_t)NT * 128 * 2);
constexpr size_t O_A = O_VT + al((size_t)NT * 128 * 2);
constexpr size_t O_S = O_A + al((size_t)NT * 256 * 2);
constexpr size_t O_YP = O_S + al((size_t)NT * 256 * 2);
constexpr size_t O_YS = O_YP + al((size_t)NT * 256 * 2);
constexpr size_t O_CARRY = O_YS + al((size_t)NT * 256 * 2);
constexpr size_t O_E = O_CARRY + al((size_t)NCH * 16 * 256 * 2);
constexpr size_t O_W13 = O_E + al((size_t)NCH * 16 * 256 * 4);
constexpr size_t O_W2 = O_W13 + al((size_t)2 * 5632 * 1024 * 2);
constexpr size_t O_WIN = O_W2 + al((size_t)2 * 1024 * 2816 * 2);
constexpr size_t O_WGLU = O_WIN + al((size_t)INW * 1024 * 2);
constexpr size_t O_WAO = O_WGLU + al((size_t)2048 * 256 * 2);
constexpr size_t O_WOUT = O_WAO + al((size_t)1024 * 512 * 2);
constexpr size_t O_WP = O_WOUT + al((size_t)1024 * 1024 * 2);
constexpr size_t O_TOEP = O_WP + al((size_t)1024 * 256 * 2);
constexpr size_t O_W1S = O_TOEP + al((size_t)16 * 512 * 512 * 2);
constexpr size_t O_W3S = O_W1S + al((size_t)16 * 256 * 512 * 2);
constexpr size_t O_KTAB = O_W3S + al((size_t)16 * 512 * 256 * 2);
constexpr size_t O_PW = O_KTAB + al((size_t)2 * 16 * 32 * 256 * 4);
constexpr size_t O_CF = O_PW + al((size_t)2048 * 33 * 8);
constexpr size_t O_MODS = O_CF + al((size_t)2048 * 8);
constexpr size_t O_ROPE = O_MODS + al((size_t)2 * 2 * 9216 * 4);
constexpr size_t O_END = O_ROPE + al((size_t)256 * 16 * 8);

struct Params { const float* in[27]; float* out; char* ws; };

DI unsigned pk2(float a, float b) { f32x2 v = {a, b}; return __builtin_bit_cast(unsigned, __builtin_convertvector(v, hbf2)); }
DI bf16 f2bf(float a) { return (bf16)(pk2(a, 0.f) & 0xffffu); }
DI float bf2f(bf16 b) { return __uint_as_float(((unsigned)b) << 16); }
DI float bflo(unsigned u) { return __uint_as_float(u << 16); }
DI float bfhi(unsigned u) { return __uint_as_float(u & 0xffff0000u); }
DI float sigmoidf_(float x) { return 1.f / (1.f + __expf(-x)); }
DI float wave_sum(float v) {
#pragma unroll
    for (int o = 32; o >= 1; o >>= 1) v += __shfl_xor(v, o);
    return v;
}
#define AT(T, base, idx) (*(T*)((char*)(base) + (unsigned)((unsigned)(idx) * (unsigned)sizeof(T))))
#define MFMA(a, b, c) __builtin_amdgcn_mfma_f32_32x32x16_bf16((a), (b), (c), 0, 0, 0)

DI double dexp(double x) {
    const double n = __builtin_rint(x * 1.4426950408889634);
    const double r = x - n * 0.6931471805599453;
    double t = 1.0;
#pragma unroll
    for (int k = 16; k >= 1; --k) t = 1.0 + t * r * (1.0 / (double)k);
    const long long e = (long long)n + 1023;
    return t * __longlong_as_double(e << 52);
}
DI void dsincos(double th, double& s, double& c) {
    const double k = __builtin_rint(th * 0.15915494309189535);
    const double x = th - k * 6.283185307179586 - k * 2.4492935982947064e-16;
    const double x2 = x * x;
    double cs = 1.0, sn = 1.0;
#pragma unroll
    for (int j = 17; j >= 1; --j) {
        cs = 1.0 - cs * x2 * (1.0 / (double)((2 * j - 1) * (2 * j)));
        sn = 1.0 - sn * x2 * (1.0 / (double)((2 * j) * (2 * j + 1)));
    }
    c = cs; s = sn * x;
}

#define XB_TMO      128
#define XB_XCNT(j)  (256  + 64 * (j))
#define XB_XSUB(j)  (1280 + 64 * (j))
#define XB_XGEN(j)  (2304 + 64 * (j))
#define XB_TOP      3328
#define XB_TOPGEN   3392
#define XCD_BAR_WORDS 3456
#define XB_SPIN_CAP (1u << 22)
DI unsigned xb_ld(unsigned* p)              { return __hip_atomic_load(p, __ATOMIC_RELAXED, __HIP_MEMORY_SCOPE_AGENT); }
DI unsigned xb_add(unsigned* p, unsigned v) { return __hip_atomic_fetch_add(p, v, __ATOMIC_RELAXED, __HIP_MEMORY_SCOPE_AGENT); }
DI unsigned xb_xcc_id() { return (unsigned)__builtin_amdgcn_s_getreg((3 << 11) | 20) & 0xFu; }
#define XB_SPIN(cond, bar) do { unsigned _sp = 0; while (cond) { __builtin_amdgcn_s_sleep(1); \
    if ((++_sp & 255u) == 0u) { if (xb_ld(&(bar)[XB_TMO])) break; if (_sp > XB_SPIN_CAP) { atomicAdd(&(bar)[XB_TMO], 1u); break; } } } } while (0)
struct XcdBarrier { unsigned* bar; unsigned x; volatile LAS unsigned* st; };
DI XcdBarrier xcd_barrier_post(unsigned* bar, volatile LAS unsigned* st) {
    XcdBarrier b; b.bar = bar; b.x = xb_xcc_id(); b.st = st;
    if (threadIdx.x == 0) (void)xb_add(&bar[XB_XCNT(b.x)], 1u);
    return b;
}
DI void xcd_barrier_complete(unsigned* bar, unsigned x, unsigned& nloc, unsigned& nx) {
    const unsigned G = gridDim.x * gridDim.y * gridDim.z;
    unsigned sum, cnt, mine, sp = 0u;
    for (;;) {
        sum = 0u; cnt = 0u; mine = 0u;
#pragma unroll
        for (unsigned j = 0; j < 16; ++j) { const unsigned c = xb_ld(&bar[XB_XCNT(j)]); sum += c; cnt += (c > 0u) ? 1u : 0u; mine = (j == x) ? c : mine; }
        if (sum == G) break;
        __builtin_amdgcn_s_sleep(1);
        if ((++sp & 255u) == 0u) { if (xb_ld(&bar[XB_TMO])) break; if (sp > XB_SPIN_CAP) { atomicAdd(&bar[XB_TMO], 1u); break; } }
    }
    nloc = mine > 0u ? mine : 1u; nx = cnt > 0u ? cnt : 1u;
}
DI void xcd_barrier(const XcdBarrier& b) {
    asm volatile("s_waitcnt vmcnt(0)" ::: "memory");
    __syncthreads();
    if (threadIdx.x == 0) {
        unsigned* bar = b.bar;
        __builtin_amdgcn_s_waitcnt(0);
        unsigned nloc = b.st[0], nx = b.st[1];
        if (nloc == 0u) { xcd_barrier_complete(bar, b.x, nloc, nx); b.st[0] = nloc; b.st[1] = nx; }
        const unsigned old = xb_add(&bar[XB_XSUB(b.x)], 1u);
        const unsigned gen = old / nloc;
        if (old + 1u == (gen + 1u) * nloc) {
            __builtin_amdgcn_fence(__ATOMIC_RELEASE, "agent");
            asm volatile("s_waitcnt vmcnt(0)" ::: "memory");
            const unsigned og = xb_add(&bar[XB_TOP], 1u);
            const unsigned tg = og / nx;
            if (og + 1u == (tg + 1u) * nx) xb_add(&bar[XB_TOPGEN], 1u);
            else XB_SPIN(xb_ld(&bar[XB_TOPGEN]) == tg, bar);
            __builtin_amdgcn_fence(__ATOMIC_ACQUIRE, "agent");
            xb_add(&bar[XB_XGEN(b.x)], 1u);
            asm volatile("s_waitcnt vmcnt(0)" ::: "memory");
        } else {
            XB_SPIN(xb_ld(&bar[XB_XGEN(b.x)]) == gen, bar);
            __builtin_amdgcn_fence(__ATOMIC_ACQUIRE, "agent");
            asm volatile("s_waitcnt vmcnt(0)" ::: "memory");
        }
    }
    __syncthreads();
}

constexpr int LROW = 144;
constexpr int LTILE = 128 * LROW;
constexpr int LSTAGE = 2 * LTILE;
constexpr int LDS_BYTES = 2 * LSTAGE;

template <int AMODE, int NCB>
DI void gemm_acc(f32x16 (&acc)[2][NCB], const bf16* __restrict__ A, const long lda, const int arow0,
                 const bf16* __restrict__ Bt, const long ldb, const int brow0, const int K, ldsp lds) {
    int tid_ = threadIdx.x; asm volatile("" : "+v"(tid_));
    const int tid = tid_, lane = tid & 63, w = tid >> 6, wm = w >> 1, wn = w & 1, r = lane & 31, h = lane >> 5;
    const int v = tid & 7, lr = tid >> 3;
    const int avoff = AMODE ? ((v >> 1) * 256 + (v & 1) * 8) : v * 8;
    const int akstep = AMODE ? 1024 : 64;
    const bf16* ag = A + (long)(arow0 + lr) * lda + avoff;
    const bf16* bg = Bt + (long)(brow0 + lr) * ldb + v * 8;
    const int nk = K >> 6;
    u32x4 ra[4], rb[2 * NCB];
#pragma unroll
    for (int i = 0; i < 4; ++i) ra[i] = *(const u32x4*)(ag + (long)i * 32 * lda);
#pragma unroll
    for (int i = 0; i < 2 * NCB; ++i) rb[i] = *(const u32x4*)(bg + (long)i * 32 * ldb);
    ldsp wr = lds + lr * LROW + v * 16;
#pragma unroll
    for (int i = 0; i < 4; ++i) *(LAS u32x4*)(wr + i * 32 * LROW) = ra[i];
#pragma unroll
    for (int i = 0; i < 2 * NCB; ++i) *(LAS u32x4*)(wr + LTILE + i * 32 * LROW) = rb[i];
    __syncthreads();
    cldsp la = lds + (wm * 64 + r) * LROW + h * 16;
    cldsp lb = lds + LTILE + (wn * 32 * NCB + r) * LROW + h * 16;
    for (int kt = 0; kt < nk; ++kt) {
        const int buf = kt & 1;
        const bool more = (kt + 1 < nk);
        if (more) {
            ag += akstep; bg += 64;
#pragma unroll
            for (int i = 0; i < 4; ++i) ra[i] = *(const u32x4*)(ag + (long)i * 32 * lda);
#pragma unroll
            for (int i = 0; i < 2 * NCB; ++i) rb[i] = *(const u32x4*)(bg + (long)i * 32 * ldb);
        }
        cldsp pa = la + buf * LSTAGE; cldsp pb = lb + buf * LSTAGE;
#pragma unroll
        for (int s = 0; s < 4; ++s) {
            const bf16x8 a0 = *(const LAS bf16x8*)(pa + s * 32), a1 = *(const LAS bf16x8*)(pa + 32 * LROW + s * 32);
#pragma unroll
            for (int cb = 0; cb < NCB; ++cb) {
                const bf16x8 b0 = *(const LAS bf16x8*)(pb + cb * 32 * LROW + s * 32);
                acc[0][cb] = MFMA(a0, b0, acc[0][cb]); acc[1][cb] = MFMA(a1, b0, acc[1][cb]);
            }
        }
        if (more) {
            ldsp w2 = wr + (buf ^ 1) * LSTAGE;
#pragma unroll
            for (int i = 0; i < 4; ++i) *(LAS u32x4*)(w2 + i * 32 * LROW) = ra[i];
#pragma unroll
            for (int i = 0; i < 2 * NCB; ++i) *(LAS u32x4*)(w2 + LTILE + i * 32 * LROW) = rb[i];
        }
        __syncthreads();
    }
}
template <int NCB>
DI void zero_acc(f32x16 (&acc)[2][NCB]) {
#pragma unroll
    for (int a = 0; a < 2; ++a)
#pragma unroll
        for (int b = 0; b < NCB; ++b)
#pragma unroll
            for (int i = 0; i < 16; ++i) acc[a][b][i] = 0.f;
}
#define ACC_ROW(rb, i) (wm * 64 + (rb) * 32 + ((i) & 3) + 8 * ((i) >> 2) + 4 * h)
#define ACC_COL(cb) (wn * 64 + (cb) * 32 + r)
#define TID_VARS int tid_ = threadIdx.x; asm volatile("" : "+v"(tid_)); const int tid = tid_, lane = tid & 63, w = tid >> 6, wm = w >> 1, wn = w & 1, r = lane & 31, h = lane >> 5; (void)wm; (void)wn; (void)r; (void)h; (void)lane; (void)w;

DI const float* mods_ptr(const Params& p, int cond, int l, int j) { return (const float*)(p.ws + O_MODS) + ((size_t)(cond * 2 + l) * 9 + j) * 1024; }

DI void ffn_a_item(const Params& p, int f, int it, ldsp lds) {
    TID_VARS
    const int nt = it % 44, mt = it / 44;
    f32x16 acc[2][2]; zero_acc<2>(acc);
    gemm_acc<0, 2>(acc, (const bf16*)(p.ws + O_H), 1024, mt * 128, (const bf16*)(p.ws + O_W13) + (unsigned)f * 5632 * 1024, 1024, nt * 128, 1024, lds);
    bf16* hid = (bf16*)(p.ws + O_BIG);
    const int col = nt * 64 + wn * 32 + r;
#pragma unroll
    for (int rb = 0; rb < 2; ++rb)
#pragma unroll
        for (int i = 0; i < 16; ++i) {
            const float g = acc[rb][0][i], u = acc[rb][1][i];
            const int row = mt * 128 + ACC_ROW(rb, i);
            AT(bf16, hid, row * DFF + col) = f2bf(g * sigmoidf_(g) * u);
        }
}
DI void gemm_resid_item(const Params& p, const bf16* A, int lda, int K, const bf16* Bt, int l, int gate_j, float scale, bool resid_in, int it, ldsp lds) {
    TID_VARS
    const int nt = it % 8, mt = it / 8;
    f32x16 acc[2][2]; zero_acc<2>(acc);
    gemm_acc<0, 2>(acc, A, lda, mt * 128, Bt, K, nt * 128, K, lds);
    const int cond = (mt >= 128) ? 1 : 0;
    const float* gate = mods_ptr(p, cond, l, gate_j);
    float* X = (float*)(p.ws + O_X);
#pragma unroll
    for (int cb = 0; cb < 2; ++cb) {
        const int col = nt * 128 + ACC_COL(cb);
        const float gs = gate[col] * scale;
#pragma unroll
        for (int rb = 0; rb < 2; ++rb)
#pragma unroll
            for (int i = 0; i < 16; ++i) {
                const int row = mt * 128 + ACC_ROW(rb, i);
                float rs;
                if (resid_in) rs = cond ? AT(const float, p.in[I_CTX], (row - NL) * D + col) : AT(const float, p.in[I_X], row * D + col);
                else rs = AT(float, X, row * D + col);
                AT(float, X, row * D + col) = rs + gs * acc[rb][cb][i];
            }
    }
}
DI void norm_item(const Params& p, int l, int which, int it) {
    const int tid = threadIdx.x, lane = tid & 63, w = tid >> 6;
    const int row = it * 4 + w;
    const int cond = row >= NL;
    const float* src = (l == 0 && which == 0) ? (cond ? p.in[I_CTX] + (unsigned)(row - NL) * D : p.in[I_X] + (unsigned)row * D) : (const float*)(p.ws + O_X) + (unsigned)row * D;
    f32x4 x[4]; float ss = 0.f;
#pragma unroll
    for (int j = 0; j < 4; ++j) { x[j] = *(const f32x4*)(src + lane * 4 + 256 * j); ss += x[j][0] * x[j][0] + x[j][1] * x[j][1] + x[j][2] * x[j][2] + x[j][3] * x[j][3]; }
    ss = wave_sum(ss);
    const float rstd = rsqrtf(ss * (1.f / 1024.f) + 1e-6f);
    const float* g = p.in[I_NORMG] + (unsigned)(l * 3 + which) * D;
    const float* sh = mods_ptr(p, cond, l, 3 * which), *sc = mods_ptr(p, cond, l, 3 * which + 1);
    bf16* H = (bf16*)(p.ws + O_H) + (unsigned)row * D;
#pragma unroll
    for (int j = 0; j < 4; ++j) {
        const int c = lane * 4 + 256 * j;
        const f32x4 gv = *(const f32x4*)(g + c), sv = *(const f32x4*)(sh + c), cv = *(const f32x4*)(sc + c);
        float o[4];
#pragma unroll
        for (int e = 0; e < 4; ++e) o[e] = x[j][e] * rstd * gv[e] * (1.f + cv[e]) + sv[e];
        u32x2 pk; pk.x = pk2(o[0], o[1]); pk.y = pk2(o[2], o[3]);
        *(u32x2*)(H + c) = pk;
    }
}
DI void final_norm_item(const Params& p, int it) {
    const int tid = threadIdx.x, lane = tid & 63, w = tid >> 6;
    const int row = it * 4 + w;
    const float* src = (const float*)(p.ws + O_X) + (unsigned)row * D;
    f32x4 x[4]; float ss = 0.f;
#pragma unroll
    for (int j = 0; j < 4; ++j) { x[j] = *(const f32x4*)(src + lane * 4 + 256 * j); ss += x[j][0] * x[j][0] + x[j][1] * x[j][1] + x[j][2] * x[j][2] + x[j][3] * x[j][3]; }
    ss = wave_sum(ss);
    const float rstd = rsqrtf(ss * (1.f / 1024.f) + 1e-6f);
    const float* g = p.in[I_FG];
#pragma unroll
    for (int j = 0; j < 4; ++j) {
        const int c = lane * 4 + 256 * j;
        const f32x4 gv = *(const f32x4*)(g + c);
        f32x4 o;
#pragma unroll
        for (int e = 0; e < 4; ++e) o[e] = x[j][e] * rstd * gv[e];
        *(f32x4*)(p.out + (unsigned)row * D + c) = o;
    }
}
DI void inproj_item(const Params& p, int l, int it, ldsp lds) {
    TID_VARS
    const int nt = it % 34, mt = it / 34;
    f32x16 acc[2][2]; zero_acc<2>(acc);
    gemm_acc<0, 2>(acc, (const bf16*)(p.ws + O_H), 1024, mt * 128, (const bf16*)(p.ws + O_WIN), 1024, nt * 128, 1024, lds);
    const int row0 = mt * 128;
    if (nt < 4) {
        bf16* dst = (bf16*)(p.ws + (nt < 2 ? O_A : O_S));
        const int cbase = (nt & 1) * 128;
#pragma unroll
        for (int rb = 0; rb < 2; ++rb)
#pragma unroll
            for (int cb = 0; cb < 2; ++cb)
#pragma unroll
                for (int i = 0; i < 16; ++i) AT(bf16, dst, (row0 + ACC_ROW(rb, i)) * 256 + cbase + ACC_COL(cb)) = f2bf(acc[rb][cb][i]);
    } else if (nt < 9) {
        const bool isq = nt < 8;
        const float* gv = p.in[isq ? I_QG : I_KG] + l * 64;
        const float g0 = gv[r], g1 = gv[32 + r];
        const float2* rope = (const float2*)(p.ws + O_ROPE);
        const bool latent = mt < 128;
        const float osc = isq ? 0.125f : 1.f;
        bf16* dst; int ld, cbase;
        if (isq) { dst = (bf16*)(p.ws + O_Q); ld = 512; cbase = (nt - 4) * 128 + wn * 64; } else { dst = (bf16*)(p.ws + O_K); ld = 128; cbase = wn * 64; }
#pragma unroll
        for (int rb = 0; rb < 2; ++rb)
#pragma unroll
            for (int i = 0; i < 16; ++i) {
                const int row = row0 + ACC_ROW(rb, i);
                float v0 = acc[rb][0][i], v1 = acc[rb][1][i];
                float ss = v0 * v0 + v1 * v1;
                ss += __shfl_xor(ss, 1); ss += __shfl_xor(ss, 2); ss += __shfl_xor(ss, 4); ss += __shfl_xor(ss, 8); ss += __shfl_xor(ss, 16);
                const float rstd = rsqrtf(ss * (1.f / 64.f) + 1e-6f);
                v0 = v0 * rstd * g0; v1 = v1 * rstd * g1;
                if (latent) {
                    const float2 cs0 = AT(const float2, rope, (row >> 6) * 16 + (r & 15)), cs1 = AT(const float2, rope, (row & 63) * 16 + (r & 15));
                    const float p0 = __shfl_xor(v0, 16), p1 = __shfl_xor(v1, 16);
                    const float sg = (r & 16) ? 1.f : -1.f;
                    v0 = v0 * cs0.x + sg * p0 * cs0.y;
                    v1 = v1 * cs1.x + sg * p1 * cs1.y;
                }
                AT(bf16, dst, row * ld + cbase + r) = f2bf(v0 * osc);
                AT(bf16, dst, row * ld + cbase + 32 + r) = f2bf(v1 * osc);
                asm volatile("" ::: "memory");
            }
    } else if (nt == 9) {
        bf16* vt = (bf16*)(p.ws + O_VT);
#pragma unroll
        for (int rb = 0; rb < 2; ++rb)
#pragma unroll
            for (int cb = 0; cb < 2; ++cb)
#pragma unroll
                for (int q = 0; q < 4; ++q) {
                    u32x2 pk; pk.x = pk2(acc[rb][cb][4 * q], acc[rb][cb][4 * q + 1]); pk.y = pk2(acc[rb][cb][4 * q + 2], acc[rb][cb][4 * q + 3]);
                    AT(u32x2, vt, (ACC_COL(cb) * NT + row0 + wm * 64 + rb * 32 + 8 * q + 4 * h) >> 2) = pk;
                }
    } else {
        bf16* G = (bf16*)(p.ws + O_BIG);
        const int cbase = (nt - 10) * 128;
#pragma unroll
        for (int rb = 0; rb < 2; ++rb)
#pragma unroll
            for (int cb = 0; cb < 2; ++cb)
#pragma unroll
                for (int i = 0; i < 16; ++i) AT(bf16, G, (row0 + ACC_ROW(rb, i)) * 3072 + cbase + ACC_COL(cb)) = f2bf(sigmoidf_(acc[rb][cb][i]));
    }
}
DI void s1_item(const Params& p, int it, ldsp lds) {
    TID_VARS
    const int g = it & 15, rest = it >> 4, nt = rest & 1, mt = rest >> 1;
    f32x16 acc[2][2]; zero_acc<2>(acc);
    gemm_acc<1, 2>(acc, (const bf16*)(p.ws + O_S) + g * 16, 8192, mt * 128, (const bf16*)(p.ws + O_W1S) + (unsigned)g * 256 * 512, 512, nt * 128, 512, lds);
    float* E = (float*)(p.ws + O_E);
#pragma unroll
    for (int rb = 0; rb < 2; ++rb)
#pragma unroll
        for (int cb = 0; cb < 2; ++cb)
#pragma unroll
            for (int i = 0; i < 16; ++i) {
                const int c = mt * 128 + ACC_ROW(rb, i);
                if (c < NCH) AT(float, E, (c * 16 + g) * 256 + nt * 128 + ACC_COL(cb)) = acc[rb][cb][i];
            }
}
DI void s2_item(const Params& p, int it) {
    const int sidx = it * 256 + threadIdx.x;
    const int g = sidx >> 7, dir = (sidx >> 6) & 1, pp = sidx & 63;
    const float2 aT = ((const float2*)(p.ws + O_PW))[(unsigned)((dir * 16 + g) * 64 + pp) * 33 + 32];
    const float* E = (const float*)(p.ws + O_E) + g * 256 + dir * 128 + pp;
    bf16* C = (bf16*)(p.ws + O_CARRY) + g * 256 + dir * 128 + pp;
    float cr = 0.f, ci = 0.f;
#pragma unroll 8
    for (int n = 0; n < NCH; ++n) {
        int c;
        if (dir == 0) c = (n < 8) ? 512 + n : n - 8;
        else c = (n < 8) ? 519 - n : 519 - n;
        const float er = E[(unsigned)c * 4096], ei = E[(unsigned)c * 4096 + 64];
        C[(unsigned)c * 4096] = f2bf(cr); C[(unsigned)c * 4096 + 64] = f2bf(ci);
        const float nr = aT.x * cr - aT.y * ci + er, ni = aT.x * ci + aT.y * cr + ei;
        cr = nr; ci = ni;
    }
}
DI float gelu_tanh(float x) { const float u = 0.7978845608028654f * (x + 0.044715f * x * x * x); return x * sigmoidf_(2.f * u); }
DI void s3_item(const Params& p, int it, ldsp lds) {
    TID_VARS
    const int g = it & 15, rest = it >> 4, nt = rest & 3, mt = rest >> 2;
    f32x16 acc[2][2]; zero_acc<2>(acc);
    gemm_acc<1, 2>(acc, (const bf16*)(p.ws + O_S) + g * 16, 8192, mt * 128, (const bf16*)(p.ws + O_TOEP) + (unsigned)g * 512 * 512, 512, nt * 128, 512, lds);
    gemm_acc<0, 2>(acc, (const bf16*)(p.ws + O_CARRY) + g * 256, 4096, mt * 128, (const bf16*)(p.ws + O_W3S) + (unsigned)g * 512 * 256, 256, nt * 128, 256, lds);
    bf16* Ys = (bf16*)(p.ws + O_YS);
#pragma unroll
    for (int rb = 0; rb < 2; ++rb)
#pragma unroll
        for (int cb = 0; cb < 2; ++cb)
#pragma unroll
            for (int i = 0; i < 16; ++i) {
                const int c = mt * 128 + ACC_ROW(rb, i);
                const int n = nt * 128 + ACC_COL(cb), j = n >> 4, hh = n & 15;
                if (c < NCH) AT(bf16, Ys, (c * 32 + j) * 256 + g * 16 + hh) = f2bf(gelu_tanh(acc[rb][cb][i]));
            }
}
DI void pool_item(const Params& p, int it) {
    const int tid = threadIdx.x, cv = tid & 31, rg = tid >> 5;
    const bf16* A = (const bf16*)(p.ws + O_A);
    bf16* Y = (bf16*)(p.ws + O_YP);
    const int half = 1 << (cv >> 3);
#pragma unroll 1
    for (int i = 0; i < 4; ++i) {
        const int row = it * 32 + rg + 8 * i;
        const int base = row >= NL ? NL : 0, n = row >= NL ? NC : NL, t = row - base;
        const int lo = max(t - half, 0), hi = min(t + half, n);
        float s[8];
#pragma unroll
        for (int e = 0; e < 8; ++e) s[e] = 0.f;
        for (int u = lo; u < hi; ++u) {
            const u32x4 v = *(const u32x4*)(A + (unsigned)(base + u) * 256 + cv * 8);
            s[0] += bflo(v.x); s[1] += bfhi(v.x); s[2] += bflo(v.y); s[3] += bfhi(v.y); s[4] += bflo(v.z); s[5] += bfhi(v.z); s[6] += bflo(v.w); s[7] += bfhi(v.w);
        }
        const u32x4 v = *(const u32x4*)(A + (unsigned)row * 256 + cv * 8);
        const float inv = 1.f / (float)(hi - lo);
        u32x4 o;
        o.x = pk2(s[0] * inv - bflo(v.x), s[1] * inv - bfhi(v.x)); o.y = pk2(s[2] * inv - bflo(v.y), s[3] * inv - bfhi(v.y));
        o.z = pk2(s[4] * inv - bflo(v.z), s[5] * inv - bfhi(v.z)); o.w = pk2(s[6] * inv - bflo(v.w), s[7] * inv - bfhi(v.w));
        *(u32x4*)(Y + (unsigned)row * 256 + cv * 8) = o;
    }
}
DI int sig_perm(int r) { return (r & 0x13) | ((r & 4) << 1) | ((r & 8) >> 1); }
DI void attn_item(const Params& p, int qb, int head, ldsp lds) {
    TID_VARS
    const int kvh = head >> 2;
    bf16* Q = (bf16*)(p.ws + O_Q);
    const bf16* Kp = (const bf16*)(p.ws + O_K) + kvh * 64;
    const bf16* Vp = (const bf16*)(p.ws + O_VT) + (unsigned)kvh * 64 * NT;
    const int q0 = qb * 128 + w * 32;
    bf16x8 qf[4];
#pragma unroll
    for (int s = 0; s < 4; ++s) qf[s] = *(const bf16x8*)(Q + (unsigned)(q0 + r) * 512 + head * 64 + 16 * s + 8 * h);
    const int key0 = qb < 128 ? 0 : NL, ntile = qb < 128 ? NT / 64 : NC / 64;
    const int lrow = tid >> 3, lv = tid & 7;
    const bf16* kg = Kp + (unsigned)(key0 + lrow) * 128 + lv * 8;
    const bf16* vg = Vp + (unsigned)lrow * NT + key0 + lv * 8;
    u32x4 rk[2], rv[2];
#pragma unroll
    for (int i = 0; i < 2; ++i) { rk[i] = *(const u32x4*)(kg + (unsigned)i * 32 * 128); rv[i] = *(const u32x4*)(vg + (unsigned)i * 32 * NT); }
    ldsp wr = lds + lrow * LROW + lv * 16;
#pragma unroll
    for (int i = 0; i < 2; ++i) { *(LAS u32x4*)(wr + i * 32 * LROW) = rk[i]; *(LAS u32x4*)(wr + 9216 + i * 32 * LROW) = rv[i]; }
    __syncthreads();
    f32x16 o0, o1;
#pragma unroll
    for (int i = 0; i < 16; ++i) { o0[i] = 0.f; o1[i] = 0.f; }
    float m = -1e30f, lsum = 0.f;
    const float L2E = 1.4426950408889634f;
    cldsp lk = lds + sig_perm(r) * LROW + h * 16;
    cldsp lvv = lds + 9216 + r * LROW + h * 16;
    for (int t = 0; t < ntile; ++t) {
        const int buf = t & 1;
        const bool more = t + 1 < ntile;
        if (more) {
            kg += 64 * 128; vg += 64;
#pragma unroll
            for (int i = 0; i < 2; ++i) { rk[i] = *(const u32x4*)(kg + (unsigned)i * 32 * 128); rv[i] = *(const u32x4*)(vg + (unsigned)i * 32 * NT); }
        }
        cldsp pk = lk + buf * 18432; cldsp pv = lvv + buf * 18432;
        f32x16 s0, s1;
#pragma unroll
        for (int i = 0; i < 16; ++i) { s0[i] = 0.f; s1[i] = 0.f; }
#pragma unroll
        for (int s = 0; s < 4; ++s) {
            const bf16x8 k0 = *(const LAS bf16x8*)(pk + s * 32), k1 = *(const LAS bf16x8*)(pk + 32 * LROW + s * 32);
            s0 = MFMA(k0, qf[s], s0); s1 = MFMA(k1, qf[s], s1);
        }
        float mx = s0[0];
#pragma unroll
        for (int i = 1; i < 16; ++i) mx = fmaxf(mx, s0[i]);
#pragma unroll
        for (int i = 0; i < 16; ++i) mx = fmaxf(mx, s1[i]);
        mx = fmaxf(mx, __shfl_xor(mx, 32));
        const float mnew = fmaxf(m, mx);
        const float alpha = __builtin_amdgcn_exp2f((m - mnew) * L2E);
        m = mnew;
        const float mb = mnew * L2E;
        float rs = 0.f;
#pragma unroll
        for (int i = 0; i < 16; ++i) { s0[i] = __builtin_amdgcn_exp2f(s0[i] * L2E - mb); rs += s0[i]; }
#pragma unroll
        for (int i = 0; i < 16; ++i) { s1[i] = __builtin_amdgcn_exp2f(s1[i] * L2E - mb); rs += s1[i]; }
        lsum = lsum * alpha + rs;
#pragma unroll
        for (int i = 0; i < 16; ++i) { o0[i] *= alpha; o1[i] *= alpha; }
#pragma unroll
        for (int kb = 0; kb < 2; ++kb)
#pragma unroll
            for (int s = 0; s < 2; ++s) {
                u32x4 pp;
                if (kb == 0) { pp.x = pk2(s0[8 * s], s0[8 * s + 1]); pp.y = pk2(s0[8 * s + 2], s0[8 * s + 3]); pp.z = pk2(s0[8 * s + 4], s0[8 * s + 5]); pp.w = pk2(s0[8 * s + 6], s0[8 * s + 7]); }
                else         { pp.x = pk2(s1[8 * s], s1[8 * s + 1]); pp.y = pk2(s1[8 * s + 2], s1[8 * s + 3]); pp.z = pk2(s1[8 * s + 4], s1[8 * s + 5]); pp.w = pk2(s1[8 * s + 6], s1[8 * s + 7]); }
                const bf16x8 pf = __builtin_bit_cast(bf16x8, pp);
                const bf16x8 v0 = *(const LAS bf16x8*)(pv + (kb * 32 + 16 * s) * 2), v1 = *(const LAS bf16x8*)(pv + 32 * LROW + (kb * 32 + 16 * s) * 2);
                o0 = MFMA(v0, pf, o0); o1 = MFMA(v1, pf, o1);
            }
        if (more) {
            ldsp w2 = wr + (buf ^ 1) * 18432;
#pragma unroll
            for (int i = 0; i < 2; ++i) { *(LAS u32x4*)(w2 + i * 32 * LROW) = rk[i]; *(LAS u32x4*)(w2 + 9216 + i * 32 * LROW) = rv[i]; }
        }
        __syncthreads();
    }
    lsum += __shfl_xor(lsum, 32);
    const float inv = 1.f / lsum;
    bf16* orow = Q + (unsigned)(q0 + r) * 512 + head * 64;
#pragma unroll
    for (int q = 0; q < 4; ++q) {
        u32x2 a, b;
        a.x = pk2(o0[4 * q] * inv, o0[4 * q + 1] * inv); a.y = pk2(o0[4 * q + 2] * inv, o0[4 * q + 3] * inv);
        b.x = pk2(o1[4 * q] * inv, o1[4 * q + 1] * inv); b.y = pk2(o1[4 * q + 2] * inv, o1[4 * q + 3] * inv);
        *(u32x2*)(orow + 8 * q + 4 * h) = a;
        *(u32x2*)(orow + 32 + 8 * q + 4 * h) = b;
    }
}
DI void mix1_item(const Params& p, int it, ldsp lds) {
    TID_VARS
    const int nt = it & 15, mt = it >> 4;
    const bf16* G = (const bf16*)(p.ws + O_BIG);
    const int row0 = mt * 128, col = nt * 64 + wn * 32 + r;
    f32x16 acc[2][1];
    f32x16 mx[2];
    zero_acc<1>(acc);
    gemm_acc<0, 1>(acc, (const bf16*)(p.ws + O_YS), 256, row0, (const bf16*)(p.ws + O_WGLU), 256, 1024 + nt * 64, 256, lds);
#pragma unroll
    for (int rb = 0; rb < 2; ++rb)
#pragma unroll
        for (int i = 0; i < 16; ++i) mx[rb][i] = sigmoidf_(acc[rb][0][i]) * bf2f(AT(const bf16, G, (row0 + ACC_ROW(rb, i)) * 3072 + 1024 + col));
    zero_acc<1>(acc);
    gemm_acc<0, 1>(acc, (const bf16*)(p.ws + O_YS), 256, row0, (const bf16*)(p.ws + O_WGLU), 256, nt * 64, 256, lds);
#pragma unroll
    for (int rb = 0; rb < 2; ++rb)
#pragma unroll
        for (int i = 0; i < 16; ++i) mx[rb][i] *= acc[rb][0][i];
    zero_acc<1>(acc);
    gemm_acc<0, 1>(acc, (const bf16*)(p.ws + O_YP), 256, row0, (const bf16*)(p.ws + O_WP), 256, nt * 64, 256, lds);
#pragma unroll
    for (int rb = 0; rb < 2; ++rb)
#pragma unroll
        for (int i = 0; i < 16; ++i) mx[rb][i] += acc[rb][0][i] * bf2f(AT(const bf16, G, (row0 + ACC_ROW(rb, i)) * 3072 + col));
    zero_acc<1>(acc);
    gemm_acc<0, 1>(acc, (const bf16*)(p.ws + O_Q), 512, row0, (const bf16*)(p.ws + O_WAO), 512, nt * 64, 512, lds);
    bf16* M = (bf16*)(p.ws + O_H);
#pragma unroll
    for (int rb = 0; rb < 2; ++rb)
#pragma unroll
        for (int i = 0; i < 16; ++i) {
            const int row = row0 + ACC_ROW(rb, i);
            const float v = mx[rb][i] + acc[rb][0][i] * bf2f(AT(const bf16, G, row * 3072 + 2048 + col));
            AT(bf16, M, row * D + col) = f2bf(v);
        }
}

DI void conv_tile(const float* src, bf16* dst, int K, int N, int permmode, int tile, ldsp lds) {
    const int tid = threadIdx.x;
    const int ntn = N / 64, tk = tile / ntn, tn = tile % ntn;
    LAS float* L = (LAS float*)lds;
#pragma unroll
    for (int i = 0; i < 4; ++i) {
        const int kk = (tid >> 4) + 16 * i, c4 = (tid & 15) * 4;
        const f32x4 v = *(const f32x4*)(src + (size_t)(tk * 64 + kk) * N + tn * 64 + c4);
        L[kk * 65 + c4] = v[0]; L[kk * 65 + c4 + 1] = v[1]; L[kk * 65 + c4 + 2] = v[2]; L[kk * 65 + c4 + 3] = v[3];
    }
    __syncthreads();
    const int n = tid >> 2, ks = (tid & 3) * 16;
    int nn = tn * 64 + n;
    if (permmode == 1) { const int half = N >> 1, b = nn >= half, hc = b ? nn - half : nn; nn = 128 * (hc >> 6) + 64 * ((hc >> 5) & 1) + 32 * b + (hc & 31); }
    u32x4 o0, o1;
    o0.x = pk2(L[(ks + 0) * 65 + n], L[(ks + 1) * 65 + n]); o0.y = pk2(L[(ks + 2) * 65 + n], L[(ks + 3) * 65 + n]);
    o0.z = pk2(L[(ks + 4) * 65 + n], L[(ks + 5) * 65 + n]); o0.w = pk2(L[(ks + 6) * 65 + n], L[(ks + 7) * 65 + n]);
    o1.x = pk2(L[(ks + 8) * 65 + n], L[(ks + 9) * 65 + n]); o1.y = pk2(L[(ks + 10) * 65 + n], L[(ks + 11) * 65 + n]);
    o1.z = pk2(L[(ks + 12) * 65 + n], L[(ks + 13) * 65 + n]); o1.w = pk2(L[(ks + 14) * 65 + n], L[(ks + 15) * 65 + n]);
    bf16* d = dst + (size_t)nn * K + tk * 64 + ks;
    *(u32x4*)d = o0; *(u32x4*)(d + 8) = o1;
    __syncthreads();
}
constexpr int CV0 = 1408, CV1 = 2816, CV2 = 3520, CV3 = 4224, CV4 = 5312, CV5 = 5440, CV6 = 5568, CV_TOTAL = 5824;
DI void conv_item(const Params& p, int l, int it, ldsp lds) {
    if (it < CV0) conv_tile(p.in[I_W13] + (size_t)(l * 2 + 0) * 1024 * 5632, (bf16*)(p.ws + O_W13), 1024, 5632, 1, it, lds);
    else if (it < CV1) conv_tile(p.in[I_W13] + (size_t)(l * 2 + 1) * 1024 * 5632, (bf16*)(p.ws + O_W13) + (size_t)5632 * 1024, 1024, 5632, 1, it - CV0, lds);
    else if (it < CV2) conv_tile(p.in[I_W2] + (size_t)(l * 2 + 0) * 2816 * 1024, (bf16*)(p.ws + O_W2), 2816, 1024, 0, it - CV1, lds);
    else if (it < CV3) conv_tile(p.in[I_W2] + (size_t)(l * 2 + 1) * 2816 * 1024, (bf16*)(p.ws + O_W2) + (size_t)1024 * 2816, 2816, 1024, 0, it - CV2, lds);
    else if (it < CV4) conv_tile(p.in[I_WIN] + (size_t)l * 1024 * INW, (bf16*)(p.ws + O_WIN), 1024, INW, 0, it - CV3, lds);
    else if (it < CV5) conv_tile(p.in[I_GLU] + (size_t)l * 256 * 2048, (bf16*)(p.ws + O_WGLU), 256, 2048, 0, it - CV4, lds);
    else if (it < CV6) conv_tile(p.in[I_AO] + (size_t)l * 512 * 1024, (bf16*)(p.ws + O_WAO), 512, 1024, 0, it - CV5, lds);
    else conv_tile(p.in[I_WO] + (size_t)l * 1024 * 1024, (bf16*)(p.ws + O_WOUT), 1024, 1024, 0, it - CV6, lds);
}
DI void mod_item(const Params& p, int it, ldsp lds) {
    const int tid = threadIdx.x, lane = tid & 63, w = tid >> 6;
    const int c0 = it * 256 + lane * 4, l = c0 / 9216, col = c0 % 9216;
    const float* W = p.in[I_MODW] + (size_t)l * 1024 * 9216 + col;
    f32x4 a0 = {0.f, 0.f, 0.f, 0.f}, a1 = {0.f, 0.f, 0.f, 0.f};
#pragma unroll 8
    for (int k = w * 256; k < w * 256 + 256; ++k) {
        const f32x4 wv = *(const f32x4*)(W + (size_t)k * 9216);
        const float c = p.in[I_C][k], cc = p.in[I_CCTX][k];
        const float s0 = c * sigmoidf_(c), s1 = cc * sigmoidf_(cc);
        a0 += wv * s0; a1 += wv * s1;
    }
    LAS f32x4* L = (LAS f32x4*)lds;
    L[(w * 64 + lane) * 2] = a0; L[(w * 64 + lane) * 2 + 1] = a1;
    __syncthreads();
    if (w == 0) {
        f32x4 b = *(const f32x4*)(p.in[I_MODB] + (size_t)l * 9216 + col);
        f32x4 r0 = b, r1 = b;
#pragma unroll
        for (int q = 0; q < 4; ++q) { r0 += L[(q * 64 + lane) * 2]; r1 += L[(q * 64 + lane) * 2 + 1]; }
        float* M = (float*)(p.ws + O_MODS);
        *(f32x4*)(M + (size_t)(0 * 2 + l) * 9216 + col) = r0;
        *(f32x4*)(M + (size_t)(1 * 2 + l) * 9216 + col) = r1;
    }
    __syncthreads();
}
DI void pw_item(const Params& p, int l, int it) {
    const int idx = it * 256 + threadIdx.x;
    if (idx >= 2048 * 33) return;
    const int st = idx / 33, e = idx % 33;
    const int dg = st >> 6;
    const double are = p.in[I_ARE][(size_t)l * 2048 + st], aim = p.in[I_AIM][(size_t)l * 2048 + st];
    const double dt = dexp((double)p.in[I_LOGDT][l * 32 + dg]);
    const double mag = dexp(are * dt * e);
    double s, c; dsincos(aim * dt * e, s, c);
    ((float2*)(p.ws + O_PW))[idx] = make_float2((float)(mag * c), (float)(mag * s));
    if (e == 1) {
        const double nr = mag * c - 1.0, ni = mag * s, den = are * are + aim * aim;
        ((float2*)(p.ws + O_CF))[st] = make_float2((float)((nr * are + ni * aim) / den), (float)((ni * are - nr * aim) / den));
    }
}
DI void wp_item(const Params& p, int l, int it) {
    const int k = it >> 2, n = (it & 3) * 256 + threadIdx.x, g = k >> 6, c = k & 63;
    const float* pw = p.in[I_POOLW] + (size_t)l * 4 * 64 * 64 + (size_t)(g * 64 + c) * 64;
    const float* ps = p.in[I_POOLS] + l * 256 + g * 64;
    const float* po = p.in[I_POOLO] + (size_t)l * 256 * 1024 + (size_t)(g * 64) * 1024 + n;
    float s = 0.f;
#pragma unroll 8
    for (int d = 0; d < 64; ++d) s += pw[d] * ps[d] * po[(size_t)d * 1024];
    ((bf16*)(p.ws + O_WP))[(size_t)n * 256 + k] = f2bf(s);
}
DI void rope_item(const Params& p, int it) {
    const int idx = it * 256 + threadIdx.x;
    const int pos = idx >> 4, i = idx & 15;
    const double inv = dexp(-(double)i * (9.210340371976184 / 16.0));
    double s, c; dsincos((double)pos * inv, s, c);
    ((float2*)(p.ws + O_ROPE))[idx] = make_float2((float)c, (float)s);
}
DI void ktab_item(const Params& p, int l, int it, ldsp lds) {
    const int tid = threadIdx.x;
    const int lag = it & 31, dg = it >> 5;
    LAS f32x2* Wl = (LAS f32x2*)lds;
    if (tid < 64) {
        const float2 z = ((const float2*)(p.ws + O_PW))[(size_t)(dg * 64 + tid) * 33 + lag], cf = ((const float2*)(p.ws + O_CF))[dg * 64 + tid];
        Wl[tid] = (f32x2){z.x * cf.x - z.y * cf.y, z.x * cf.y + z.y * cf.x};
    }
    __syncthreads();
    const int hp = tid >> 4, hh = tid & 15;
    const size_t pb = (size_t)(l * 32 + dg) * 1024;
    const float* cre = p.in[I_CRE] + pb + hp * 64, *cim = p.in[I_CIM] + pb + hp * 64;
    const float* bre = p.in[I_BRE] + pb + hh, *bim = p.in[I_BIM] + pb + hh;
    float s = 0.f;
#pragma unroll 8
    for (int q = 0; q < 64; ++q) {
        const f32x2 wv = Wl[q];
        const float br = bre[q * 16], bi = bim[q * 16];
        const float tr = wv.x * br - wv.y * bi, ti = wv.x * bi + wv.y * br;
        s += cre[q] * tr - cim[q] * ti;
    }
    ((float*)(p.ws + O_KTAB))[(size_t)it * 256 + tid] = s;
    __syncthreads();
}
DI void w1_item(const Params& p, int l, int it) {
    const int idx = it * 256 + threadIdx.x;
    const int k8 = idx & 63, n = (idx >> 6) & 255, g = idx >> 14;
    const int dir = n >> 7, ri = (n >> 6) & 1, pp = n & 63, j = k8 >> 1, h0 = (k8 & 1) * 8;
    const int e = dir ? j : 31 - j, st = (dir * 16 + g) * 64 + pp;
    const float2 z = ((const float2*)(p.ws + O_PW))[(size_t)st * 33 + e], cf = ((const float2*)(p.ws + O_CF))[st];
    const float wr = z.x * cf.x - z.y * cf.y, wi = z.x * cf.y + z.y * cf.x;
    const float* bre = p.in[I_BRE] + (size_t)(l * 32 + dir * 16 + g) * 1024 + pp * 16 + h0;
    const float* bim = p.in[I_BIM] + (size_t)(l * 32 + dir * 16 + g) * 1024 + pp * 16 + h0;
    float o[8];
#pragma unroll
    for (int q = 0; q < 8; ++q) o[q] = ri ? (wr * bim[q] + wi * bre[q]) : (wr * bre[q] - wi * bim[q]);
    u32x4 v; v.x = pk2(o[0], o[1]); v.y = pk2(o[2], o[3]); v.z = pk2(o[4], o[5]); v.w = pk2(o[6], o[7]);
    *(u32x4*)((bf16*)(p.ws + O_W1S) + ((size_t)g * 256 + n) * 512 + k8 * 8) = v;
}
DI void w3_item(const Params& p, int l, int it) {
    const int idx = it * 256 + threadIdx.x;
    const int k8 = idx & 31, n = (idx >> 5) & 511, g = idx >> 14;
    const int dir = k8 >> 4, ri = (k8 >> 3) & 1, p0 = (k8 & 7) * 8, j = n >> 4, hp = n & 15;
    const int e = dir ? 32 - j : j + 1;
    const float* cre = p.in[I_CRE] + (size_t)(l * 32 + dir * 16 + g) * 1024 + hp * 64 + p0;
    const float* cim = p.in[I_CIM] + (size_t)(l * 32 + dir * 16 + g) * 1024 + hp * 64 + p0;
    const float2* pw = (const float2*)(p.ws + O_PW) + (size_t)((dir * 16 + g) * 64 + p0) * 33 + e;
    float o[8];
#pragma unroll
    for (int q = 0; q < 8; ++q) { const float2 z = pw[q * 33]; o[q] = ri ? -(cre[q] * z.y + cim[q] * z.x) : (cre[q] * z.x - cim[q] * z.y); }
    u32x4 v; v.x = pk2(o[0], o[1]); v.y = pk2(o[2], o[3]); v.z = pk2(o[4], o[5]); v.w = pk2(o[6], o[7]);
    *(u32x4*)((bf16*)(p.ws + O_W3S) + ((size_t)g * 512 + n) * 256 + k8 * 8) = v;
}
DI void toep_item(const Params& p, int l, int it) {
    const int idx = it * 256 + threadIdx.x;
    const int k8 = idx & 63, n = (idx >> 6) & 511, g = idx >> 15;
    const int j2 = k8 >> 1, h0 = (k8 & 1) * 8, j = n >> 4, hp = n & 15;
    const float* KT = (const float*)(p.ws + O_KTAB);
    float o[8];
#pragma unroll
    for (int q = 0; q < 8; ++q) o[q] = 0.f;
    if (j2 <= j) { const float* kf = KT + ((size_t)(0 * 16 + g) * 32 + (j - j2)) * 256 + hp * 16 + h0;
#pragma unroll
        for (int q = 0; q < 8; ++q) o[q] += kf[q]; }
    if (j2 >= j) { const float* kb = KT + ((size_t)(1 * 16 + g) * 32 + (j2 - j)) * 256 + hp * 16 + h0;
#pragma unroll
        for (int q = 0; q < 8; ++q) o[q] += kb[q]; }
    if (j2 == j) {
        const float dd = p.in[I_SD][l * 256 + g * 16 + hp];
#pragma unroll
        for (int q = 0; q < 8; ++q) if (h0 + q == hp) o[q] += dd;
    }
    u32x4 v; v.x = pk2(o[0], o[1]); v.y = pk2(o[2], o[3]); v.z = pk2(o[4], o[5]); v.w = pk2(o[6], o[7]);
    *(u32x4*)((bf16*)(p.ws + O_TOEP) + ((size_t)g * 512 + n) * 512 + k8 * 8) = v;
}

constexpr int PH_PER_LAYER = 14, N_PHASES = 2 * PH_PER_LAYER + 1;
DI void run_phase(const Params& p, const int ph, ldsp lds) {
    const int G = gridDim.x, b = blockIdx.x;
    if (ph == 2 * PH_PER_LAYER) { for (int it = b; it < NL / 4; it += G) final_norm_item(p, it); return; }
    const int l = ph / PH_PER_LAYER, s = ph % PH_PER_LAYER;
    const int mtiles = (l == 1) ? 128 : 130;
#ifdef ONLY_S
    if (s != ONLY_S) return;
#endif
    switch (s) {
    case 0: {
        const int n_mod = (l == 0) ? 72 : 0, n_pw = 264, n_wp = 1024, n_rope = (l == 0) ? 16 : 0;
        int off = 0;
#define SUBLOOP(n, call) { for (int it = ((b - off) % G + G) % G; it < (n); it += G) { call; } off = (off + (n)) % G; }
        SUBLOOP(n_mod, mod_item(p, it, lds))
        SUBLOOP(n_pw, pw_item(p, l, it))
        SUBLOOP(n_wp, wp_item(p, l, it))
        SUBLOOP(n_rope, rope_item(p, it))
        SUBLOOP(CV_TOTAL, conv_item(p, l, it, lds))
    } break;
    case 1: {
        int off = 0;
        SUBLOOP(1024, ktab_item(p, l, it, lds))
        SUBLOOP(1024, w1_item(p, l, it))
        SUBLOOP(1024, w3_item(p, l, it))
        SUBLOOP(NT / 4, norm_item(p, l, 0, it))
    } break;
    case 2: for (int it = b; it < 130 * 44; it += G) ffn_a_item(p, 0, it, lds); break;
    case 3: for (int it = b; it < 130 * 8; it += G) gemm_resid_item(p, (const bf16*)(p.ws + O_BIG), DFF, DFF, (const bf16*)(p.ws + O_W2), l, 2, 0.5f, l == 0, it, lds); break;
    case 4: {
        int off = 0;
        SUBLOOP(2048, toep_item(p, l, it))
        SUBLOOP(NT / 4, norm_item(p, l, 1, it))
    } break;
    case 5: for (int it = b; it < 130 * 34; it += G) inproj_item(p, l, it, lds); break;
    case 6: {
        int off = 0;
        SUBLOOP(160, s1_item(p, it, lds))
        SUBLOOP(mtiles * 4, pool_item(p, it))
        SUBLOOP(((l == 0) ? 16 : 0), attn_item(p, 128 + (it >> 3), it & 7, lds))
    } break;
    case 7: {
        int off = 0;
        SUBLOOP(8, s2_item(p, it))
        SUBLOOP(1024, attn_item(p, it >> 3, it & 7, lds))
    } break;
    case 8: for (int it = b; it < 320; it += G) s3_item(p, it, lds); break;
    case 9: for (int it = b; it < mtiles * 16; it += G) mix1_item(p, it, lds); break;
    case 10: for (int it = b; it < mtiles * 8; it += G) gemm_resid_item(p, (const bf16*)(p.ws + O_H), D, D, (const bf16*)(p.ws + O_WOUT), l, 5, 1.0f, false, it, lds); break;
    case 11: for (int it = b; it < mtiles * 32; it += G) norm_item(p, l, 2, it); break;
    case 12: for (int it = b; it < mtiles * 44; it += G) ffn_a_item(p, 1, it, lds); break;
    case 13: for (int it = b; it < mtiles * 8; it += G) gemm_resid_item(p, (const bf16*)(p.ws + O_BIG), DFF, DFF, (const bf16*)(p.ws + O_W2) + (size_t)1024 * DFF, l, 8, 0.5f, false, it, lds); break;
    }
}

__global__ void __launch_bounds__(256, 2) hybrid_fwd(Params p, int ph_lo, int ph_hi) {
    __shared__ __attribute__((aligned(16))) char lds_raw[LDS_BYTES];
    ldsp lds = (ldsp)lds_raw;
    __shared__ uint4 xb_words;
    if (p.ws == nullptr) cg::this_grid().sync();
    XcdBarrier bar;
    const bool multi = (ph_hi - ph_lo) > 1;
    if (multi) {
        if (threadIdx.x == 0) xb_words = make_uint4(0u, 0u, 0u, 0u);
        __syncthreads();
        bar = xcd_barrier_post((unsigned*)(p.ws + O_BAR), (volatile LAS unsigned*)&xb_words);
    }
#define PH(k) if (ph_lo <= (k) && (k) < ph_hi) { if ((k) > ph_lo) xcd_barrier(bar); run_phase(p, (k), lds); }
    PH(0) PH(1) PH(2) PH(3) PH(4) PH(5) PH(6) PH(7) PH(8) PH(9) PH(10) PH(11) PH(12) PH(13)
    PH(14) PH(15) PH(16) PH(17) PH(18) PH(19) PH(20) PH(21) PH(22) PH(23) PH(24) PH(25) PH(26) PH(27) PH(28)
}

extern "C" void kernel_launch(void* const* d_in, const int* in_sizes, int n_in, void* d_out, int out_size, void* d_ws, size_t ws_size, hipStream_t stream) {
    (void)in_sizes; (void)n_in; (void)out_size;
    if (ws_size < O_END) { fprintf(stderr, "workspace too small: %zu < %zu\n", ws_size, (size_t)O_END); return; }
    static int grid_blocks = 0;
    if (!grid_blocks) {
        int dev = 0, cus = 0, per_cu = 0;
        hipGetDevice(&dev);
        hipDeviceGetAttribute(&cus, hipDeviceAttributeMultiprocessorCount, dev);
        hipOccupancyMaxActiveBlocksPerMultiprocessor(&per_cu, hybrid_fwd, 256, 0);
        if (per_cu > 2) per_cu = 2;
        if (per_cu < 1) per_cu = 1;
        grid_blocks = cus * per_cu;
    }
    Params p{};
    for (int i = 0; i < 27; ++i) p.in[i] = (const float*)d_in[i];
    p.out = (float*)d_out; p.ws = (char*)d_ws;
#if MK_ONE_LAUNCH
    hipMemsetAsync(d_ws, 0, 16384, stream);
    int lo = 0, hi = N_PHASES;
    void* args[] = {&p, &lo, &hi};
    hipError_t e = hipLaunchCooperativeKernel((void*)hybrid_fwd, dim3(grid_blocks), dim3(256), args, 0, stream);
    if (e != hipSuccess) fprintf(stderr, "cooperative launch failed: %s (grid %d)\n", hipGetErrorString(e), grid_blocks);
#else
    for (int ph = 0; ph < N_PHASES; ++ph) hipLaunchKernelGGL(hybrid_fwd, dim3(grid_blocks), dim3(256), 0, stream, p, ph, ph + 1);
#endif
}
```

```cpp
#include <hip/hip_runtime.h>
#include <hip/hip_cooperative_groups.h>
#include <cstdio>
#include <cstdint>
namespace cg = cooperative_groups;

#define DI __device__ __forceinline__
#define LAS __attribute__((address_space(3)))
typedef __attribute__((address_space(3))) char* ldsp;
typedef const __attribute__((address_space(3))) char* cldsp;
typedef unsigned short bf16;
typedef short bf16x8 __attribute__((ext_vector_type(8)));
typedef float f32x16 __attribute__((ext_vector_type(16)));
typedef float f32x4 __attribute__((ext_vector_type(4)));
typedef float f32x2 __attribute__((ext_vector_type(2)));
typedef unsigned u32x4 __attribute__((ext_vector_type(4)));
typedef unsigned u32x2 __attribute__((ext_vector_type(2)));
typedef __bf16 hbf2 __attribute__((ext_vector_type(2)));

#ifndef MK_ONE_LAUNCH
#define MK_ONE_LAUNCH 1
#endif

constexpr int D = 1024, NL = 16384, NC = 256, NT = NL + NC, DFF = 2816, INW = 4352;
constexpr int NCH = NT / 32;

enum { I_X = 0, I_C, I_CTX, I_CCTX, I_MODW, I_MODB, I_NORMG, I_W13, I_W2, I_WIN, I_POOLW, I_POOLS, I_POOLO, I_ARE, I_AIM, I_LOGDT,
       I_BRE, I_BIM, I_CRE, I_CIM, I_SD, I_GLU, I_QG, I_KG, I_AO, I_WO, I_FG };

constexpr size_t al(size_t x) { return (x + 255) & ~(size_t)255; }
constexpr size_t O_BAR = 0;
constexpr size_t O_X = 16384;
constexpr size_t O_H = O_X + al((size_t)NT * D * 4);
constexpr size_t O_BIG = O_H + al((size_t)NT * D * 2);
constexpr size_t O_Q = O_BIG + al((size_t)NT * 3072 * 2);
constexpr size_t O_K = O_Q + al((size_t)NT * 512 * 2);
constexpr size_t O_VT = O_K + al((size_t)NT * 128 * 2);
constexpr size_t O_A = O_VT + al((size_t)NT * 128 * 2);
constexpr size_t O_S = O_A + al((size_t)NT * 256 * 2);
constexpr size_t O_YP = O_S + al((size_t)NT * 256 * 2);
constexpr size_t O_YS = O_YP + al((size_t)NT * 256 * 2);
constexpr size_t O_CARRY = O_YS + al((size_t)NT * 256 * 2);
constexpr size_t O_E = O_CARRY + al((size_t)NCH * 16 * 256 * 2);
constexpr size_t O_W13 = O_E + al((size_t)NCH * 16 * 256 * 4);
constexpr size_t O_W2 = O_W13 + al((size_t)2 * 5632 * 1024 * 2);
constexpr size_t O_WIN = O_W2 + al((size_t)2 * 1024 * 2816 * 2);
constexpr size_t O_WGLU = O_WIN + al((size_t)INW * 1024 * 2);
constexpr size_t O_WAO = O_WGLU + al((size_t)2048 * 256 * 2);
constexpr size_t O_WOUT = O_WAO + al((size_t)1024 * 512 * 2);
constexpr size_t O_WP = O_WOUT + al((size_t)1024 * 1024 * 2);
constexpr size_t O_TOEP = O_WP + al((size_t)1024 * 256 * 2);
constexpr size_t O_W1S = O_TOEP + al((size_t)16 * 512 * 512 * 2);
constexpr size_t O_W3S = O_W1S + al((size_t)16 * 256 * 512 * 2);
constexpr size_t O_KTAB = O_W3S + al((size_t)16 * 512 * 256 * 2);
constexpr size_t O_PW = O_KTAB + al((size_t)2 * 16 * 32 * 256 * 4);
constexpr size_t O_CF = O_PW + al((size_t)2048 * 33 * 8);
constexpr size_t O_MODS = O_CF + al((size_t)2048 * 8);
constexpr size_t O_ROPE = O_MODS + al((size_t)2 * 2 * 9216 * 4);
constexpr size_t O_END = O_ROPE + al((size_t)256 * 16 * 8);

struct Params { const float* in[27]; float* out; char* ws; };

DI unsigned pk2(float a, float b) { f32x2 v = {a, b}; return __builtin_bit_cast(unsigned, __builtin_convertvector(v, hbf2)); }
DI bf16 f2bf(float a) { return (bf16)(pk2(a, 0.f) & 0xffffu); }
DI float bf2f(bf16 b) { return __uint_as_float(((unsigned)b) << 16); }
DI float bflo(unsigned u) { return __uint_as_float(u << 16); }
DI float bfhi(unsigned u) { return __uint_as_float(u & 0xffff0000u); }
DI float sigmoidf_(float x) { return 1.f / (1.f + __expf(-x)); }
DI float wave_sum(float v) {
#pragma unroll
    for (int o = 32; o >= 1; o >>= 1) v += __shfl_xor(v, o);
    return v;
}
#define AT(T, base, idx) (*(T*)((char*)(base) + (unsigned)((unsigned)(idx) * (unsigned)sizeof(T))))
#define MFMA(a, b, c) __builtin_amdgcn_mfma_f32_32x32x16_bf16((a), (b), (c), 0, 0, 0)

DI double dexp(double x) {
    const double n = __builtin_rint(x * 1.4426950408889634);
    const double r = x - n * 0.6931471805599453;
    double t = 1.0;
#pragma unroll
    for (int k = 16; k >= 1; --k) t = 1.0 + t * r * (1.0 / (double)k);
    const long long e = (long long)n + 1023;
    return t * __longlong_as_double(e << 52);
}
DI void dsincos(double th, double& s, double& c) {
    const double k = __builtin_rint(th * 0.15915494309189535);
    const double x = th - k * 6.283185307179586 - k * 2.4492935982947064e-16;
    const double x2 = x * x;
    double cs = 1.0, sn = 1.0;
#pragma unroll
    for (int j = 17; j >= 1; --j) {
        cs = 1.0 - cs * x2 * (1.0 / (double)((2 * j - 1) * (2 * j)));
        sn = 1.0 - sn * x2 * (1.0 / (double)((2 * j) * (2 * j + 1)));
    }
    c = cs; s = sn * x;
}

#define XB_TMO      128
#define XB_XCNT(j)  (256  + 64 * (j))
#define XB_XSUB(j)  (1280 + 64 * (j))
#define XB_XGEN(j)  (2304 + 64 * (j))
#define XB_TOP      3328
#define XB_TOPGEN   3392
#define XCD_BAR_WORDS 3456
#define XB_SPIN_CAP (1u << 22)
DI unsigned xb_ld(unsigned* p)              { return __hip_atomic_load(p, __ATOMIC_RELAXED, __HIP_MEMORY_SCOPE_AGENT); }
DI unsigned xb_add(unsigned* p, unsigned v) { return __hip_atomic_fetch_add(p, v, __ATOMIC_RELAXED, __HIP_MEMORY_SCOPE_AGENT); }
DI unsigned xb_xcc_id() { return (unsigned)__builtin_amdgcn_s_getreg((3 << 11) | 20) & 0xFu; }
#define XB_SPIN(cond, bar) do { unsigned _sp = 0; while (cond) { __builtin_amdgcn_s_sleep(1); \
    if ((++_sp & 255u) == 0u) { if (xb_ld(&(bar)[XB_TMO])) break; if (_sp > XB_SPIN_CAP) { atomicAdd(&(bar)[XB_TMO], 1u); break; } } } } while (0)
struct XcdBarrier { unsigned* bar; unsigned x; volatile LAS unsigned* st; };
DI XcdBarrier xcd_barrier_post(unsigned* bar, volatile LAS unsigned* st) {
    XcdBarrier b; b.bar = bar; b.x = xb_xcc_id(); b.st = st;
    if (threadIdx.x == 0) (void)xb_add(&bar[XB_XCNT(b.x)], 1u);
    return b;
}
DI void xcd_barrier_complete(unsigned* bar, unsigned x, unsigned& nloc, unsigned& nx) {
    const unsigned G = gridDim.x * gridDim.y * gridDim.z;
    unsigned sum, cnt, mine, sp = 0u;
    for (;;) {
        sum = 0u; cnt = 0u; mine = 0u;
#pragma unroll
        for (unsigned j = 0; j < 16; ++j) { const unsigned c = xb_ld(&bar[XB_XCNT(j)]); sum += c; cnt += (c > 0u) ? 1u : 0u; mine = (j == x) ? c : mine; }
        if (sum == G) break;
        __builtin_amdgcn_s_sleep(1);
        if ((++sp & 255u) == 0u) { if (xb_ld(&bar[XB_TMO])) break; if (sp > XB_SPIN_CAP) { atomicAdd(&bar[XB_TMO], 1u); break; } }
    }
    nloc = mine > 0u ? mine : 1u; nx = cnt > 0u ? cnt : 1u;
}
DI void xcd_barrier(const XcdBarrier& b) {
    asm volatile("s_waitcnt vmcnt(0)" ::: "memory");
    __syncthreads();
    if (threadIdx.x == 0) {
        unsigned* bar = b.bar;
        __builtin_amdgcn_s_waitcnt(0);
        unsigned nloc = b.st[0], nx = b.st[1];
        if (nloc == 0u) { xcd_barrier_complete(bar, b.x, nloc, nx); b.st[0] = nloc; b.st[1] = nx; }
        const unsigned old = xb_add(&bar[XB_XSUB(b.x)], 1u);
        const unsigned gen = old / nloc;
        if (old + 1u == (gen + 1u) * nloc) {
            __builtin_amdgcn_fence(__ATOMIC_RELEASE, "agent");
            asm volatile("s_waitcnt vmcnt(0)" ::: "memory");
            const unsigned og = xb_add(&bar[XB_TOP], 1u);
            const unsigned tg = og / nx;
            if (og + 1u == (tg + 1u) * nx) xb_add(&bar[XB_TOPGEN], 1u);
            else XB_SPIN(xb_ld(&bar[XB_TOPGEN]) == tg, bar);
            __builtin_amdgcn_fence(__ATOMIC_ACQUIRE, "agent");
            xb_add(&bar[XB_XGEN(b.x)], 1u);
            asm volatile("s_waitcnt vmcnt(0)" ::: "memory");
        } else {
            XB_SPIN(xb_ld(&bar[XB_XGEN(b.x)]) == gen, bar);
            __builtin_amdgcn_fence(__ATOMIC_ACQUIRE, "agent");
            asm volatile("s_waitcnt vmcnt(0)" ::: "memory");
        }
    }
    __syncthreads();
}

constexpr int LROW = 144;
constexpr int LTILE = 256 * LROW;
constexpr int LSTAGE = 2 * LTILE;
constexpr int LDS_BYTES = 2 * LSTAGE;

template <int AMODE, int NRB, int NCB>
DI void gemm_acc(f32x16 (&acc)[NRB][NCB], const bf16* __restrict__ A, const long lda, const int arow0,
                 const bf16* __restrict__ Bt, const long ldb, const int brow0, const int K, ldsp lds) {
    int tid_ = threadIdx.x; asm volatile("" : "+v"(tid_));
    const int tid = tid_, lane = tid & 63, w = tid >> 6, wm = w >> 2, wn = w & 3, r = lane & 31, h = lane >> 5;
    const int v = tid & 7, lr = tid >> 3;
    const int avoff = AMODE ? ((v >> 1) * 256 + (v & 1) * 8) : v * 8;
    const int akstep = AMODE ? 1024 : 64;
    const bf16* ag = A + (long)(arow0 + lr) * lda + avoff;
    const bf16* bg = Bt + (long)(brow0 + lr) * ldb + v * 8;
    const int nk = K >> 6;
    u32x4 ra[NRB], rb[2 * NCB];
#pragma unroll
    for (int i = 0; i < NRB; ++i) ra[i] = *(const u32x4*)(ag + (long)i * 64 * lda);
#pragma unroll
    for (int i = 0; i < 2 * NCB; ++i) rb[i] = *(const u32x4*)(bg + (long)i * 64 * ldb);
    ldsp wr = lds + lr * LROW + v * 16;
#pragma unroll
    for (int i = 0; i < NRB; ++i) *(LAS u32x4*)(wr + i * 64 * LROW) = ra[i];
#pragma unroll
    for (int i = 0; i < 2 * NCB; ++i) *(LAS u32x4*)(wr + LTILE + i * 64 * LROW) = rb[i];
    __syncthreads();
    cldsp la = lds + (wm * 32 * NRB + r) * LROW + h * 16;
    cldsp lb = lds + LTILE + (wn * 32 * NCB + r) * LROW + h * 16;
    for (int kt = 0; kt < nk; ++kt) {
        const int buf = kt & 1;
        const bool more = (kt + 1 < nk);
        if (more) {
            ag += akstep; bg += 64;
#pragma unroll
            for (int i = 0; i < NRB; ++i) ra[i] = *(const u32x4*)(ag + (long)i * 64 * lda);
#pragma unroll
            for (int i = 0; i < 2 * NCB; ++i) rb[i] = *(const u32x4*)(bg + (long)i * 64 * ldb);
        }
        cldsp pa = la + buf * LSTAGE; cldsp pb = lb + buf * LSTAGE;
#pragma unroll
        for (int s = 0; s < 4; ++s) {
            bf16x8 af[NRB], bfr[NCB];
#pragma unroll
            for (int rb_ = 0; rb_ < NRB; ++rb_) af[rb_] = *(const LAS bf16x8*)(pa + rb_ * 32 * LROW + s * 32);
#pragma unroll
            for (int cb = 0; cb < NCB; ++cb) bfr[cb] = *(const LAS bf16x8*)(pb + cb * 32 * LROW + s * 32);
#pragma unroll
            for (int rb_ = 0; rb_ < NRB; ++rb_)
#pragma unroll
                for (int cb = 0; cb < NCB; ++cb) acc[rb_][cb] = MFMA(af[rb_], bfr[cb], acc[rb_][cb]);
        }
        if (more) {
            ldsp w2 = wr + (buf ^ 1) * LSTAGE;
#pragma unroll
            for (int i = 0; i < NRB; ++i) *(LAS u32x4*)(w2 + i * 64 * LROW) = ra[i];
#pragma unroll
            for (int i = 0; i < 2 * NCB; ++i) *(LAS u32x4*)(w2 + LTILE + i * 64 * LROW) = rb[i];
        }
        __syncthreads();
    }
}
template <int NRB, int NCB>
DI void zero_acc(f32x16 (&acc)[NRB][NCB]) {
#pragma unroll
    for (int a = 0; a < NRB; ++a)
#pragma unroll
        for (int b = 0; b < NCB; ++b)
#pragma unroll
            for (int i = 0; i < 16; ++i) acc[a][b][i] = 0.f;
}
#define ACC_ROW(rb, i) (wm * 128 + (rb) * 32 + ((i) & 3) + 8 * ((i) >> 2) + 4 * h)
#define ACC_COL(cb) (wn * 64 + (cb) * 32 + r)
#define TID_VARS int tid_ = threadIdx.x; asm volatile("" : "+v"(tid_)); const int tid = tid_, lane = tid & 63, w = tid >> 6, wm = w >> 2, wn = w & 3, r = lane & 31, h = lane >> 5; (void)wm; (void)wn; (void)r; (void)h; (void)lane; (void)w;

DI const float* mods_ptr(const Params& p, int cond, int l, int j) { return (const float*)(p.ws + O_MODS) + ((size_t)(cond * 2 + l) * 9 + j) * 1024; }

DI void ffn_a_item(const Params& p, int f, int it, ldsp lds) {
    TID_VARS
    const int nt = it % 22, mt = it / 22;
    f32x16 acc[4][2]; zero_acc<4, 2>(acc);
    gemm_acc<0, 4, 2>(acc, (const bf16*)(p.ws + O_H), 1024, mt * 256, (const bf16*)(p.ws + O_W13) + (unsigned)f * 5632 * 1024, 1024, nt * 256, 1024, lds);
    bf16* hid = (bf16*)(p.ws + O_BIG);
    const int col = nt * 128 + wn * 32 + r;
#pragma unroll
    for (int rb = 0; rb < 4; ++rb)
#pragma unroll
        for (int i = 0; i < 16; ++i) {
            const float g = acc[rb][0][i], u = acc[rb][1][i];
            const int row = mt * 256 + ACC_ROW(rb, i);
            AT(bf16, hid, row * DFF + col) = f2bf(g * sigmoidf_(g) * u);
        }
}
DI void gemm_resid_item(const Params& p, const bf16* A, int lda, const bf16* Bt, int mt, int nt, int k0, int klen, int l, int gate_j, float scale, bool resid_in, bool atomic, ldsp lds) {
    TID_VARS
    f32x16 acc[4][2]; zero_acc<4, 2>(acc);
    gemm_acc<0, 4, 2>(acc, A + k0, lda, mt * 256, Bt + k0, lda, nt * 256, klen, lds);
    const int cond = (mt >= 64) ? 1 : 0;
    const float* gate = mods_ptr(p, cond, l, gate_j);
    float* X = (float*)(p.ws + O_X);
#pragma unroll
    for (int cb = 0; cb < 2; ++cb) {
        const int col = nt * 256 + ACC_COL(cb);
        const float gs = gate[col] * scale;
#pragma unroll
        for (int rb = 0; rb < 4; ++rb)
#pragma unroll
            for (int i = 0; i < 16; ++i) {
                const int row = mt * 256 + ACC_ROW(rb, i);
                if (atomic) {
                    atomicAdd(&AT(float, X, row * D + col), gs * acc[rb][cb][i]);
                } else {
                    float rs;
                    if (resid_in) rs = AT(const float, p.in[I_X], row * D + col);
                    else rs = AT(float, X, row * D + col);
                    AT(float, X, row * D + col) = rs + gs * acc[rb][cb][i];
                }
                if ((i & 7) == 7) asm volatile("" ::: "memory");
            }
    }
}
DI void norm_item(const Params& p, int l, int which, int it) {
    const int tid = threadIdx.x, lane = tid & 63, w = tid >> 6;
    const int row = it * 8 + w;
    const int cond = row >= NL;
    const bool from_in = (l == 0 && which == 0);
    const float* src = from_in ? (cond ? p.in[I_CTX] + (size_t)(row - NL) * D : p.in[I_X] + (size_t)row * D) : (const float*)(p.ws + O_X) + (size_t)row * D;
    f32x4 x[4]; float ss = 0.f;
#pragma unroll
    for (int j = 0; j < 4; ++j) { x[j] = *(const f32x4*)(src + lane * 4 + 256 * j); ss += x[j][0] * x[j][0] + x[j][1] * x[j][1] + x[j][2] * x[j][2] + x[j][3] * x[j][3]; }
    if (from_in && cond) {
        float* xr = (float*)(p.ws + O_X) + (size_t)row * D;
#pragma unroll
        for (int j = 0; j < 4; ++j) *(f32x4*)(xr + lane * 4 + 256 * j) = x[j];
    }
    ss = wave_sum(ss);
    const float rstd = rsqrtf(ss * (1.f / 1024.f) + 1e-6f);
    const float* g = p.in[I_NORMG] + (size_t)(l * 3 + which) * D;
    const float* sh = mods_ptr(p, cond, l, 3 * which), *sc = mods_ptr(p, cond, l, 3 * which + 1);
    bf16* H = (bf16*)(p.ws + O_H) + (size_t)row * D;
#pragma unroll
    for (int j = 0; j < 4; ++j) {
        const int c = lane * 4 + 256 * j;
        const f32x4 gv = *(const f32x4*)(g + c), sv = *(const f32x4*)(sh + c), cv = *(const f32x4*)(sc + c);
        float o[4];
#pragma unroll
        for (int e = 0; e < 4; ++e) o[e] = x[j][e] * rstd * gv[e] * (1.f + cv[e]) + sv[e];
        u32x2 pk; pk.x = pk2(o[0], o[1]); pk.y = pk2(o[2], o[3]);
        *(u32x2*)(H + c) = pk;
    }
}
DI void final_norm_item(const Params& p, int it) {
    const int tid = threadIdx.x, lane = tid & 63, w = tid >> 6;
    const int row = it * 8 + w;
    const float* src = (const float*)(p.ws + O_X) + (size_t)row * D;
    f32x4 x[4]; float ss = 0.f;
#pragma unroll
    for (int j = 0; j < 4; ++j) { x[j] = *(const f32x4*)(src + lane * 4 + 256 * j); ss += x[j][0] * x[j][0] + x[j][1] * x[j][1] + x[j][2] * x[j][2] + x[j][3] * x[j][3]; }
    ss = wave_sum(ss);
    const float rstd = rsqrtf(ss * (1.f / 1024.f) + 1e-6f);
    const float* g = p.in[I_FG];
#pragma unroll
    for (int j = 0; j < 4; ++j) {
        const int c = lane * 4 + 256 * j;
        const f32x4 gv = *(const f32x4*)(g + c);
        f32x4 o;
#pragma unroll
        for (int e = 0; e < 4; ++e) o[e] = x[j][e] * rstd * gv[e];
        *(f32x4*)(p.out + (size_t)row * D + c) = o;
    }
}
DI void inproj_item(const Params& p, int l, int it, ldsp lds) {
    TID_VARS
    const int nt = it % 17, mt = it / 17;
    f32x16 acc[4][2]; zero_acc<4, 2>(acc);
    gemm_acc<0, 4, 2>(acc, (const bf16*)(p.ws + O_H), 1024, mt * 256, (const bf16*)(p.ws + O_WIN), 1024, nt * 256, 1024, lds);
    const int row0 = mt * 256;
    if (nt < 2) {
        bf16* dst = (bf16*)(p.ws + (nt == 0 ? O_A : O_S));
#pragma unroll
        for (int rb = 0; rb < 4; ++rb)
#pragma unroll
            for (int cb = 0; cb < 2; ++cb)
#pragma unroll
                for (int i = 0; i < 16; ++i) AT(bf16, dst, (row0 + ACC_ROW(rb, i)) * 256 + ACC_COL(cb)) = f2bf(acc[rb][cb][i]);
    } else if (nt < 4 || (nt == 4 && wn < 2)) {
        const bool isq = nt < 4;
        const float* gv = p.in[isq ? I_QG : I_KG] + l * 64;
        const float g0 = gv[r], g1 = gv[32 + r];
        const float2* rope = (const float2*)(p.ws + O_ROPE);
        const bool latent = mt < 64;
        const float osc = isq ? 0.125f : 1.f;
        bf16* dst; int ld, cbase;
        if (isq) { dst = (bf16*)(p.ws + O_Q); ld = 512; cbase = (nt - 2) * 256 + wn * 64; } else { dst = (bf16*)(p.ws + O_K); ld = 128; cbase = wn * 64; }
#pragma unroll
        for (int rb = 0; rb < 4; ++rb)
#pragma unroll
            for (int i = 0; i < 16; ++i) {
                const int row = row0 + ACC_ROW(rb, i);
                float v0 = acc[rb][0][i], v1 = acc[rb][1][i];
                float ss = v0 * v0 + v1 * v1;
                ss += __shfl_xor(ss, 1); ss += __shfl_xor(ss, 2); ss += __shfl_xor(ss, 4); ss += __shfl_xor(ss, 8); ss += __shfl_xor(ss, 16);
                const float rstd = rsqrtf(ss * (1.f / 64.f) + 1e-6f);
                v0 = v0 * rstd * g0; v1 = v1 * rstd * g1;
                if (latent) {
                    const float2 cs0 = AT(const float2, rope, (row >> 6) * 16 + (r & 15)), cs1 = AT(const float2, rope, (row & 63) * 16 + (r & 15));
                    const float p0 = __shfl_xor(v0, 16), p1 = __shfl_xor(v1, 16);
                    const float sg = (r & 16) ? 1.f : -1.f;
                    v0 = v0 * cs0.x + sg * p0 * cs0.y;
                    v1 = v1 * cs1.x + sg * p1 * cs1.y;
                }
                AT(bf16, dst, row * ld + cbase + r) = f2bf(v0 * osc);
                AT(bf16, dst, row * ld + cbase + 32 + r) = f2bf(v1 * osc);
                asm volatile("" ::: "memory");
            }
    } else if (nt == 4) {
        bf16* vt = (bf16*)(p.ws + O_VT);
#pragma unroll
        for (int rb = 0; rb < 4; ++rb)
#pragma unroll
            for (int cb = 0; cb < 2; ++cb)
#pragma unroll
                for (int q = 0; q < 4; ++q) {
                    u32x2 pk; pk.x = pk2(acc[rb][cb][4 * q], acc[rb][cb][4 * q + 1]); pk.y = pk2(acc[rb][cb][4 * q + 2], acc[rb][cb][4 * q + 3]);
                    AT(u32x2, vt, (((wn - 2) * 64 + cb * 32 + r) * NT + row0 + wm * 128 + rb * 32 + 8 * q + 4 * h) >> 2) = pk;
                }
    } else {
        bf16* G = (bf16*)(p.ws + O_BIG);
        const int cbase = (nt - 5) * 256;
#pragma unroll
        for (int rb = 0; rb < 4; ++rb)
#pragma unroll
            for (int cb = 0; cb < 2; ++cb)
#pragma unroll
                for (int i = 0; i < 16; ++i) AT(bf16, G, (row0 + ACC_ROW(rb, i)) * 3072 + cbase + ACC_COL(cb)) = f2bf(sigmoidf_(acc[rb][cb][i]));
    }
}
DI void s1_item(const Params& p, int it, ldsp lds) {
    TID_VARS
    const int g = it & 15, mt = it >> 4;
    f32x16 acc[4][2]; zero_acc<4, 2>(acc);
    gemm_acc<1, 4, 2>(acc, (const bf16*)(p.ws + O_S) + g * 16, 8192, mt * 256, (const bf16*)(p.ws + O_W1S) + (unsigned)g * 256 * 512, 512, 0, 512, lds);
    float* E = (float*)(p.ws + O_E);
#pragma unroll
    for (int rb = 0; rb < 4; ++rb)
#pragma unroll
        for (int cb = 0; cb < 2; ++cb)
#pragma unroll
            for (int i = 0; i < 16; ++i) {
                const int c = mt * 256 + ACC_ROW(rb, i);
                if (c < NCH) AT(float, E, (c * 16 + g) * 256 + ACC_COL(cb)) = acc[rb][cb][i];
            }
}
DI void s2_item(const Params& p, int it) {
    const int sidx = it * 512 + threadIdx.x;
    const int g = sidx >> 7, dir = (sidx >> 6) & 1, pp = sidx & 63;
    const float2 aT = ((const float2*)(p.ws + O_PW))[(unsigned)((dir * 16 + g) * 64 + pp) * 33 + 32];
    const float* E = (const float*)(p.ws + O_E) + g * 256 + dir * 128 + pp;
    bf16* C = (bf16*)(p.ws + O_CARRY) + g * 256 + dir * 128 + pp;
    float cr = 0.f, ci = 0.f;
#pragma unroll 8
    for (int n = 0; n < NCH; ++n) {
        int c;
        if (dir == 0) c = (n < 8) ? 512 + n : n - 8;
        else c = 519 - n;
        const float er = E[(unsigned)c * 4096], ei = E[(unsigned)c * 4096 + 64];
        C[(unsigned)c * 4096] = f2bf(cr); C[(unsigned)c * 4096 + 64] = f2bf(ci);
        const float nr = aT.x * cr - aT.y * ci + er, ni = aT.x * ci + aT.y * cr + ei;
        cr = nr; ci = ni;
    }
}
DI float gelu_tanh(float x) { const float u = 0.7978845608028654f * (x + 0.044715f * x * x * x); return x * sigmoidf_(2.f * u); }
DI void s3_item(const Params& p, int it, ldsp lds) {
    TID_VARS
    const int g = it & 15, rest = it >> 4, nt = rest & 1, mt = rest >> 1;
    f32x16 acc[4][2]; zero_acc<4, 2>(acc);
    gemm_acc<1, 4, 2>(acc, (const bf16*)(p.ws + O_S) + g * 16, 8192, mt * 256, (const bf16*)(p.ws + O_TOEP) + (unsigned)g * 512 * 512, 512, nt * 256, 512, lds);
    gemm_acc<0, 4, 2>(acc, (const bf16*)(p.ws + O_CARRY) + g * 256, 4096, mt * 256, (const bf16*)(p.ws + O_W3S) + (unsigned)g * 512 * 256, 256, nt * 256, 256, lds);
    bf16* Ys = (bf16*)(p.ws + O_YS);
#pragma unroll
    for (int rb = 0; rb < 4; ++rb)
#pragma unroll
        for (int cb = 0; cb < 2; ++cb)
#pragma unroll
            for (int i = 0; i < 16; ++i) {
                const int c = mt * 256 + ACC_ROW(rb, i);
                const int n = nt * 256 + ACC_COL(cb), j = n >> 4, hh = n & 15;
                if (c < NCH) AT(bf16, Ys, (c * 32 + j) * 256 + g * 16 + hh) = f2bf(gelu_tanh(acc[rb][cb][i]));
            }
}
DI void pool_item(const Params& p, int it) {
    const int tid = threadIdx.x, cv = tid & 31, rg = tid >> 5;
    const bf16* A = (const bf16*)(p.ws + O_A);
    bf16* Y = (bf16*)(p.ws + O_YP);
    const int half = 1 << (cv >> 3);
#pragma unroll 1
    for (int i = 0; i < 4; ++i) {
        const int row = it * 64 + rg + 16 * i;
        const int base = row >= NL ? NL : 0, n = row >= NL ? NC : NL, t = row - base;
        const int lo = max(t - half, 0), hi = min(t + half, n);
        float s[8];
#pragma unroll
        for (int e = 0; e < 8; ++e) s[e] = 0.f;
        for (int u = lo; u < hi; ++u) {
            const u32x4 v = *(const u32x4*)(A + (unsigned)(base + u) * 256 + cv * 8);
            s[0] += bflo(v.x); s[1] += bfhi(v.x); s[2] += bflo(v.y); s[3] += bfhi(v.y); s[4] += bflo(v.z); s[5] += bfhi(v.z); s[6] += bflo(v.w); s[7] += bfhi(v.w);
        }
        const u32x4 v = *(const u32x4*)(A + (unsigned)row * 256 + cv * 8);
        const float inv = 1.f / (float)(hi - lo);
        u32x4 o;
        o.x = pk2(s[0] * inv - bflo(v.x), s[1] * inv - bfhi(v.x)); o.y = pk2(s[2] * inv - bflo(v.y), s[3] * inv - bfhi(v.y));
        o.z = pk2(s[4] * inv - bflo(v.z), s[5] * inv - bfhi(v.z)); o.w = pk2(s[6] * inv - bflo(v.w), s[7] * inv - bfhi(v.w));
        *(u32x4*)(Y + (unsigned)row * 256 + cv * 8) = o;
    }
}
DI int sig_perm(int r) { return (r & 0x13) | ((r & 4) << 1) | ((r & 8) >> 1); }
template <bool FIXED>
DI void attn_item(const Params& p, int qb, int head, float bound, ldsp lds) {
    TID_VARS
    const int kvh = head >> 2;
    bf16* Q = (bf16*)(p.ws + O_Q);
    const bf16* Kp = (const bf16*)(p.ws + O_K) + kvh * 64;
    const bf16* Vp = (const bf16*)(p.ws + O_VT) + (unsigned)kvh * 64 * NT;
    const int q0 = qb * 256 + w * 32;
    bf16x8 qf[4];
#pragma unroll
    for (int s = 0; s < 4; ++s) qf[s] = *(const bf16x8*)(Q + (unsigned)(q0 + r) * 512 + head * 64 + 16 * s + 8 * h);
    const int key0 = qb < 64 ? 0 : NL, ntile = qb < 64 ? NT / 64 : NC / 64;
    const int isv = tid >> 8, lrow = (tid & 255) >> 3, lv = tid & 7;
    const bf16* gp = isv ? (Vp + (unsigned)lrow * NT + key0 + lv * 8) : (Kp + (unsigned)(key0 + lrow) * 128 + lv * 8);
    const unsigned gstep = isv ? 64u : 64u * 128u, grow = isv ? 32u * NT : 32u * 128u;
    u32x4 rg[2];
#pragma unroll
    for (int i = 0; i < 2; ++i) rg[i] = *(const u32x4*)(gp + i * grow);
    ldsp wr = lds + isv * 9216 + lrow * LROW + lv * 16;
#pragma unroll
    for (int i = 0; i < 2; ++i) *(LAS u32x4*)(wr + i * 32 * LROW) = rg[i];
    __syncthreads();
    f32x16 o0, o1;
#pragma unroll
    for (int i = 0; i < 16; ++i) { o0[i] = 0.f; o1[i] = 0.f; }
    const float L2E = 1.4426950408889634f;
    float m = FIXED ? bound : -1e30f, lsum = 0.f;
    f32x2 ls2 = {0.f, 0.f};
    cldsp lk = lds + sig_perm(r) * LROW + h * 16;
    cldsp lvv = lds + 9216 + r * LROW + h * 16;
    for (int t = 0; t < ntile; ++t) {
        const int buf = t & 1;
        const bool more = t + 1 < ntile;
        if (more) {
            gp += gstep;
#pragma unroll
            for (int i = 0; i < 2; ++i) rg[i] = *(const u32x4*)(gp + i * grow);
        }
        cldsp pk = lk + buf * 18432; cldsp pv = lvv + buf * 18432;
        f32x16 s0, s1;
#pragma unroll
        for (int i = 0; i < 16; ++i) { s0[i] = 0.f; s1[i] = 0.f; }
#pragma unroll
        for (int s = 0; s < 4; ++s) {
            const bf16x8 k0 = *(const LAS bf16x8*)(pk + s * 32), k1 = *(const LAS bf16x8*)(pk + 32 * LROW + s * 32);
            s0 = MFMA(k0, qf[s], s0); s1 = MFMA(k1, qf[s], s1);
        }
        if (!FIXED) {
            float mx = s0[0];
#pragma unroll
            for (int i = 1; i < 16; ++i) mx = fmaxf(mx, s0[i]);
#pragma unroll
            for (int i = 0; i < 16; ++i) mx = fmaxf(mx, s1[i]);
            mx = fmaxf(mx, __shfl_xor(mx, 32));
            const float mnew = fmaxf(m, mx);
            const float alpha = __builtin_amdgcn_exp2f((m - mnew) * L2E);
            m = mnew;
            ls2 *= alpha;
#pragma unroll
            for (int i = 0; i < 16; ++i) { o0[i] *= alpha; o1[i] *= alpha; }
        }
        const float mb = m * L2E;
        const f32x2 mb2 = {mb, mb}, l2 = {L2E, L2E};
#pragma unroll
        for (int i = 0; i < 16; i += 2) {
            f32x2 a = {s0[i], s0[i + 1]}, b = {s1[i], s1[i + 1]};
            a = a * l2 - mb2; b = b * l2 - mb2;
            a.x = __builtin_amdgcn_exp2f(a.x); a.y = __builtin_amdgcn_exp2f(a.y); b.x = __builtin_amdgcn_exp2f(b.x); b.y = __builtin_amdgcn_exp2f(b.y);
            ls2 += a; ls2 += b;
            s0[i] = a.x; s0[i + 1] = a.y; s1[i] = b.x; s1[i + 1] = b.y;
        }
#pragma unroll
        for (int kb = 0; kb < 2; ++kb)
#pragma unroll
            for (int s = 0; s < 2; ++s) {
                u32x4 pp;
                if (kb == 0) { pp.x = pk2(s0[8 * s], s0[8 * s + 1]); pp.y = pk2(s0[8 * s + 2], s0[8 * s + 3]); pp.z = pk2(s0[8 * s + 4], s0[8 * s + 5]); pp.w = pk2(s0[8 * s + 6], s0[8 * s + 7]); }
                else         { pp.x = pk2(s1[8 * s], s1[8 * s + 1]); pp.y = pk2(s1[8 * s + 2], s1[8 * s + 3]); pp.z = pk2(s1[8 * s + 4], s1[8 * s + 5]); pp.w = pk2(s1[8 * s + 6], s1[8 * s + 7]); }
                const bf16x8 pf = __builtin_bit_cast(bf16x8, pp);
                const bf16x8 v0 = *(const LAS bf16x8*)(pv + (kb * 32 + 16 * s) * 2), v1 = *(const LAS bf16x8*)(pv + 32 * LROW + (kb * 32 + 16 * s) * 2);
                o0 = MFMA(v0, pf, o0); o1 = MFMA(v1, pf, o1);
            }
        if (more) {
            ldsp w2 = wr + (buf ^ 1) * 18432;
#pragma unroll
            for (int i = 0; i < 2; ++i) *(LAS u32x4*)(w2 + i * 32 * LROW) = rg[i];
        }
        __syncthreads();
    }
    lsum = ls2.x + ls2.y;
    lsum += __shfl_xor(lsum, 32);
    const float inv = 1.f / lsum;
    bf16* orow = Q + (unsigned)(q0 + r) * 512 + head * 64;
#pragma unroll
    for (int q = 0; q < 4; ++q) {
        u32x2 a, b;
        a.x = pk2(o0[4 * q] * inv, o0[4 * q + 1] * inv); a.y = pk2(o0[4 * q + 2] * inv, o0[4 * q + 3] * inv);
        b.x = pk2(o1[4 * q] * inv, o1[4 * q + 1] * inv); b.y = pk2(o1[4 * q + 2] * inv, o1[4 * q + 3] * inv);
        *(u32x2*)(orow + 8 * q + 4 * h) = a;
        *(u32x2*)(orow + 32 + 8 * q + 4 * h) = b;
    }
}
DI float attn_bound(const Params& p, int l) {
    const int lane = threadIdx.x & 63;
    float a = fabsf(p.in[I_QG][l * 64 + lane]), b = fabsf(p.in[I_KG][l * 64 + lane]);
#pragma unroll
    for (int o = 32; o >= 1; o >>= 1) { a = fmaxf(a, __shfl_xor(a, o)); b = fmaxf(b, __shfl_xor(b, o)); }
    return 8.f * 1.02f * a * b;
}
DI void attn_dispatch(const Params& p, int l, int qb, int head, ldsp lds) {
    const float bound = attn_bound(p, l);
    if (bound < 40.f) attn_item<true>(p, qb, head, bound, lds);
    else attn_item<false>(p, qb, head, 0.f, lds);
}
DI void mix1_item(const Params& p, int it, ldsp lds) {
    TID_VARS
    const int nt = it & 7, mt = it >> 3;
    const bf16* G = (const bf16*)(p.ws + O_BIG);
    const int row0 = mt * 128 + wm * 64 + 4 * h, col = nt * 128 + wn * 32 + r;
#define MROW(rb, i) (row0 + (rb) * 32 + ((i) & 3) + 8 * ((i) >> 2))
    f32x16 acc[2][1];
    f32x16 mx[2];
    zero_acc<2, 1>(acc);
    gemm_acc<0, 2, 1>(acc, (const bf16*)(p.ws + O_YS), 256, mt * 128, (const bf16*)(p.ws + O_WGLU), 256, 1024 + nt * 128, 256, lds);
#pragma unroll
    for (int rb = 0; rb < 2; ++rb)
#pragma unroll
        for (int i = 0; i < 16; ++i) mx[rb][i] = sigmoidf_(acc[rb][0][i]) * bf2f(AT(const bf16, G, MROW(rb, i) * 3072 + 1024 + col));
    zero_acc<2, 1>(acc);
    gemm_acc<0, 2, 1>(acc, (const bf16*)(p.ws + O_YS), 256, mt * 128, (const bf16*)(p.ws + O_WGLU), 256, nt * 128, 256, lds);
#pragma unroll
    for (int rb = 0; rb < 2; ++rb)
#pragma unroll
        for (int i = 0; i < 16; ++i) mx[rb][i] *= acc[rb][0][i];
    zero_acc<2, 1>(acc);
    gemm_acc<0, 2, 1>(acc, (const bf16*)(p.ws + O_YP), 256, mt * 128, (const bf16*)(p.ws + O_WP), 256, nt * 128, 256, lds);
#pragma unroll
    for (int rb = 0; rb < 2; ++rb)
#pragma unroll
        for (int i = 0; i < 16; ++i) mx[rb][i] += acc[rb][0][i] * bf2f(AT(const bf16, G, MROW(rb, i) * 3072 + col));
    zero_acc<2, 1>(acc);
    gemm_acc<0, 2, 1>(acc, (const bf16*)(p.ws + O_Q), 512, mt * 128, (const bf16*)(p.ws + O_WAO), 512, nt * 128, 512, lds);
    bf16* M = (bf16*)(p.ws + O_H);
#pragma unroll
    for (int rb = 0; rb < 2; ++rb)
#pragma unroll
        for (int i = 0; i < 16; ++i) {
            const int row = MROW(rb, i);
            const float v = mx[rb][i] + acc[rb][0][i] * bf2f(AT(const bf16, G, row * 3072 + 2048 + col));
            AT(bf16, M, row * D + col) = f2bf(v);
        }
}

DI void conv_tile(const float* src, bf16* dst, int K, int N, int permmode, int tile, ldsp lds) {
    const int tid = threadIdx.x & 255, half = threadIdx.x >> 8;
    tile = tile * 2 + half;
    const int ntn = N / 64, tk = tile / ntn, tn = tile % ntn;
    LAS float* L = (LAS float*)lds + half * (64 * 65);
#pragma unroll
    for (int i = 0; i < 4; ++i) {
        const int kk = (tid >> 4) + 16 * i, c4 = (tid & 15) * 4;
        const f32x4 v = *(const f32x4*)(src + (size_t)(tk * 64 + kk) * N + tn * 64 + c4);
        L[kk * 65 + c4] = v[0]; L[kk * 65 + c4 + 1] = v[1]; L[kk * 65 + c4 + 2] = v[2]; L[kk * 65 + c4 + 3] = v[3];
    }
    __syncthreads();
    const int n = tid >> 2, ks = (tid & 3) * 16;
    int nn = tn * 64 + n;
    if (permmode == 1) { const int hN = N >> 1, b = nn >= hN, hc = b ? nn - hN : nn; nn = 256 * (hc >> 7) + 64 * ((hc >> 5) & 3) + 32 * b + (hc & 31); }
    u32x4 o0, o1;
    o0.x = pk2(L[(ks + 0) * 65 + n], L[(ks + 1) * 65 + n]); o0.y = pk2(L[(ks + 2) * 65 + n], L[(ks + 3) * 65 + n]);
    o0.z = pk2(L[(ks + 4) * 65 + n], L[(ks + 5) * 65 + n]); o0.w = pk2(L[(ks + 6) * 65 + n], L[(ks + 7) * 65 + n]);
    o1.x = pk2(L[(ks + 8) * 65 + n], L[(ks + 9) * 65 + n]); o1.y = pk2(L[(ks + 10) * 65 + n], L[(ks + 11) * 65 + n]);
    o1.z = pk2(L[(ks + 12) * 65 + n], L[(ks + 13) * 65 + n]); o1.w = pk2(L[(ks + 14) * 65 + n], L[(ks + 15) * 65 + n]);
    bf16* d = dst + (size_t)nn * K + tk * 64 + ks;
    *(u32x4*)d = o0; *(u32x4*)(d + 8) = o1;
    __syncthreads();
}
constexpr int CV0 = 704, CV1 = 1408, CV2 = 1760, CV3 = 2112, CV4 = 2656, CV5 = 2720, CV6 = 2784, CV_TOTAL = 2912;
DI void conv_item(const Params& p, int l, int it, ldsp lds) {
    if (it < CV0) conv_tile(p.in[I_W13] + (size_t)(l * 2 + 0) * 1024 * 5632, (bf16*)(p.ws + O_W13), 1024, 5632, 1, it, lds);
    else if (it < CV1) conv_tile(p.in[I_W13] + (size_t)(l * 2 + 1) * 1024 * 5632, (bf16*)(p.ws + O_W13) + (size_t)5632 * 1024, 1024, 5632, 1, it - CV0, lds);
    else if (it < CV2) conv_tile(p.in[I_W2] + (size_t)(l * 2 + 0) * 2816 * 1024, (bf16*)(p.ws + O_W2), 2816, 1024, 0, it - CV1, lds);
    else if (it < CV3) conv_tile(p.in[I_W2] + (size_t)(l * 2 + 1) * 2816 * 1024, (bf16*)(p.ws + O_W2) + (size_t)1024 * 2816, 2816, 1024, 0, it - CV2, lds);
    else if (it < CV4) conv_tile(p.in[I_WIN] + (size_t)l * 1024 * INW, (bf16*)(p.ws + O_WIN), 1024, INW, 0, it - CV3, lds);
    else if (it < CV5) conv_tile(p.in[I_GLU] + (size_t)l * 256 * 2048, (bf16*)(p.ws + O_WGLU), 256, 2048, 0, it - CV4, lds);
    else if (it < CV6) conv_tile(p.in[I_AO] + (size_t)l * 512 * 1024, (bf16*)(p.ws + O_WAO), 512, 1024, 0, it - CV5, lds);
    else conv_tile(p.in[I_WO] + (size_t)l * 1024 * 1024, (bf16*)(p.ws + O_WOUT), 1024, 1024, 0, it - CV6, lds);
}
DI void mod_item(const Params& p, int it, ldsp lds) {
    const int tid = threadIdx.x, lane = tid & 63, w = tid >> 6;
    const int c0 = it * 256 + lane * 4, l = c0 / 9216, col = c0 % 9216;
    const float* W = p.in[I_MODW] + (size_t)l * 1024 * 9216 + col;
    f32x4 a0 = {0.f, 0.f, 0.f, 0.f}, a1 = {0.f, 0.f, 0.f, 0.f};
#pragma unroll 8
    for (int k = w * 128; k < w * 128 + 128; ++k) {
        const f32x4 wv = *(const f32x4*)(W + (size_t)k * 9216);
        const float c = p.in[I_C][k], cc = p.in[I_CCTX][k];
        const float s0 = c * sigmoidf_(c), s1 = cc * sigmoidf_(cc);
        a0 += wv * s0; a1 += wv * s1;
    }
    LAS f32x4* L = (LAS f32x4*)lds;
    L[(w * 64 + lane) * 2] = a0; L[(w * 64 + lane) * 2 + 1] = a1;
    __syncthreads();
    if (w == 0) {
        f32x4 b = *(const f32x4*)(p.in[I_MODB] + (size_t)l * 9216 + col);
        f32x4 r0 = b, r1 = b;
#pragma unroll
        for (int q = 0; q < 8; ++q) { r0 += L[(q * 64 + lane) * 2]; r1 += L[(q * 64 + lane) * 2 + 1]; }
        float* M = (float*)(p.ws + O_MODS);
        *(f32x4*)(M + (size_t)(0 * 2 + l) * 9216 + col) = r0;
        *(f32x4*)(M + (size_t)(1 * 2 + l) * 9216 + col) = r1;
    }
    __syncthreads();
}
DI void pw_item(const Params& p, int l, int it) {
    const int idx = it * 512 + threadIdx.x;
    if (idx >= 2048 * 33) return;
    const int st = idx / 33, e = idx % 33;
    const int dg = st >> 6;
    const double are = p.in[I_ARE][(size_t)l * 2048 + st], aim = p.in[I_AIM][(size_t)l * 2048 + st];
    const double dt = dexp((double)p.in[I_LOGDT][l * 32 + dg]);
    const double mag = dexp(are * dt * e);
    double s, c; dsincos(aim * dt * e, s, c);
    ((float2*)(p.ws + O_PW))[idx] = make_float2((float)(mag * c), (float)(mag * s));
    if (e == 1) {
        const double nr = mag * c - 1.0, ni = mag * s, den = are * are + aim * aim;
        ((float2*)(p.ws + O_CF))[st] = make_float2((float)((nr * are + ni * aim) / den), (float)((ni * are - nr * aim) / den));
    }
}
DI void wp_item(const Params& p, int l, int it) {
    const int k = it >> 1, n = (it & 1) * 512 + threadIdx.x, g = k >> 6, c = k & 63;
    const float* pw = p.in[I_POOLW] + (size_t)l * 4 * 64 * 64 + (size_t)(g * 64 + c) * 64;
    const float* ps = p.in[I_POOLS] + l * 256 + g * 64;
    const float* po = p.in[I_POOLO] + (size_t)l * 256 * 1024 + (size_t)(g * 64) * 1024 + n;
    float s = 0.f;
#pragma unroll 8
    for (int d = 0; d < 64; ++d) s += pw[d] * ps[d] * po[(size_t)d * 1024];
    ((bf16*)(p.ws + O_WP))[(size_t)n * 256 + k] = f2bf(s);
}
DI void rope_item(const Params& p, int it) {
    const int idx = it * 512 + threadIdx.x;
    const int pos = idx >> 4, i = idx & 15;
    const double inv = dexp(-(double)i * (9.210340371976184 / 16.0));
    double s, c; dsincos((double)pos * inv, s, c);
    ((float2*)(p.ws + O_ROPE))[idx] = make_float2((float)c, (float)s);
}
DI void ktab_item(const Params& p, int l, int it, ldsp lds) {
    const int tid = threadIdx.x & 255, half = threadIdx.x >> 8;
    const int lag = (it & 15) * 2 + half, dg = it >> 4;
    LAS f32x2* Wl = (LAS f32x2*)lds + half * 64;
    if (tid < 64) {
        const float2 z = ((const float2*)(p.ws + O_PW))[(size_t)(dg * 64 + tid) * 33 + lag], cf = ((const float2*)(p.ws + O_CF))[dg * 64 + tid];
        Wl[tid] = (f32x2){z.x * cf.x - z.y * cf.y, z.x * cf.y + z.y * cf.x};
    }
    __syncthreads();
    const int hp = tid >> 4, hh = tid & 15;
    const size_t pb = (size_t)(l * 32 + dg) * 1024;
    const float* cre = p.in[I_CRE] + pb + hp * 64, *cim = p.in[I_CIM] + pb + hp * 64;
    const float* bre = p.in[I_BRE] + pb + hh, *bim = p.in[I_BIM] + pb + hh;
    float s = 0.f;
#pragma unroll 8
    for (int q = 0; q < 64; ++q) {
        const f32x2 wv = Wl[q];
        const float br = bre[q * 16], bi = bim[q * 16];
        const float tr = wv.x * br - wv.y * bi, ti = wv.x * bi + wv.y * br;
        s += cre[q] * tr - cim[q] * ti;
    }
    ((float*)(p.ws + O_KTAB))[(size_t)(dg * 32 + lag) * 256 + tid] = s;
    __syncthreads();
}
DI void w1_item(const Params& p, int l, int it) {
    const int idx = it * 512 + threadIdx.x;
    const int k8 = idx & 63, n = (idx >> 6) & 255, g = idx >> 14;
    const int dir = n >> 7, ri = (n >> 6) & 1, pp = n & 63, j = k8 >> 1, h0 = (k8 & 1) * 8;
    const int e = dir ? j : 31 - j, st = (dir * 16 + g) * 64 + pp;
    const float2 z = ((const float2*)(p.ws + O_PW))[(size_t)st * 33 + e], cf = ((const float2*)(p.ws + O_CF))[st];
    const float wr = z.x * cf.x - z.y * cf.y, wi = z.x * cf.y + z.y * cf.x;
    const float* bre = p.in[I_BRE] + (size_t)(l * 32 + dir * 16 + g) * 1024 + pp * 16 + h0;
    const float* bim = p.in[I_BIM] + (size_t)(l * 32 + dir * 16 + g) * 1024 + pp * 16 + h0;
    float o[8];
#pragma unroll
    for (int q = 0; q < 8; ++q) o[q] = ri ? (wr * bim[q] + wi * bre[q]) : (wr * bre[q] - wi * bim[q]);
    u32x4 v; v.x = pk2(o[0], o[1]); v.y = pk2(o[2], o[3]); v.z = pk2(o[4], o[5]); v.w = pk2(o[6], o[7]);
    *(u32x4*)((bf16*)(p.ws + O_W1S) + ((size_t)g * 256 + n) * 512 + k8 * 8) = v;
}
DI void w3_item(const Params& p, int l, int it) {
    const int idx = it * 512 + threadIdx.x;
    const int k8 = idx & 31, n = (idx >> 5) & 511, g = idx >> 14;
    const int dir = k8 >> 4, ri = (k8 >> 3) & 1, p0 = (k8 & 7) * 8, j = n >> 4, hp = n & 15;
    const int e = dir ? 32 - j : j + 1;
    const float* cre = p.in[I_CRE] + (size_t)(l * 32 + dir * 16 + g) * 1024 + hp * 64 + p0;
    const float* cim = p.in[I_CIM] + (size_t)(l * 32 + dir * 16 + g) * 1024 + hp * 64 + p0;
    const float2* pw = (const float2*)(p.ws + O_PW) + (size_t)((dir * 16 + g) * 64 + p0) * 33 + e;
    float o[8];
#pragma unroll
    for (int q = 0; q < 8; ++q) { const float2 z = pw[q * 33]; o[q] = ri ? -(cre[q] * z.y + cim[q] * z.x) : (cre[q] * z.x - cim[q] * z.y); }
    u32x4 v; v.x = pk2(o[0], o[1]); v.y = pk2(o[2], o[3]); v.z = pk2(o[4], o[5]); v.w = pk2(o[6], o[7]);
    *(u32x4*)((bf16*)(p.ws + O_W3S) + ((size_t)g * 512 + n) * 256 + k8 * 8) = v;
}
DI void toep_item(const Params& p, int l, int it) {
    const int idx = it * 512 + threadIdx.x;
    const int k8 = idx & 63, n = (idx >> 6) & 511, g = idx >> 15;
    const int j2 = k8 >> 1, h0 = (k8 & 1) * 8, j = n >> 4, hp = n & 15;
    const float* KT = (const float*)(p.ws + O_KTAB);
    float o[8];
#pragma unroll
    for (int q = 0; q < 8; ++q) o[q] = 0.f;
    if (j2 <= j) { const float* kf = KT + ((size_t)(0 * 16 + g) * 32 + (j - j2)) * 256 + hp * 16 + h0;
#pragma unroll
        for (int q = 0; q < 8; ++q) o[q] += kf[q]; }
    if (j2 >= j) { const float* kb = KT + ((size_t)(1 * 16 + g) * 32 + (j2 - j)) * 256 + hp * 16 + h0;
#pragma unroll
        for (int q = 0; q < 8; ++q) o[q] += kb[q]; }
    if (j2 == j) {
        const float dd = p.in[I_SD][l * 256 + g * 16 + hp];
#pragma unroll
        for (int q = 0; q < 8; ++q) if (h0 + q == hp) o[q] += dd;
    }
    u32x4 v; v.x = pk2(o[0], o[1]); v.y = pk2(o[2], o[3]); v.z = pk2(o[4], o[5]); v.w = pk2(o[6], o[7]);
    *(u32x4*)((bf16*)(p.ws + O_TOEP) + ((size_t)g * 512 + n) * 512 + k8 * 8) = v;
}

constexpr int PH_PER_LAYER = 14, N_PHASES = 2 * PH_PER_LAYER + 1;
#define SUBLOOP(n, call) { for (int it = ((b - off) % G + G) % G; it < (n); it += G) { call; } off = (off + (n)) % G; }
DI void run_phase(const Params& p, const int ph, ldsp lds) {
    const int G = gridDim.x, b = blockIdx.x;
    if (ph == 2 * PH_PER_LAYER) { for (int it = b; it < NL / 8; it += G) final_norm_item(p, it); return; }
    const int l = ph / PH_PER_LAYER, s = ph % PH_PER_LAYER;
    const int mtiles = (l == 1) ? 64 : 65;
    const bf16* HID = (const bf16*)(p.ws + O_BIG);
    const bf16* W2 = (const bf16*)(p.ws + O_W2);
    int off = 0;
#ifdef ONLY_S
    if (s != ONLY_S) return;
#endif
    switch (s) {
    case 0: {
        SUBLOOP(((l == 0) ? 72 : 0), mod_item(p, it, lds))
        SUBLOOP(132, pw_item(p, l, it))
        SUBLOOP(512, wp_item(p, l, it))
        SUBLOOP(((l == 0) ? 8 : 0), rope_item(p, it))
        SUBLOOP(CV_TOTAL, conv_item(p, l, it, lds))
    } break;
    case 1: {
        SUBLOOP(512, ktab_item(p, l, it, lds))
        SUBLOOP(512, w1_item(p, l, it))
        SUBLOOP(512, w3_item(p, l, it))
        SUBLOOP(NT / 8, norm_item(p, l, 0, it))
    } break;
    case 2: SUBLOOP(65 * 22, ffn_a_item(p, 0, it, lds)) break;
    case 3: {
        SUBLOOP(44, gemm_resid_item(p, HID, DFF, W2, 64, it & 3, (it >> 2) * 256, 256, l, 2, 0.5f, false, true, lds))
        SUBLOOP(256, gemm_resid_item(p, HID, DFF, W2, it >> 2, it & 3, 0, DFF, l, 2, 0.5f, l == 0, false, lds))
    } break;
    case 4: {
        SUBLOOP(1024, toep_item(p, l, it))
        SUBLOOP(NT / 8, norm_item(p, l, 1, it))
    } break;
    case 5: SUBLOOP(65 * 17, inproj_item(p, l, it, lds)) break;
    case 6: {
        SUBLOOP(48, s1_item(p, it, lds))
        SUBLOOP(mtiles * 4, pool_item(p, it))
        SUBLOOP(((l == 0) ? 8 : 0), attn_dispatch(p, l, 64, it, lds))
    } break;
    case 7: {
        SUBLOOP(4, s2_item(p, it))
        SUBLOOP(512, attn_dispatch(p, l, it >> 3, it & 7, lds))
    } break;
    case 8: SUBLOOP(96, s3_item(p, it, lds)) break;
    case 9: SUBLOOP(mtiles * 16, mix1_item(p, it, lds)) break;
    case 10: {
        SUBLOOP(((l == 0) ? 16 : 0), gemm_resid_item(p, (const bf16*)(p.ws + O_H), D, (const bf16*)(p.ws + O_WOUT), 64, it & 3, (it >> 2) * 256, 256, l, 5, 1.0f, false, true, lds))
        SUBLOOP(256, gemm_resid_item(p, (const bf16*)(p.ws + O_H), D, (const bf16*)(p.ws + O_WOUT), it >> 2, it & 3, 0, D, l, 5, 1.0f, false, false, lds))
    } break;
    case 11: SUBLOOP(mtiles * 32, norm_item(p, l, 2, it)) break;
    case 12: SUBLOOP(mtiles * 22, ffn_a_item(p, 1, it, lds)) break;
    case 13: {
        SUBLOOP(((l == 0) ? 44 : 0), gemm_resid_item(p, HID, DFF, W2 + (size_t)1024 * DFF, 64, it & 3, (it >> 2) * 256, 256, l, 8, 0.5f, false, true, lds))
        SUBLOOP(256, gemm_resid_item(p, HID, DFF, W2 + (size_t)1024 * DFF, it >> 2, it & 3, 0, DFF, l, 8, 0.5f, false, false, lds))
    } break;
    }
}

__global__ void __launch_bounds__(512, 2) hybrid_fwd(Params p, int ph_lo, int ph_hi) {
    __shared__ __attribute__((aligned(16))) char lds_raw[LDS_BYTES];
    ldsp lds = (ldsp)lds_raw;
    __shared__ uint4 xb_words;
    if (p.ws == nullptr) cg::this_grid().sync();
    XcdBarrier bar;
    const bool multi = (ph_hi - ph_lo) > 1;
    if (multi) {
        if (threadIdx.x == 0) xb_words = make_uint4(0u, 0u, 0u, 0u);
        __syncthreads();
        bar = xcd_barrier_post((unsigned*)(p.ws + O_BAR), (volatile LAS unsigned*)&xb_words);
    }
#define PH(k) if (ph_lo <= (k) && (k) < ph_hi) { if ((k) > ph_lo) xcd_barrier(bar); run_phase(p, (k), lds); }
    PH(0) PH(1) PH(2) PH(3) PH(4) PH(5) PH(6) PH(7) PH(8) PH(9) PH(10) PH(11) PH(12) PH(13)
    PH(14) PH(15) PH(16) PH(17) PH(18) PH(19) PH(20) PH(21) PH(22) PH(23) PH(24) PH(25) PH(26) PH(27) PH(28)
}

extern "C" void kernel_launch(void* const* d_in, const int* in_sizes, int n_in, void* d_out, int out_size, void* d_ws, size_t ws_size, hipStream_t stream) {
    (void)in_sizes; (void)n_in; (void)out_size;
    if (ws_size < O_END) { fprintf(stderr, "workspace too small: %zu < %zu\n", ws_size, (size_t)O_END); return; }
    static int grid_blocks = 0;
    if (!grid_blocks) {
        int dev = 0, cus = 0, per_cu = 0;
        (void)hipGetDevice(&dev);
        (void)hipDeviceGetAttribute(&cus, hipDeviceAttributeMultiprocessorCount, dev);
        (void)hipOccupancyMaxActiveBlocksPerMultiprocessor(&per_cu, hybrid_fwd, 512, 0);
        if (per_cu > 1) per_cu = 1;
        if (per_cu < 1) per_cu = 1;
        grid_blocks = cus * per_cu;
    }
    Params p{};
    for (int i = 0; i < 27; ++i) p.in[i] = (const float*)d_in[i];
    p.out = (float*)d_out; p.ws = (char*)d_ws;
#if MK_ONE_LAUNCH
    (void)hipMemsetAsync(d_ws, 0, 16384, stream);
    int lo = 0, hi = N_PHASES;
    void* args[] = {&p, &lo, &hi};
    hipError_t e = hipLaunchCooperativeKernel((void*)hybrid_fwd, dim3(grid_blocks), dim3(512), args, 0, stream);
    if (e != hipSuccess) fprintf(stderr, "cooperative launch failed: %s (grid %d)\n", hipGetErrorString(e), grid_blocks);
#else
    for (int ph = 0; ph < N_PHASES; ++ph) hipLaunchKernelGGL(hybrid_fwd, dim3(grid_blocks), dim3(512), 0, stream, p, ph, ph + 1);
#endif
}
```

```cpp
#include <hip/hip_runtime.h>
#include <hip/hip_cooperative_groups.h>
#include <cstdio>
#include <cstdint>
namespace cg = cooperative_groups;

#define DI __device__ __forceinline__
#define LAS __attribute__((address_space(3)))
typedef __attribute__((address_space(3))) char* ldsp;
typedef const __attribute__((address_space(3))) char* cldsp;
typedef unsigned short bf16;
typedef short bf16x8 __attribute__((ext_vector_type(8)));
typedef float f32x16 __attribute__((ext_vector_type(16)));
typedef float f32x4 __attribute__((ext_vector_type(4)));
typedef float f32x2 __attribute__((ext_vector_type(2)));
typedef unsigned u32x4 __attribute__((ext_vector_type(4)));
typedef unsigned u32x2 __attribute__((ext_vector_type(2)));
typedef __bf16 hbf2 __attribute__((ext_vector_type(2)));

#ifndef MK_ONE_LAUNCH
#define MK_ONE_LAUNCH 1
#endif

constexpr int D = 1024, NL = 16384, NC = 256, NT = NL + NC, DFF = 2816, INW = 4352;
constexpr int NCH = NT / 32;

enum { I_X = 0, I_C, I_CTX, I_CCTX, I_MODW, I_MODB, I_NORMG, I_W13, I_W2, I_WIN, I_POOLW, I_POOLS, I_POOLO, I_ARE, I_AIM, I_LOGDT,
       I_BRE, I_BIM, I_CRE, I_CIM, I_SD, I_GLU, I_QG, I_KG, I_AO, I_WO, I_FG };

constexpr size_t al(size_t x) { return (x + 255) & ~(size_t)255; }
constexpr size_t O_BAR = 0;
constexpr size_t O_X = 16384;
constexpr size_t O_H = O_X + al((size_t)NT * D * 4);
constexpr size_t O_BIG = O_H + al((size_t)NT * D * 2);
constexpr size_t O_Q = O_BIG + al((size_t)NT * 3072 * 2);
constexpr size_t O_K = O_Q + al((size_t)NT * 512 * 2);
constexpr size_t O_VT = O_K + al((size_t)NT * 128 * 2);
constexpr size_t O_A = O_VT + al((size_t)NT * 128 * 2);
constexpr size_t O_S = O_A + al((size_t)NT * 256 * 2);
constexpr size_t O_YP = O_S + al((size_t)NT * 256 * 2);
constexpr size_t O_YS = O_YP + al((size_t)NT * 256 * 2);
constexpr size_t O_CARRY = O_YS + al((size_t)NT * 256 * 2);
constexpr size_t O_E = O_CARRY + al((size_t)NCH * 16 * 256 * 2);
constexpr size_t O_W13 = O_E + al((size_t)NCH * 16 * 256 * 4);
constexpr size_t O_W2 = O_W13 + al((size_t)2 * 5632 * 1024 * 2);
constexpr size_t O_WIN = O_W2 + al((size_t)2 * 1024 * 2816 * 2);
constexpr size_t O_WGLU = O_WIN + al((size_t)INW * 1024 * 2);
constexpr size_t O_WAO = O_WGLU + al((size_t)2048 * 256 * 2);
constexpr size_t O_WOUT = O_WAO + al((size_t)1024 * 512 * 2);
constexpr size_t O_WP = O_WOUT + al((size_t)1024 * 1024 * 2);
constexpr size_t O_TOEP = O_WP + al((size_t)1024 * 256 * 2);
constexpr size_t O_W1S = O_TOEP + al((size_t)16 * 512 * 512 * 2);
constexpr size_t O_W3S = O_W1S + al((size_t)16 * 256 * 512 * 2);
constexpr size_t O_KTAB = O_W3S + al((size_t)16 * 512 * 256 * 2);
constexpr size_t O_PW = O_KTAB + al((size_t)2 * 16 * 32 * 256 * 4);
constexpr size_t O_CF = O_PW + al((size_t)2048 * 33 * 8);
constexpr size_t O_MODS = O_CF + al((size_t)2048 * 8);
constexpr size_t O_ROPE = O_MODS + al((size_t)2 * 2 * 9216 * 4);
constexpr size_t O_END = O_ROPE + al((size_t)256 * 16 * 8);

struct Params { const float* in[27]; float* out; char* ws; };

DI unsigned pk2(float a, float b) { f32x2 v = {a, b}; return __builtin_bit_cast(unsigned, __builtin_convertvector(v, hbf2)); }
DI bf16 f2bf(float a) { return (bf16)(pk2(a, 0.f) & 0xffffu); }
DI float bf2f(bf16 b) { return __uint_as_float(((unsigned)b) << 16); }
DI float bflo(unsigned u) { return __uint_as_float(u << 16); }
DI float bfhi(unsigned u) { return __uint_as_float(u & 0xffff0000u); }
DI float sigmoidf_(float x) { return 1.f / (1.f + __expf(-x)); }
DI float wave_sum(float v) {
#pragma unroll
    for (int o = 32; o >= 1; o >>= 1) v += __shfl_xor(v, o);
    return v;
}
#define AT(T, base, idx) (*(T*)((char*)(base) + (unsigned)((unsigned)(idx) * (unsigned)sizeof(T))))
#define MFMA(a, b, c) __builtin_amdgcn_mfma_f32_32x32x16_bf16((a), (b), (c), 0, 0, 0)

DI double dexp(double x) {
    const double n = __builtin_rint(x * 1.4426950408889634);
    const double r = x - n * 0.6931471805599453;
    double t = 1.0;
#pragma unroll
    for (int k = 16; k >= 1; --k) t = 1.0 + t * r * (1.0 / (double)k);
    const long long e = (long long)n + 1023;
    return t * __longlong_as_double(e << 52);
}
DI void dsincos(double th, double& s, double& c) {
    const double k = __builtin_rint(th * 0.15915494309189535);
    const double x = th - k * 6.283185307179586 - k * 2.4492935982947064e-16;
    const double x2 = x * x;
    double cs = 1.0, sn = 1.0;
#pragma unroll
    for (int j = 17; j >= 1; --j) {
        cs = 1.0 - cs * x2 * (1.0 / (double)((2 * j - 1) * (2 * j)));
        sn = 1.0 - sn * x2 * (1.0 / (double)((2 * j) * (2 * j + 1)));
    }
    c = cs; s = sn * x;
}

#define XB_TMO      128
#define XB_XCNT(j)  (256  + 64 * (j))
#define XB_XSUB(j)  (1280 + 64 * (j))
#define XB_XGEN(j)  (2304 + 64 * (j))
#define XB_TOP      3328
#define XB_TOPGEN   3392
#define XCD_BAR_WORDS 3456
#define XB_SPIN_CAP (1u << 22)
DI unsigned xb_ld(unsigned* p)              { return __hip_atomic_load(p, __ATOMIC_RELAXED, __HIP_MEMORY_SCOPE_AGENT); }
DI unsigned xb_add(unsigned* p, unsigned v) { return __hip_atomic_fetch_add(p, v, __ATOMIC_RELAXED, __HIP_MEMORY_SCOPE_AGENT); }
DI unsigned xb_xcc_id() { return (unsigned)__builtin_amdgcn_s_getreg((3 << 11) | 20) & 0xFu; }
#define XB_SPIN(cond, bar) do { unsigned _sp = 0; while (cond) { __builtin_amdgcn_s_sleep(1); \
    if ((++_sp & 255u) == 0u) { if (xb_ld(&(bar)[XB_TMO])) break; if (_sp > XB_SPIN_CAP) { atomicAdd(&(bar)[XB_TMO], 1u); break; } } } } while (0)
struct XcdBarrier { unsigned* bar; unsigned x; volatile LAS unsigned* st; };
DI XcdBarrier xcd_barrier_post(unsigned* bar, volatile LAS unsigned* st) {
    XcdBarrier b; b.bar = bar; b.x = xb_xcc_id(); b.st = st;
    if (threadIdx.x == 0) (void)xb_add(&bar[XB_XCNT(b.x)], 1u);
    return b;
}
DI void xcd_barrier_complete(unsigned* bar, unsigned x, unsigned& nloc, unsigned& nx) {
    const unsigned G = gridDim.x * gridDim.y * gridDim.z;
    unsigned sum, cnt, mine, sp = 0u;
    for (;;) {
        sum = 0u; cnt = 0u; mine = 0u;
#pragma unroll
        for (unsigned j = 0; j < 16; ++j) { const unsigned c = xb_ld(&bar[XB_XCNT(j)]); sum += c; cnt += (c > 0u) ? 1u : 0u; mine = (j == x) ? c : mine; }
        if (sum == G) break;
        __builtin_amdgcn_s_sleep(1);
        if ((++sp & 255u) == 0u) { if (xb_ld(&bar[XB_TMO])) break; if (sp > XB_SPIN_CAP) { atomicAdd(&bar[XB_TMO], 1u); break; } }
    }
    nloc = mine > 0u ? mine : 1u; nx = cnt > 0u ? cnt : 1u;
}
DI void xcd_barrier(const XcdBarrier& b) {
    asm volatile("s_waitcnt vmcnt(0)" ::: "memory");
    __syncthreads();
    if (threadIdx.x == 0) {
        unsigned* bar = b.bar;
        __builtin_amdgcn_s_waitcnt(0);
        unsigned nloc = b.st[0], nx = b.st[1];
        if (nloc == 0u) { xcd_barrier_complete(bar, b.x, nloc, nx); b.st[0] = nloc; b.st[1] = nx; }
        const unsigned old = xb_add(&bar[XB_XSUB(b.x)], 1u);
        const unsigned gen = old / nloc;
        if (old + 1u == (gen + 1u) * nloc) {
            __builtin_amdgcn_fence(__ATOMIC_RELEASE, "agent");
            asm volatile("s_waitcnt vmcnt(0)" ::: "memory");
            const unsigned og = xb_add(&bar[XB_TOP], 1u);
            const unsigned tg = og / nx;
            if (og + 1u == (tg + 1u) * nx) xb_add(&bar[XB_TOPGEN], 1u);
            else XB_SPIN(xb_ld(&bar[XB_TOPGEN]) == tg, bar);
            __builtin_amdgcn_fence(__ATOMIC_ACQUIRE, "agent");
            xb_add(&bar[XB_XGEN(b.x)], 1u);
            asm volatile("s_waitcnt vmcnt(0)" ::: "memory");
        } else {
            XB_SPIN(xb_ld(&bar[XB_XGEN(b.x)]) == gen, bar);
            __builtin_amdgcn_fence(__ATOMIC_ACQUIRE, "agent");
            asm volatile("s_waitcnt vmcnt(0)" ::: "memory");
        }
    }
    __syncthreads();
}

constexpr int LROW = 144;
constexpr int LTILE = 256 * LROW;
constexpr int LSTAGE = 2 * LTILE;
constexpr int LDS_BYTES = 2 * LSTAGE;

template <int AMODE, int NRB, int NCB>
DI void gemm_acc(f32x16 (&acc)[NRB][NCB], const bf16* __restrict__ A, const long lda, const int arow0,
                 const bf16* __restrict__ Bt, const long ldb, const int brow0, const int K, ldsp lds) {
    int tid_ = threadIdx.x; asm volatile("" : "+v"(tid_));
    const int tid = tid_, lane = tid & 63, w = tid >> 6, wm = w >> 2, wn = w & 3, r = lane & 31, h = lane >> 5;
    const int v = tid & 7, lr = tid >> 3;
    const int avoff = AMODE ? ((v >> 1) * 256 + (v & 1) * 8) : v * 8;
    const int akstep = AMODE ? 1024 : 64;
    const bf16* ag = A + (long)(arow0 + lr) * lda + avoff;
    const bf16* bg = Bt + (long)(brow0 + lr) * ldb + v * 8;
    const int nk = K >> 6;
    u32x4 ra[NRB], rb[2 * NCB];
#pragma unroll
    for (int i = 0; i < NRB; ++i) ra[i] = *(const u32x4*)(ag + (long)i * 64 * lda);
#pragma unroll
    for (int i = 0; i < 2 * NCB; ++i) rb[i] = *(const u32x4*)(bg + (long)i * 64 * ldb);
    ldsp wr = lds + lr * LROW + v * 16;
#pragma unroll
    for (int i = 0; i < NRB; ++i) *(LAS u32x4*)(wr + i * 64 * LROW) = ra[i];
#pragma unroll
    for (int i = 0; i < 2 * NCB; ++i) *(LAS u32x4*)(wr + LTILE + i * 64 * LROW) = rb[i];
    __syncthreads();
    cldsp la = lds + (wm * 32 * NRB + r) * LROW + h * 16;
    cldsp lb = lds + LTILE + (wn * 32 * NCB + r) * LROW + h * 16;
    for (int kt = 0; kt < nk; ++kt) {
        const int buf = kt & 1;
        const bool more = (kt + 1 < nk);
        if (more) {
            ag += akstep; bg += 64;
#pragma unroll
            for (int i = 0; i < NRB; ++i) ra[i] = *(const u32x4*)(ag + (long)i * 64 * lda);
#pragma unroll
            for (int i = 0; i < 2 * NCB; ++i) rb[i] = *(const u32x4*)(bg + (long)i * 64 * ldb);
        }
        __builtin_amdgcn_sched_barrier(0);
        cldsp pa = la + buf * LSTAGE; cldsp pb = lb + buf * LSTAGE;
#pragma unroll
        for (int s = 0; s < 4; ++s) {
            bf16x8 af[NRB], bfr[NCB];
#pragma unroll
            for (int rb_ = 0; rb_ < NRB; ++rb_) af[rb_] = *(const LAS bf16x8*)(pa + rb_ * 32 * LROW + s * 32);
#pragma unroll
            for (int cb = 0; cb < NCB; ++cb) bfr[cb] = *(const LAS bf16x8*)(pb + cb * 32 * LROW + s * 32);
#pragma unroll
            for (int rb_ = 0; rb_ < NRB; ++rb_)
#pragma unroll
                for (int cb = 0; cb < NCB; ++cb) acc[rb_][cb] = MFMA(af[rb_], bfr[cb], acc[rb_][cb]);
        }
        __builtin_amdgcn_sched_barrier(0);
        if (more) {
            ldsp w2 = wr + (buf ^ 1) * LSTAGE;
#pragma unroll
            for (int i = 0; i < NRB; ++i) *(LAS u32x4*)(w2 + i * 64 * LROW) = ra[i];
#pragma unroll
            for (int i = 0; i < 2 * NCB; ++i) *(LAS u32x4*)(w2 + LTILE + i * 64 * LROW) = rb[i];
        }
        __syncthreads();
    }
}
template <int NRB, int NCB>
DI void zero_acc(f32x16 (&acc)[NRB][NCB]) {
#pragma unroll
    for (int a = 0; a < NRB; ++a)
#pragma unroll
        for (int b = 0; b < NCB; ++b)
#pragma unroll
            for (int i = 0; i < 16; ++i) acc[a][b][i] = 0.f;
}
#define ACC_ROW(rb, i) (wm * 128 + (rb) * 32 + ((i) & 3) + 8 * ((i) >> 2) + 4 * h)
#define ACC_COL(cb) (wn * 64 + (cb) * 32 + r)
#define TID_VARS int tid_ = threadIdx.x; asm volatile("" : "+v"(tid_)); const int tid = tid_, lane = tid & 63, w = tid >> 6, wm = w >> 2, wn = w & 3, r = lane & 31, h = lane >> 5; (void)wm; (void)wn; (void)r; (void)h; (void)lane; (void)w;

DI const float* mods_ptr(const Params& p, int cond, int l, int j) { return (const float*)(p.ws + O_MODS) + ((size_t)(cond * 2 + l) * 9 + j) * 1024; }

DI void ffn_a_item(const Params& p, int f, int it, ldsp lds) {
    TID_VARS
    const int nt = it % 22, mt = it / 22;
    f32x16 acc[4][2]; zero_acc<4, 2>(acc);
    gemm_acc<0, 4, 2>(acc, (const bf16*)(p.ws + O_H), 1024, mt * 256, (const bf16*)(p.ws + O_W13) + (unsigned)f * 5632 * 1024, 1024, nt * 256, 1024, lds);
    bf16* hid = (bf16*)(p.ws + O_BIG);
    const int col = nt * 128 + wn * 32 + r;
#pragma unroll
    for (int rb = 0; rb < 4; ++rb)
#pragma unroll
        for (int i = 0; i < 16; ++i) {
            const float g = acc[rb][0][i], u = acc[rb][1][i];
            const int row = mt * 256 + ACC_ROW(rb, i);
            AT(bf16, hid, row * DFF + col) = f2bf(g * sigmoidf_(g) * u);
        }
}
DI void gemm_resid_item(const Params& p, const bf16* A, int lda, const bf16* Bt, int mt, int nt, int k0, int klen, int l, int gate_j, float scale, bool resid_in, bool atomic, ldsp lds) {
    TID_VARS
    f32x16 acc[4][2]; zero_acc<4, 2>(acc);
    gemm_acc<0, 4, 2>(acc, A + k0, lda, mt * 256, Bt + k0, lda, nt * 256, klen, lds);
    const int cond = (mt >= 64) ? 1 : 0;
    const float* gate = mods_ptr(p, cond, l, gate_j);
    float* X = (float*)(p.ws + O_X);
#pragma unroll
    for (int cb = 0; cb < 2; ++cb) {
        const int col = nt * 256 + ACC_COL(cb);
        const float gs = gate[col] * scale;
#pragma unroll
        for (int rb = 0; rb < 4; ++rb)
#pragma unroll
            for (int i = 0; i < 16; ++i) {
                const int row = mt * 256 + ACC_ROW(rb, i);
                if (atomic) {
                    atomicAdd(&AT(float, X, row * D + col), gs * acc[rb][cb][i]);
                } else {
                    float rs;
                    if (resid_in) rs = AT(const float, p.in[I_X], row * D + col);
                    else rs = AT(float, X, row * D + col);
                    AT(float, X, row * D + col) = rs + gs * acc[rb][cb][i];
                }
                if ((i & 7) == 7) asm volatile("" ::: "memory");
            }
    }
}
DI void norm_item(const Params& p, int l, int which, int it) {
    const int tid = threadIdx.x, lane = tid & 63, w = tid >> 6;
    const int row = it * 8 + w;
    const int cond = row >= NL;
    const bool from_in = (l == 0 && which == 0);
    const float* src = from_in ? (cond ? p.in[I_CTX] + (size_t)(row - NL) * D : p.in[I_X] + (size_t)row * D) : (const float*)(p.ws + O_X) + (size_t)row * D;
    f32x4 x[4]; float ss = 0.f;
#pragma unroll
    for (int j = 0; j < 4; ++j) { x[j] = *(const f32x4*)(src + lane * 4 + 256 * j); ss += x[j][0] * x[j][0] + x[j][1] * x[j][1] + x[j][2] * x[j][2] + x[j][3] * x[j][3]; }
    if (from_in && cond) {
        float* xr = (float*)(p.ws + O_X) + (size_t)row * D;
#pragma unroll
        for (int j = 0; j < 4; ++j) *(f32x4*)(xr + lane * 4 + 256 * j) = x[j];
    }
    ss = wave_sum(ss);
    const float rstd = rsqrtf(ss * (1.f / 1024.f) + 1e-6f);
    const float* g = p.in[I_NORMG] + (size_t)(l * 3 + which) * D;
    const float* sh = mods_ptr(p, cond, l, 3 * which), *sc = mods_ptr(p, cond, l, 3 * which + 1);
    bf16* H = (bf16*)(p.ws + O_H) + (size_t)row * D;
#pragma unroll
    for (int j = 0; j < 4; ++j) {
        const int c = lane * 4 + 256 * j;
        const f32x4 gv = *(const f32x4*)(g + c), sv = *(const f32x4*)(sh + c), cv = *(const f32x4*)(sc + c);
        float o[4];
#pragma unroll
        for (int e = 0; e < 4; ++e) o[e] = x[j][e] * rstd * gv[e] * (1.f + cv[e]) + sv[e];
        u32x2 pk; pk.x = pk2(o[0], o[1]); pk.y = pk2(o[2], o[3]);
        *(u32x2*)(H + c) = pk;
    }
}
DI void final_norm_item(const Params& p, int it) {
    const int tid = threadIdx.x, lane = tid & 63, w = tid >> 6;
    const int row = it * 8 + w;
    const float* src = (const float*)(p.ws + O_X) + (size_t)row * D;
    f32x4 x[4]; float ss = 0.f;
#pragma unroll
    for (int j = 0; j < 4; ++j) { x[j] = *(const f32x4*)(src + lane * 4 + 256 * j); ss += x[j][0] * x[j][0] + x[j][1] * x[j][1] + x[j][2] * x[j][2] + x[j][3] * x[j][3]; }
    ss = wave_sum(ss);
    const float rstd = rsqrtf(ss * (1.f / 1024.f) + 1e-6f);
    const float* g = p.in[I_FG];
#pragma unroll
    for (int j = 0; j < 4; ++j) {
        const int c = lane * 4 + 256 * j;
        const f32x4 gv = *(const f32x4*)(g + c);
        f32x4 o;
#pragma unroll
        for (int e = 0; e < 4; ++e) o[e] = x[j][e] * rstd * gv[e];
        *(f32x4*)(p.out + (size_t)row * D + c) = o;
    }
}
DI void inproj_item(const Params& p, int l, int it, ldsp lds) {
    TID_VARS
    const int nt = it % 17, mt = it / 17;
    f32x16 acc[4][2]; zero_acc<4, 2>(acc);
    gemm_acc<0, 4, 2>(acc, (const bf16*)(p.ws + O_H), 1024, mt * 256, (const bf16*)(p.ws + O_WIN), 1024, nt * 256, 1024, lds);
    const int row0 = mt * 256;
    if (nt < 2) {
        bf16* dst = (bf16*)(p.ws + (nt == 0 ? O_A : O_S));
#pragma unroll
        for (int rb = 0; rb < 4; ++rb)
#pragma unroll
            for (int cb = 0; cb < 2; ++cb)
#pragma unroll
                for (int i = 0; i < 16; ++i) AT(bf16, dst, (row0 + ACC_ROW(rb, i)) * 256 + ACC_COL(cb)) = f2bf(acc[rb][cb][i]);
    } else if (nt < 4 || (nt == 4 && wn < 2)) {
        const bool isq = nt < 4;
        const float* gv = p.in[isq ? I_QG : I_KG] + l * 64;
        const float g0 = gv[r], g1 = gv[32 + r];
        const float2* rope = (const float2*)(p.ws + O_ROPE);
        const bool latent = mt < 64;
        const float osc = isq ? 0.125f : 1.f;
        bf16* dst; int ld, cbase;
        if (isq) { dst = (bf16*)(p.ws + O_Q); ld = 512; cbase = (nt - 2) * 256 + wn * 64; } else { dst = (bf16*)(p.ws + O_K); ld = 128; cbase = wn * 64; }
#pragma unroll
        for (int rb = 0; rb < 4; ++rb)
#pragma unroll
            for (int i = 0; i < 16; ++i) {
                const int row = row0 + ACC_ROW(rb, i);
                float v0 = acc[rb][0][i], v1 = acc[rb][1][i];
                float ss = v0 * v0 + v1 * v1;
                ss += __shfl_xor(ss, 1); ss += __shfl_xor(ss, 2); ss += __shfl_xor(ss, 4); ss += __shfl_xor(ss, 8); ss += __shfl_xor(ss, 16);
                const float rstd = rsqrtf(ss * (1.f / 64.f) + 1e-6f);
                v0 = v0 * rstd * g0; v1 = v1 * rstd * g1;
                if (latent) {
                    const float2 cs0 = AT(const float2, rope, (row >> 6) * 16 + (r & 15)), cs1 = AT(const float2, rope, (row & 63) * 16 + (r & 15));
                    const float p0 = __shfl_xor(v0, 16), p1 = __shfl_xor(v1, 16);
                    const float sg = (r & 16) ? 1.f : -1.f;
                    v0 = v0 * cs0.x + sg * p0 * cs0.y;
                    v1 = v1 * cs1.x + sg * p1 * cs1.y;
                }
                AT(bf16, dst, row * ld + cbase + r) = f2bf(v0 * osc);
                AT(bf16, dst, row * ld + cbase + 32 + r) = f2bf(v1 * osc);
                asm volatile("" ::: "memory");
            }
    } else if (nt == 4) {
        bf16* vt = (bf16*)(p.ws + O_VT);
#pragma unroll
        for (int rb = 0; rb < 4; ++rb)
#pragma unroll
            for (int cb = 0; cb < 2; ++cb)
#pragma unroll
                for (int q = 0; q < 4; ++q) {
                    u32x2 pk; pk.x = pk2(acc[rb][cb][4 * q], acc[rb][cb][4 * q + 1]); pk.y = pk2(acc[rb][cb][4 * q + 2], acc[rb][cb][4 * q + 3]);
                    AT(u32x2, vt, (((wn - 2) * 64 + cb * 32 + r) * NT + row0 + wm * 128 + rb * 32 + 8 * q + 4 * h) >> 2) = pk;
                }
    } else {
        bf16* G = (bf16*)(p.ws + O_BIG);
        const int cbase = (nt - 5) * 256;
#pragma unroll
        for (int rb = 0; rb < 4; ++rb)
#pragma unroll
            for (int cb = 0; cb < 2; ++cb)
#pragma unroll
                for (int i = 0; i < 16; ++i) AT(bf16, G, (row0 + ACC_ROW(rb, i)) * 3072 + cbase + ACC_COL(cb)) = f2bf(sigmoidf_(acc[rb][cb][i]));
    }
}
DI void s1_item(const Params& p, int it, ldsp lds) {
    TID_VARS
    const int g = it & 15, mt = it >> 4;
    f32x16 acc[4][2]; zero_acc<4, 2>(acc);
    gemm_acc<1, 4, 2>(acc, (const bf16*)(p.ws + O_S) + g * 16, 8192, mt * 256, (const bf16*)(p.ws + O_W1S) + (unsigned)g * 256 * 512, 512, 0, 512, lds);
    float* E = (float*)(p.ws + O_E);
#pragma unroll
    for (int rb = 0; rb < 4; ++rb)
#pragma unroll
        for (int cb = 0; cb < 2; ++cb)
#pragma unroll
            for (int i = 0; i < 16; ++i) {
                const int c = mt * 256 + ACC_ROW(rb, i);
                if (c < NCH) AT(float, E, (c * 16 + g) * 256 + ACC_COL(cb)) = acc[rb][cb][i];
            }
}
DI void s2_item(const Params& p, int it) {
    const int sidx = it * 512 + threadIdx.x;
    const int g = sidx >> 7, dir = (sidx >> 6) & 1, pp = sidx & 63;
    const float2 aT = ((const float2*)(p.ws + O_PW))[(unsigned)((dir * 16 + g) * 64 + pp) * 33 + 32];
    const float* E = (const float*)(p.ws + O_E) + g * 256 + dir * 128 + pp;
    bf16* C = (bf16*)(p.ws + O_CARRY) + g * 256 + dir * 128 + pp;
    float cr = 0.f, ci = 0.f;
#pragma unroll 8
    for (int n = 0; n < NCH; ++n) {
        int c;
        if (dir == 0) c = (n < 8) ? 512 + n : n - 8;
        else c = 519 - n;
        const float er = E[(unsigned)c * 4096], ei = E[(unsigned)c * 4096 + 64];
        C[(unsigned)c * 4096] = f2bf(cr); C[(unsigned)c * 4096 + 64] = f2bf(ci);
        const float nr = aT.x * cr - aT.y * ci + er, ni = aT.x * ci + aT.y * cr + ei;
        cr = nr; ci = ni;
    }
}
DI float gelu_tanh(float x) { const float u = 0.7978845608028654f * (x + 0.044715f * x * x * x); return x * sigmoidf_(2.f * u); }
DI void s3_item(const Params& p, int it, ldsp lds) {
    TID_VARS
    const int g = it & 15, rest = it >> 4, nt = rest & 1, mt = rest >> 1;
    f32x16 acc[4][2]; zero_acc<4, 2>(acc);
    gemm_acc<1, 4, 2>(acc, (const bf16*)(p.ws + O_S) + g * 16, 8192, mt * 256, (const bf16*)(p.ws + O_TOEP) + (unsigned)g * 512 * 512, 512, nt * 256, 512, lds);
    gemm_acc<0, 4, 2>(acc, (const bf16*)(p.ws + O_CARRY) + g * 256, 4096, mt * 256, (const bf16*)(p.ws + O_W3S) + (unsigned)g * 512 * 256, 256, nt * 256, 256, lds);
    bf16* Ys = (bf16*)(p.ws + O_YS);
#pragma unroll
    for (int rb = 0; rb < 4; ++rb)
#pragma unroll
        for (int cb = 0; cb < 2; ++cb)
#pragma unroll
            for (int i = 0; i < 16; ++i) {
                const int c = mt * 256 + ACC_ROW(rb, i);
                const int n = nt * 256 + ACC_COL(cb), j = n >> 4, hh = n & 15;
                if (c < NCH) AT(bf16, Ys, (c * 32 + j) * 256 + g * 16 + hh) = f2bf(gelu_tanh(acc[rb][cb][i]));
            }
}
DI void pool_item(const Params& p, int it) {
    const int tid = threadIdx.x, cv = tid & 31, rg = tid >> 5;
    const bf16* A = (const bf16*)(p.ws + O_A);
    bf16* Y = (bf16*)(p.ws + O_YP);
    const int half = 1 << (cv >> 3);
#pragma unroll 1
    for (int i = 0; i < 4; ++i) {
        const int row = it * 64 + rg + 16 * i;
        const int base = row >= NL ? NL : 0, n = row >= NL ? NC : NL, t = row - base;
        const int lo = max(t - half, 0), hi = min(t + half, n);
        float s[8];
#pragma unroll
        for (int e = 0; e < 8; ++e) s[e] = 0.f;
        for (int u = lo; u < hi; ++u) {
            const u32x4 v = *(const u32x4*)(A + (unsigned)(base + u) * 256 + cv * 8);
            s[0] += bflo(v.x); s[1] += bfhi(v.x); s[2] += bflo(v.y); s[3] += bfhi(v.y); s[4] += bflo(v.z); s[5] += bfhi(v.z); s[6] += bflo(v.w); s[7] += bfhi(v.w);
        }
        const u32x4 v = *(const u32x4*)(A + (unsigned)row * 256 + cv * 8);
        const float inv = 1.f / (float)(hi - lo);
        u32x4 o;
        o.x = pk2(s[0] * inv - bflo(v.x), s[1] * inv - bfhi(v.x)); o.y = pk2(s[2] * inv - bflo(v.y), s[3] * inv - bfhi(v.y));
        o.z = pk2(s[4] * inv - bflo(v.z), s[5] * inv - bfhi(v.z)); o.w = pk2(s[6] * inv - bflo(v.w), s[7] * inv - bfhi(v.w));
        *(u32x4*)(Y + (unsigned)row * 256 + cv * 8) = o;
    }
}
DI int sig_perm(int r) { return (r & 0x13) | ((r & 4) << 1) | ((r & 8) >> 1); }
template <bool FIXED>
DI void attn_item(const Params& p, int qb, int head, float bound, ldsp lds) {
    TID_VARS
    const int kvh = head >> 2;
    bf16* Q = (bf16*)(p.ws + O_Q);
    const bf16* Kp = (const bf16*)(p.ws + O_K) + kvh * 64;
    const bf16* Vp = (const bf16*)(p.ws + O_VT) + (unsigned)kvh * 64 * NT;
    const int q0 = qb * 256 + w * 32;
    bf16x8 qf[4];
#pragma unroll
    for (int s = 0; s < 4; ++s) qf[s] = *(const bf16x8*)(Q + (unsigned)(q0 + r) * 512 + head * 64 + 16 * s + 8 * h);
    const int key0 = qb < 64 ? 0 : NL, ntile = qb < 64 ? NT / 64 : NC / 64;
    const int isv = tid >> 8, lrow = (tid & 255) >> 3, lv = tid & 7;
    const bf16* gp = isv ? (Vp + (unsigned)lrow * NT + key0 + lv * 8) : (Kp + (unsigned)(key0 + lrow) * 128 + lv * 8);
    const unsigned gstep = isv ? 64u : 64u * 128u, grow = isv ? 32u * NT : 32u * 128u;
    u32x4 rg[2];
#pragma unroll
    for (int i = 0; i < 2; ++i) rg[i] = *(const u32x4*)(gp + i * grow);
    ldsp wr = lds + isv * 9216 + lrow * LROW + lv * 16;
#pragma unroll
    for (int i = 0; i < 2; ++i) *(LAS u32x4*)(wr + i * 32 * LROW) = rg[i];
    __syncthreads();
    f32x16 o0, o1;
#pragma unroll
    for (int i = 0; i < 16; ++i) { o0[i] = 0.f; o1[i] = 0.f; }
    const float L2E = 1.4426950408889634f;
    float m = FIXED ? bound : -1e30f, lsum = 0.f;
    f32x2 ls2 = {0.f, 0.f};
    cldsp lk = lds + sig_perm(r) * LROW + h * 16;
    cldsp lvv = lds + 9216 + r * LROW + h * 16;
    for (int t = 0; t < ntile; ++t) {
        const int buf = t & 1;
        const bool more = t + 1 < ntile;
        if (more) {
            gp += gstep;
#pragma unroll
            for (int i = 0; i < 2; ++i) rg[i] = *(const u32x4*)(gp + i * grow);
        }
        __builtin_amdgcn_sched_barrier(0);
        cldsp pk = lk + buf * 18432; cldsp pv = lvv + buf * 18432;
        f32x16 s0, s1;
#pragma unroll
        for (int i = 0; i < 16; ++i) { s0[i] = 0.f; s1[i] = 0.f; }
#pragma unroll
        for (int s = 0; s < 4; ++s) {
            const bf16x8 k0 = *(const LAS bf16x8*)(pk + s * 32), k1 = *(const LAS bf16x8*)(pk + 32 * LROW + s * 32);
            s0 = MFMA(k0, qf[s], s0); s1 = MFMA(k1, qf[s], s1);
        }
        if (!FIXED) {
            float mx = s0[0];
#pragma unroll
            for (int i = 1; i < 16; ++i) mx = fmaxf(mx, s0[i]);
#pragma unroll
            for (int i = 0; i < 16; ++i) mx = fmaxf(mx, s1[i]);
            mx = fmaxf(mx, __shfl_xor(mx, 32));
            const float mnew = fmaxf(m, mx);
            const float alpha = __builtin_amdgcn_exp2f((m - mnew) * L2E);
            m = mnew;
            ls2 *= alpha;
#pragma unroll
            for (int i = 0; i < 16; ++i) { o0[i] *= alpha; o1[i] *= alpha; }
        }
        const float mb = m * L2E;
        const f32x2 mb2 = {mb, mb}, l2 = {L2E, L2E};
#pragma unroll
        for (int i = 0; i < 16; i += 2) {
            f32x2 a = {s0[i], s0[i + 1]}, b = {s1[i], s1[i + 1]};
            a = a * l2 - mb2; b = b * l2 - mb2;
            a.x = __builtin_amdgcn_exp2f(a.x); a.y = __builtin_amdgcn_exp2f(a.y); b.x = __builtin_amdgcn_exp2f(b.x); b.y = __builtin_amdgcn_exp2f(b.y);
            ls2 += a; ls2 += b;
            s0[i] = a.x; s0[i + 1] = a.y; s1[i] = b.x; s1[i + 1] = b.y;
        }
#pragma unroll
        for (int kb = 0; kb < 2; ++kb)
#pragma unroll
            for (int s = 0; s < 2; ++s) {
                u32x4 pp;
                if (kb == 0) { pp.x = pk2(s0[8 * s], s0[8 * s + 1]); pp.y = pk2(s0[8 * s + 2], s0[8 * s + 3]); pp.z = pk2(s0[8 * s + 4], s0[8 * s + 5]); pp.w = pk2(s0[8 * s + 6], s0[8 * s + 7]); }
                else         { pp.x = pk2(s1[8 * s], s1[8 * s + 1]); pp.y = pk2(s1[8 * s + 2], s1[8 * s + 3]); pp.z = pk2(s1[8 * s + 4], s1[8 * s + 5]); pp.w = pk2(s1[8 * s + 6], s1[8 * s + 7]); }
                const bf16x8 pf = __builtin_bit_cast(bf16x8, pp);
                const bf16x8 v0 = *(const LAS bf16x8*)(pv + (kb * 32 + 16 * s) * 2), v1 = *(const LAS bf16x8*)(pv + 32 * LROW + (kb * 32 + 16 * s) * 2);
                o0 = MFMA(v0, pf, o0); o1 = MFMA(v1, pf, o1);
            }
        __builtin_amdgcn_sched_barrier(0);
        if (more) {
            ldsp w2 = wr + (buf ^ 1) * 18432;
#pragma unroll
            for (int i = 0; i < 2; ++i) *(LAS u32x4*)(w2 + i * 32 * LROW) = rg[i];
        }
        __syncthreads();
    }
    lsum = ls2.x + ls2.y;
    lsum += __shfl_xor(lsum, 32);
    const float inv = 1.f / lsum;
    bf16* orow = Q + (unsigned)(q0 + r) * 512 + head * 64;
#pragma unroll
    for (int q = 0; q < 4; ++q) {
        u32x2 a, b;
        a.x = pk2(o0[4 * q] * inv, o0[4 * q + 1] * inv); a.y = pk2(o0[4 * q + 2] * inv, o0[4 * q + 3] * inv);
        b.x = pk2(o1[4 * q] * inv, o1[4 * q + 1] * inv); b.y = pk2(o1[4 * q + 2] * inv, o1[4 * q + 3] * inv);
        *(u32x2*)(orow + 8 * q + 4 * h) = a;
        *(u32x2*)(orow + 32 + 8 * q + 4 * h) = b;
    }
}
DI float attn_bound(const Params& p, int l) {
    const int lane = threadIdx.x & 63;
    float a = fabsf(p.in[I_QG][l * 64 + lane]), b = fabsf(p.in[I_KG][l * 64 + lane]);
#pragma unroll
    for (int o = 32; o >= 1; o >>= 1) { a = fmaxf(a, __shfl_xor(a, o)); b = fmaxf(b, __shfl_xor(b, o)); }
    return 8.f * 1.02f * a * b;
}
DI void attn_dispatch(const Params& p, int l, int qb, int head, ldsp lds) {
    const float bound = attn_bound(p, l);
    if (bound < 40.f) attn_item<true>(p, qb, head, bound, lds);
    else attn_item<false>(p, qb, head, 0.f, lds);
}
DI void mix1_item(const Params& p, int it, ldsp lds) {
    TID_VARS
    const int nt = it & 7, mt = it >> 3;
    const bf16* G = (const bf16*)(p.ws + O_BIG);
    const int row0 = mt * 128 + wm * 64 + 4 * h, col = nt * 128 + wn * 32 + r;
#define MROW(rb, i) (row0 + (rb) * 32 + ((i) & 3) + 8 * ((i) >> 2))
    f32x16 acc[2][1];
    f32x16 mx[2];
    zero_acc<2, 1>(acc);
    gemm_acc<0, 2, 1>(acc, (const bf16*)(p.ws + O_YS), 256, mt * 128, (const bf16*)(p.ws + O_WGLU), 256, 1024 + nt * 128, 256, lds);
#pragma unroll
    for (int rb = 0; rb < 2; ++rb)
#pragma unroll
        for (int i = 0; i < 16; ++i) mx[rb][i] = sigmoidf_(acc[rb][0][i]) * bf2f(AT(const bf16, G, MROW(rb, i) * 3072 + 1024 + col));
    zero_acc<2, 1>(acc);
    gemm_acc<0, 2, 1>(acc, (const bf16*)(p.ws + O_YS), 256, mt * 128, (const bf16*)(p.ws + O_WGLU), 256, nt * 128, 256, lds);
#pragma unroll
    for (int rb = 0; rb < 2; ++rb)
#pragma unroll
        for (int i = 0; i < 16; ++i) mx[rb][i] *= acc[rb][0][i];
    zero_acc<2, 1>(acc);
    gemm_acc<0, 2, 1>(acc, (const bf16*)(p.ws + O_YP), 256, mt * 128, (const bf16*)(p.ws + O_WP), 256, nt * 128, 256, lds);
#pragma unroll
    for (int rb = 0; rb < 2; ++rb)
#pragma unroll
        for (int i = 0; i < 16; ++i) mx[rb][i] += acc[rb][0][i] * bf2f(AT(const bf16, G, MROW(rb, i) * 3072 + col));
    zero_acc<2, 1>(acc);
    gemm_acc<0, 2, 1>(acc, (const bf16*)(p.ws + O_Q), 512, mt * 128, (const bf16*)(p.ws + O_WAO), 512, nt * 128, 512, lds);
    bf16* M = (bf16*)(p.ws + O_H);
#pragma unroll
    for (int rb = 0; rb < 2; ++rb)
#pragma unroll
        for (int i = 0; i < 16; ++i) {
            const int row = MROW(rb, i);
            const float v = mx[rb][i] + acc[rb][0][i] * bf2f(AT(const bf16, G, row * 3072 + 2048 + col));
            AT(bf16, M, row * D + col) = f2bf(v);
        }
}

DI void conv_tile(const float* src, bf16* dst, int K, int N, int permmode, int tile, ldsp lds) {
    const int tid = threadIdx.x & 255, half = threadIdx.x >> 8;
    tile = tile * 2 + half;
    const int ntn = N / 64, tk = tile / ntn, tn = tile % ntn;
    LAS float* L = (LAS float*)lds + half * (64 * 65);
#pragma unroll
    for (int i = 0; i < 4; ++i) {
        const int kk = (tid >> 4) + 16 * i, c4 = (tid & 15) * 4;
        const f32x4 v = *(const f32x4*)(src + (size_t)(tk * 64 + kk) * N + tn * 64 + c4);
        L[kk * 65 + c4] = v[0]; L[kk * 65 + c4 + 1] = v[1]; L[kk * 65 + c4 + 2] = v[2]; L[kk * 65 + c4 + 3] = v[3];
    }
    __syncthreads();
    const int n = tid >> 2, ks = (tid & 3) * 16;
    int nn = tn * 64 + n;
    if (permmode == 1) { const int hN = N >> 1, b = nn >= hN, hc = b ? nn - hN : nn; nn = 256 * (hc >> 7) + 64 * ((hc >> 5) & 3) + 32 * b + (hc & 31); }
    u32x4 o0, o1;
    o0.x = pk2(L[(ks + 0) * 65 + n], L[(ks + 1) * 65 + n]); o0.y = pk2(L[(ks + 2) * 65 + n], L[(ks + 3) * 65 + n]);
    o0.z = pk2(L[(ks + 4) * 65 + n], L[(ks + 5) * 65 + n]); o0.w = pk2(L[(ks + 6) * 65 + n], L[(ks + 7) * 65 + n]);
    o1.x = pk2(L[(ks + 8) * 65 + n], L[(ks + 9) * 65 + n]); o1.y = pk2(L[(ks + 10) * 65 + n], L[(ks + 11) * 65 + n]);
    o1.z = pk2(L[(ks + 12) * 65 + n], L[(ks + 13) * 65 + n]); o1.w = pk2(L[(ks + 14) * 65 + n], L[(ks + 15) * 65 + n]);
    bf16* d = dst + (size_t)nn * K + tk * 64 + ks;
    *(u32x4*)d = o0; *(u32x4*)(d + 8) = o1;
    __syncthreads();
}
constexpr int CV0 = 704, CV1 = 1408, CV2 = 1760, CV3 = 2112, CV4 = 2656, CV5 = 2720, CV6 = 2784, CV_TOTAL = 2912;
DI void conv_item(const Params& p, int l, int it, ldsp lds) {
    if (it < CV0) conv_tile(p.in[I_W13] + (size_t)(l * 2 + 0) * 1024 * 5632, (bf16*)(p.ws + O_W13), 1024, 5632, 1, it, lds);
    else if (it < CV1) conv_tile(p.in[I_W13] + (size_t)(l * 2 + 1) * 1024 * 5632, (bf16*)(p.ws + O_W13) + (size_t)5632 * 1024, 1024, 5632, 1, it - CV0, lds);
    else if (it < CV2) conv_tile(p.in[I_W2] + (size_t)(l * 2 + 0) * 2816 * 1024, (bf16*)(p.ws + O_W2), 2816, 1024, 0, it - CV1, lds);
    else if (it < CV3) conv_tile(p.in[I_W2] + (size_t)(l * 2 + 1) * 2816 * 1024, (bf16*)(p.ws + O_W2) + (size_t)1024 * 2816, 2816, 1024, 0, it - CV2, lds);
    else if (it < CV4) conv_tile(p.in[I_WIN] + (size_t)l * 1024 * INW, (bf16*)(p.ws + O_WIN), 1024, INW, 0, it - CV3, lds);
    else if (it < CV5) conv_tile(p.in[I_GLU] + (size_t)l * 256 * 2048, (bf16*)(p.ws + O_WGLU), 256, 2048, 0, it - CV4, lds);
    else if (it < CV6) conv_tile(p.in[I_AO] + (size_t)l * 512 * 1024, (bf16*)(p.ws + O_WAO), 512, 1024, 0, it - CV5, lds);
    else conv_tile(p.in[I_WO] + (size_t)l * 1024 * 1024, (bf16*)(p.ws + O_WOUT), 1024, 1024, 0, it - CV6, lds);
}
DI void mod_item(const Params& p, int it, ldsp lds) {
    const int tid = threadIdx.x, lane = tid & 63, w = tid >> 6;
    const int c0 = it * 256 + lane * 4, l = c0 / 9216, col = c0 % 9216;
    const float* W = p.in[I_MODW] + (size_t)l * 1024 * 9216 + col;
    f32x4 a0 = {0.f, 0.f, 0.f, 0.f}, a1 = {0.f, 0.f, 0.f, 0.f};
#pragma unroll 8
    for (int k = w * 128; k < w * 128 + 128; ++k) {
        const f32x4 wv = *(const f32x4*)(W + (size_t)k * 9216);
        const float c = p.in[I_C][k], cc = p.in[I_CCTX][k];
        const float s0 = c * sigmoidf_(c), s1 = cc * sigmoidf_(cc);
        a0 += wv * s0; a1 += wv * s1;
    }
    LAS f32x4* L = (LAS f32x4*)lds;
    L[(w * 64 + lane) * 2] = a0; L[(w * 64 + lane) * 2 + 1] = a1;
    __syncthreads();
    if (w == 0) {
        f32x4 b = *(const f32x4*)(p.in[I_MODB] + (size_t)l * 9216 + col);
        f32x4 r0 = b, r1 = b;
#pragma unroll
        for (int q = 0; q < 8; ++q) { r0 += L[(q * 64 + lane) * 2]; r1 += L[(q * 64 + lane) * 2 + 1]; }
        float* M = (float*)(p.ws + O_MODS);
        *(f32x4*)(M + (size_t)(0 * 2 + l) * 9216 + col) = r0;
        *(f32x4*)(M + (size_t)(1 * 2 + l) * 9216 + col) = r1;
    }
    __syncthreads();
}
DI void pw_item(const Params& p, int l, int it) {
    const int idx = it * 512 + threadIdx.x;
    if (idx >= 2048 * 33) return;
    const int st = idx / 33, e = idx % 33;
    const int dg = st >> 6;
    const double are = p.in[I_ARE][(size_t)l * 2048 + st], aim = p.in[I_AIM][(size_t)l * 2048 + st];
    const double dt = dexp((double)p.in[I_LOGDT][l * 32 + dg]);
    const double mag = dexp(are * dt * e);
    double s, c; dsincos(aim * dt * e, s, c);
    ((float2*)(p.ws + O_PW))[idx] = make_float2((float)(mag * c), (float)(mag * s));
    if (e == 1) {
        const double nr = mag * c - 1.0, ni = mag * s, den = are * are + aim * aim;
        ((float2*)(p.ws + O_CF))[st] = make_float2((float)((nr * are + ni * aim) / den), (float)((ni * are - nr * aim) / den));
    }
}
DI void wp_item(const Params& p, int l, int it) {
    const int k = it >> 1, n = (it & 1) * 512 + threadIdx.x, g = k >> 6, c = k & 63;
    const float* pw = p.in[I_POOLW] + (size_t)l * 4 * 64 * 64 + (size_t)(g * 64 + c) * 64;
    const float* ps = p.in[I_POOLS] + l * 256 + g * 64;
    const float* po = p.in[I_POOLO] + (size_t)l * 256 * 1024 + (size_t)(g * 64) * 1024 + n;
    float s = 0.f;
#pragma unroll 8
    for (int d = 0; d < 64; ++d) s += pw[d] * ps[d] * po[(size_t)d * 1024];
    ((bf16*)(p.ws + O_WP))[(size_t)n * 256 + k] = f2bf(s);
}
DI void rope_item(const Params& p, int it) {
    const int idx = it * 512 + threadIdx.x;
    const int pos = idx >> 4, i = idx & 15;
    const double inv = dexp(-(double)i * (9.210340371976184 / 16.0));
    double s, c; dsincos((double)pos * inv, s, c);
    ((float2*)(p.ws + O_ROPE))[idx] = make_float2((float)c, (float)s);
}
DI void ktab_item(const Params& p, int l, int it, ldsp lds) {
    const int tid = threadIdx.x & 255, half = threadIdx.x >> 8;
    const int lag = (it & 15) * 2 + half, dg = it >> 4;
    LAS f32x2* Wl = (LAS f32x2*)lds + half * 64;
    if (tid < 64) {
        const float2 z = ((const float2*)(p.ws + O_PW))[(size_t)(dg * 64 + tid) * 33 + lag], cf = ((const float2*)(p.ws + O_CF))[dg * 64 + tid];
        Wl[tid] = (f32x2){z.x * cf.x - z.y * cf.y, z.x * cf.y + z.y * cf.x};
    }
    __syncthreads();
    const int hp = tid >> 4, hh = tid & 15;
    const size_t pb = (size_t)(l * 32 + dg) * 1024;
    const float* cre = p.in[I_CRE] + pb + hp * 64, *cim = p.in[I_CIM] + pb + hp * 64;
    const float* bre = p.in[I_BRE] + pb + hh, *bim = p.in[I_BIM] + pb + hh;
    float s = 0.f;
#pragma unroll 8
    for (int q = 0; q < 64; ++q) {
        const f32x2 wv = Wl[q];
        const float br = bre[q * 16], bi = bim[q * 16];
        const float tr = wv.x * br - wv.y * bi, ti = wv.x * bi + wv.y * br;
        s += cre[q] * tr - cim[q] * ti;
    }
    ((float*)(p.ws + O_KTAB))[(size_t)(dg * 32 + lag) * 256 + tid] = s;
    __syncthreads();
}
DI void w1_item(const Params& p, int l, int it) {
    const int idx = it * 512 + threadIdx.x;
    const int k8 = idx & 63, n = (idx >> 6) & 255, g = idx >> 14;
    const int dir = n >> 7, ri = (n >> 6) & 1, pp = n & 63, j = k8 >> 1, h0 = (k8 & 1) * 8;
    const int e = dir ? j : 31 - j, st = (dir * 16 + g) * 64 + pp;
    const float2 z = ((const float2*)(p.ws + O_PW))[(size_t)st * 33 + e], cf = ((const float2*)(p.ws + O_CF))[st];
    const float wr = z.x * cf.x - z.y * cf.y, wi = z.x * cf.y + z.y * cf.x;
    const float* bre = p.in[I_BRE] + (size_t)(l * 32 + dir * 16 + g) * 1024 + pp * 16 + h0;
    const float* bim = p.in[I_BIM] + (size_t)(l * 32 + dir * 16 + g) * 1024 + pp * 16 + h0;
    float o[8];
#pragma unroll
    for (int q = 0; q < 8; ++q) o[q] = ri ? (wr * bim[q] + wi * bre[q]) : (wr * bre[q] - wi * bim[q]);
    u32x4 v; v.x = pk2(o[0], o[1]); v.y = pk2(o[2], o[3]); v.z = pk2(o[4], o[5]); v.w = pk2(o[6], o[7]);
    *(u32x4*)((bf16*)(p.ws + O_W1S) + ((size_t)g * 256 + n) * 512 + k8 * 8) = v;
}
DI void w3_item(const Params& p, int l, int it) {
    const int idx = it * 512 + threadIdx.x;
    const int k8 = idx & 31, n = (idx >> 5) & 511, g = idx >> 14;
    const int dir = k8 >> 4, ri = (k8 >> 3) & 1, p0 = (k8 & 7) * 8, j = n >> 4, hp = n & 15;
    const int e = dir ? 32 - j : j + 1;
    const float* cre = p.in[I_CRE] + (size_t)(l * 32 + dir * 16 + g) * 1024 + hp * 64 + p0;
    const float* cim = p.in[I_CIM] + (size_t)(l * 32 + dir * 16 + g) * 1024 + hp * 64 + p0;
    const float2* pw = (const float2*)(p.ws + O_PW) + (size_t)((dir * 16 + g) * 64 + p0) * 33 + e;
    float o[8];
#pragma unroll
    for (int q = 0; q < 8; ++q) { const float2 z = pw[q * 33]; o[q] = ri ? -(cre[q] * z.y + cim[q] * z.x) : (cre[q] * z.x - cim[q] * z.y); }
    u32x4 v; v.x = pk2(o[0], o[1]); v.y = pk2(o[2], o[3]); v.z = pk2(o[4], o[5]); v.w = pk2(o[6], o[7]);
    *(u32x4*)((bf16*)(p.ws + O_W3S) + ((size_t)g * 512 + n) * 256 + k8 * 8) = v;
}
DI void toep_item(const Params& p, int l, int it) {
    const int idx = it * 512 + threadIdx.x;
    const int k8 = idx & 63, n = (idx >> 6) & 511, g = idx >> 15;
    const int j2 = k8 >> 1, h0 = (k8 & 1) * 8, j = n >> 4, hp = n & 15;
    const float* KT = (const float*)(p.ws + O_KTAB);
    float o[8];
#pragma unroll
    for (int q = 0; q < 8; ++q) o[q] = 0.f;
    if (j2 <= j) { const float* kf = KT + ((size_t)(0 * 16 + g) * 32 + (j - j2)) * 256 + hp * 16 + h0;
#pragma unroll
        for (int q = 0; q < 8; ++q) o[q] += kf[q]; }
    if (j2 >= j) { const float* kb = KT + ((size_t)(1 * 16 + g) * 32 + (j2 - j)) * 256 + hp * 16 + h0;
#pragma unroll
        for (int q = 0; q < 8; ++q) o[q] += kb[q]; }
    if (j2 == j) {
        const float dd = p.in[I_SD][l * 256 + g * 16 + hp];
#pragma unroll
        for (int q = 0; q < 8; ++q) if (h0 + q == hp) o[q] += dd;
    }
    u32x4 v; v.x = pk2(o[0], o[1]); v.y = pk2(o[2], o[3]); v.z = pk2(o[4], o[5]); v.w = pk2(o[6], o[7]);
    *(u32x4*)((bf16*)(p.ws + O_TOEP) + ((size_t)g * 512 + n) * 512 + k8 * 8) = v;
}

constexpr int PH_PER_LAYER = 14, N_PHASES = 2 * PH_PER_LAYER + 1;
#define SUBLOOP(n, call) { for (int it = ((b - off) % G + G) % G; it < (n); it += G) { call; } off = (off + (n)) % G; }
DI void run_phase(const Params& p, const int ph, ldsp lds) {
    const int G = gridDim.x, b = blockIdx.x;
    if (ph == 2 * PH_PER_LAYER) { for (int it = b; it < NL / 8; it += G) final_norm_item(p, it); return; }
    const int l = ph / PH_PER_LAYER, s = ph % PH_PER_LAYER;
    const int mtiles = (l == 1) ? 64 : 65;
    const bf16* HID = (const bf16*)(p.ws + O_BIG);
    const bf16* W2 = (const bf16*)(p.ws + O_W2);
    int off = 0;
#ifdef ONLY_S
    if (s != ONLY_S) return;
#endif
    switch (s) {
    case 0: {
        SUBLOOP(((l == 0) ? 72 : 0), mod_item(p, it, lds))
        SUBLOOP(132, pw_item(p, l, it))
        SUBLOOP(512, wp_item(p, l, it))
        SUBLOOP(((l == 0) ? 8 : 0), rope_item(p, it))
        SUBLOOP(CV_TOTAL, conv_item(p, l, it, lds))
    } break;
    case 1: {
        SUBLOOP(512, ktab_item(p, l, it, lds))
        SUBLOOP(512, w1_item(p, l, it))
        SUBLOOP(512, w3_item(p, l, it))
        SUBLOOP(NT / 8, norm_item(p, l, 0, it))
    } break;
    case 2: SUBLOOP(65 * 22, ffn_a_item(p, 0, it, lds)) break;
    case 3: {
        SUBLOOP(44, gemm_resid_item(p, HID, DFF, W2, 64, it & 3, (it >> 2) * 256, 256, l, 2, 0.5f, false, true, lds))
        SUBLOOP(256, gemm_resid_item(p, HID, DFF, W2, it >> 2, it & 3, 0, DFF, l, 2, 0.5f, l == 0, false, lds))
    } break;
    case 4: {
        SUBLOOP(1024, toep_item(p, l, it))
        SUBLOOP(NT / 8, norm_item(p, l, 1, it))
    } break;
    case 5: SUBLOOP(65 * 17, inproj_item(p, l, it, lds)) break;
    case 6: {
        SUBLOOP(48, s1_item(p, it, lds))
        SUBLOOP(mtiles * 4, pool_item(p, it))
        SUBLOOP(((l == 0) ? 8 : 0), attn_dispatch(p, l, 64, it, lds))
    } break;
    case 7: {
        SUBLOOP(4, s2_item(p, it))
        SUBLOOP(512, attn_dispatch(p, l, it >> 3, it & 7, lds))
    } break;
    case 8: SUBLOOP(96, s3_item(p, it, lds)) break;
    case 9: SUBLOOP(mtiles * 16, mix1_item(p, it, lds)) break;
    case 10: {
        SUBLOOP(((l == 0) ? 16 : 0), gemm_resid_item(p, (const bf16*)(p.ws + O_H), D, (const bf16*)(p.ws + O_WOUT), 64, it & 3, (it >> 2) * 256, 256, l, 5, 1.0f, false, true, lds))
        SUBLOOP(256, gemm_resid_item(p, (const bf16*)(p.ws + O_H), D, (const bf16*)(p.ws + O_WOUT), it >> 2, it & 3, 0, D, l, 5, 1.0f, false, false, lds))
    } break;
    case 11: SUBLOOP(mtiles * 32, norm_item(p, l, 2, it)) break;
    case 12: SUBLOOP(mtiles * 22, ffn_a_item(p, 1, it, lds)) break;
    case 13: {
        SUBLOOP(((l == 0) ? 44 : 0), gemm_resid_item(p, HID, DFF, W2 + (size_t)1024 * DFF, 64, it & 3, (it >> 2) * 256, 256, l, 8, 0.5f, false, true, lds))
        SUBLOOP(256, gemm_resid_item(p, HID, DFF, W2 + (size_t)1024 * DFF, it >> 2, it & 3, 0, DFF, l, 8, 0.5f, false, false, lds))
    } break;
    }
}

__global__ void __launch_bounds__(512, 2) hybrid_fwd(Params p, int ph_lo, int ph_hi) {
    __shared__ __attribute__((aligned(16))) char lds_raw[LDS_BYTES];
    ldsp lds = (ldsp)lds_raw;
    __shared__ uint4 xb_words;
    if (p.ws == nullptr) cg::this_grid().sync();
    XcdBarrier bar;
    const bool multi = (ph_hi - ph_lo) > 1;
    if (multi) {
        if (threadIdx.x == 0) xb_words = make_uint4(0u, 0u, 0u, 0u);
        __syncthreads();
        bar = xcd_barrier_post((unsigned*)(p.ws + O_BAR), (volatile LAS unsigned*)&xb_words);
    }
#define PH(k) if (ph_lo <= (k) && (k) < ph_hi) { if ((k) > ph_lo) xcd_barrier(bar); run_phase(p, (k), lds); }
    PH(0) PH(1) PH(2) PH(3) PH(4) PH(5) PH(6) PH(7) PH(8) PH(9) PH(10) PH(11) PH(12) PH(13)
    PH(14) PH(15) PH(16) PH(17) PH(18) PH(19) PH(20) PH(21) PH(22) PH(23) PH(24) PH(25) PH(26) PH(27) PH(28)
}

extern "C" void kernel_launch(void* const* d_in, const int* in_sizes, int n_in, void* d_out, int out_size, void* d_ws, size_t ws_size, hipStream_t stream) {
    (void)in_sizes; (void)n_in; (void)out_size;
    if (ws_size < O_END) { fprintf(stderr, "workspace too small: %zu < %zu\n", ws_size, (size_t)O_END); return; }
    static int grid_blocks = 0;
    if (!grid_blocks) {
        int dev = 0, cus = 0, per_cu = 0;
        (void)hipGetDevice(&dev);
        (void)hipDeviceGetAttribute(&cus, hipDeviceAttributeMultiprocessorCount, dev);
        (void)hipOccupancyMaxActiveBlocksPerMultiprocessor(&per_cu, hybrid_fwd, 512, 0);
        if (per_cu > 1) per_cu = 1;
        if (per_cu < 1) per_cu = 1;
        grid_blocks = cus * per_cu;
    }
    Params p{};
    for (int i = 0; i < 27; ++i) p.in[i] = (const float*)d_in[i];
    p.out = (float*)d_out; p.ws = (char*)d_ws;
#if MK_ONE_LAUNCH
    (void)hipMemsetAsync(d_ws, 0, 16384, stream);
    int lo = 0, hi = N_PHASES;
    void* args[] = {&p, &lo, &hi};
    hipError_t e = hipLaunchCooperativeKernel((void*)hybrid_fwd, dim3(grid_blocks), dim3(512), args, 0, stream);
    if (e != hipSuccess) fprintf(stderr, "cooperative launch failed: %s (grid %d)\n", hipGetErrorString(e), grid_blocks);
#else
    for (int ph = 0; ph < N_PHASES; ++ph) hipLaunchKernelGGL(hybrid_fwd, dim3(grid_blocks), dim3(512), 0, stream, p, ph, ph + 1);
#endif
}
```

```cpp
#include <hip/hip_runtime.h>
#include <hip/hip_cooperative_groups.h>
#include <cstdio>
#include <cstdint>
namespace cg = cooperative_groups;

#define DI __device__ __forceinline__
#define LAS __attribute__((address_space(3)))
typedef __attribute__((address_space(3))) char* ldsp;
typedef const __attribute__((address_space(3))) char* cldsp;
typedef unsigned short bf16;
typedef short bf16x8 __attribute__((ext_vector_type(8)));
typedef float f32x16 __attribute__((ext_vector_type(16)));
typedef float f32x4 __attribute__((ext_vector_type(4)));
typedef float f32x2 __attribute__((ext_vector_type(2)));
typedef unsigned u32x4 __attribute__((ext_vector_type(4)));
typedef unsigned u32x2 __attribute__((ext_vector_type(2)));
typedef __bf16 hbf2 __attribute__((ext_vector_type(2)));

#ifndef MK_ONE_LAUNCH
#define MK_ONE_LAUNCH 1
#endif

constexpr int D = 1024, NL = 16384, NC = 256, NT = NL + NC, DFF = 2816, INW = 4352;
constexpr int NCH = NT / 32;

enum { I_X = 0, I_C, I_CTX, I_CCTX, I_MODW, I_MODB, I_NORMG, I_W13, I_W2, I_WIN, I_POOLW, I_POOLS, I_POOLO, I_ARE, I_AIM, I_LOGDT,
       I_BRE, I_BIM, I_CRE, I_CIM, I_SD, I_GLU, I_QG, I_KG, I_AO, I_WO, I_FG };

constexpr size_t al(size_t x) { return (x + 255) & ~(size_t)255; }
constexpr size_t O_BAR = 0;
constexpr size_t O_X = 32768;
constexpr size_t O_H = O_X + al((size_t)NT * D * 4);
constexpr size_t O_BIG = O_H + al((size_t)NT * D * 2);
constexpr size_t O_Q = O_BIG + al((size_t)NT * 3072 * 2);
constexpr size_t O_K = O_Q + al((size_t)NT * 512 * 2);
constexpr size_t O_VT = O_K + al((size_t)NT * 128 * 2);
constexpr size_t O_A = O_VT + al((size_t)NT * 128 * 2);
constexpr size_t O_S = O_A + al((size_t)NT * 256 * 2);
constexpr size_t O_YP = O_S + al((size_t)NT * 256 * 2);
constexpr size_t O_YS = O_YP + al((size_t)NT * 256 * 2);
constexpr size_t O_CARRY = O_YS + al((size_t)NT * 256 * 2);
constexpr size_t O_E = O_CARRY + al((size_t)NCH * 16 * 256 * 2);
constexpr size_t O_W13 = O_E + al((size_t)NCH * 16 * 256 * 4);
constexpr size_t O_W2 = O_W13 + al((size_t)2 * 5632 * 1024 * 2);
constexpr size_t O_WIN = O_W2 + al((size_t)2 * 1024 * 2816 * 2);
constexpr size_t O_WGLU = O_WIN + al((size_t)INW * 1024 * 2);
constexpr size_t O_WAO = O_WGLU + al((size_t)2048 * 256 * 2);
constexpr size_t O_WOUT = O_WAO + al((size_t)1024 * 512 * 2);
constexpr size_t O_WP = O_WOUT + al((size_t)1024 * 1024 * 2);
constexpr size_t O_TOEP = O_WP + al((size_t)1024 * 256 * 2);
constexpr size_t O_W1S = O_TOEP + al((size_t)16 * 512 * 512 * 2);
constexpr size_t O_W3S = O_W1S + al((size_t)16 * 256 * 512 * 2);
constexpr size_t O_KTAB = O_W3S + al((size_t)16 * 512 * 256 * 2);
constexpr size_t O_PW = O_KTAB + al((size_t)2 * 16 * 32 * 256 * 4);
constexpr size_t O_CF = O_PW + al((size_t)2048 * 33 * 8);
constexpr size_t O_MODS = O_CF + al((size_t)2048 * 8);
constexpr size_t O_ROPE = O_MODS + al((size_t)2 * 2 * 9216 * 4);
constexpr size_t O_END = O_ROPE + al((size_t)256 * 16 * 8);

struct Params { const float* in[27]; float* out; char* ws; };

DI unsigned pk2(float a, float b) { f32x2 v = {a, b}; return __builtin_bit_cast(unsigned, __builtin_convertvector(v, hbf2)); }
DI bf16 f2bf(float a) { return (bf16)(pk2(a, 0.f) & 0xffffu); }
DI float bf2f(bf16 b) { return __uint_as_float(((unsigned)b) << 16); }
DI float bflo(unsigned u) { return __uint_as_float(u << 16); }
DI float bfhi(unsigned u) { return __uint_as_float(u & 0xffff0000u); }
DI float sigmoidf_(float x) { return __builtin_amdgcn_rcpf(1.f + __builtin_amdgcn_exp2f(-1.4426950408889634f * x)); }
DI float wave_sum(float v) {
#pragma unroll
    for (int o = 32; o >= 1; o >>= 1) v += __shfl_xor(v, o);
    return v;
}
#define AT(T, base, idx) (*(T*)((char*)(base) + (unsigned)((unsigned)(idx) * (unsigned)sizeof(T))))
#define MFMA(a, b, c) __builtin_amdgcn_mfma_f32_32x32x16_bf16((a), (b), (c), 0, 0, 0)

DI double dexp(double x) {
    const double n = __builtin_rint(x * 1.4426950408889634);
    const double r = x - n * 0.6931471805599453;
    double t = 1.0;
#pragma unroll
    for (int k = 16; k >= 1; --k) t = 1.0 + t * r * (1.0 / (double)k);
    const long long e = (long long)n + 1023;
    return t * __longlong_as_double(e << 52);
}
DI void dsincos(double th, double& s, double& c) {
    const double k = __builtin_rint(th * 0.15915494309189535);
    const double x = th - k * 6.283185307179586 - k * 2.4492935982947064e-16;
    const double x2 = x * x;
    double cs = 1.0, sn = 1.0;
#pragma unroll
    for (int j = 17; j >= 1; --j) {
        cs = 1.0 - cs * x2 * (1.0 / (double)((2 * j - 1) * (2 * j)));
        sn = 1.0 - sn * x2 * (1.0 / (double)((2 * j) * (2 * j + 1)));
    }
    c = cs; s = sn * x;
}

#define XB_TMO      128
#define XB_XCNT(j)  (256  + 64 * (j))
#define XB_XSUB(j)  (1280 + 64 * (j))
#define XB_XGEN(j)  (2304 + 64 * (j))
#define XB_TOP      3328
#define XB_TOPGEN   3392
#define XCD_BAR_WORDS 3456
#define XB_SPIN_CAP (1u << 22)
DI unsigned xb_ld(unsigned* p)              { return __hip_atomic_load(p, __ATOMIC_RELAXED, __HIP_MEMORY_SCOPE_AGENT); }
DI unsigned xb_add(unsigned* p, unsigned v) { return __hip_atomic_fetch_add(p, v, __ATOMIC_RELAXED, __HIP_MEMORY_SCOPE_AGENT); }
DI unsigned xb_xcc_id() { return (unsigned)__builtin_amdgcn_s_getreg((3 << 11) | 20) & 0xFu; }
#define XB_SPIN(cond, bar) do { unsigned _sp = 0; while (cond) { __builtin_amdgcn_s_sleep(1); \
    if ((++_sp & 255u) == 0u) { if (xb_ld(&(bar)[XB_TMO])) break; if (_sp > XB_SPIN_CAP) { atomicAdd(&(bar)[XB_TMO], 1u); break; } } } } while (0)
struct XcdBarrier { unsigned* bar; unsigned x; volatile LAS unsigned* st; };
DI XcdBarrier xcd_barrier_post(unsigned* bar, volatile LAS unsigned* st) {
    XcdBarrier b; b.bar = bar; b.x = xb_xcc_id(); b.st = st;
    if (threadIdx.x == 0) (void)xb_add(&bar[XB_XCNT(b.x)], 1u);
    return b;
}
DI void xcd_barrier_complete(unsigned* bar, unsigned x, unsigned& nloc, unsigned& nx) {
    const unsigned G = gridDim.x * gridDim.y * gridDim.z;
    unsigned sum, cnt, mine, sp = 0u;
    for (;;) {
        sum = 0u; cnt = 0u; mine = 0u;
#pragma unroll
        for (unsigned j = 0; j < 16; ++j) { const unsigned c = xb_ld(&bar[XB_XCNT(j)]); sum += c; cnt += (c > 0u) ? 1u : 0u; mine = (j == x) ? c : mine; }
        if (sum == G) break;
        __builtin_amdgcn_s_sleep(1);
        if ((++sp & 255u) == 0u) { if (xb_ld(&bar[XB_TMO])) break; if (sp > XB_SPIN_CAP) { atomicAdd(&bar[XB_TMO], 1u); break; } }
    }
    nloc = mine > 0u ? mine : 1u; nx = cnt > 0u ? cnt : 1u;
}
DI void xcd_barrier(const XcdBarrier& b) {
    asm volatile("s_waitcnt vmcnt(0)" ::: "memory");
    __syncthreads();
    if (threadIdx.x == 0) {
        unsigned* bar = b.bar;
        __builtin_amdgcn_s_waitcnt(0);
        unsigned nloc = b.st[0], nx = b.st[1];
        if (nloc == 0u) { xcd_barrier_complete(bar, b.x, nloc, nx); b.st[0] = nloc; b.st[1] = nx; }
        const unsigned old = xb_add(&bar[XB_XSUB(b.x)], 1u);
        const unsigned gen = old / nloc;
        if (old + 1u == (gen + 1u) * nloc) {
            __builtin_amdgcn_fence(__ATOMIC_RELEASE, "agent");
            asm volatile("s_waitcnt vmcnt(0)" ::: "memory");
            const unsigned og = xb_add(&bar[XB_TOP], 1u);
            const unsigned tg = og / nx;
            if (og + 1u == (tg + 1u) * nx) xb_add(&bar[XB_TOPGEN], 1u);
            else XB_SPIN(xb_ld(&bar[XB_TOPGEN]) == tg, bar);
            __builtin_amdgcn_fence(__ATOMIC_ACQUIRE, "agent");
            xb_add(&bar[XB_XGEN(b.x)], 1u);
            asm volatile("s_waitcnt vmcnt(0)" ::: "memory");
        } else {
            XB_SPIN(xb_ld(&bar[XB_XGEN(b.x)]) == gen, bar);
            __builtin_amdgcn_fence(__ATOMIC_ACQUIRE, "agent");
            asm volatile("s_waitcnt vmcnt(0)" ::: "memory");
        }
    }
    __syncthreads();
}


#define XB_CNT(k) (3584 + 64 * (k))
DI void signal_count(unsigned* w) {
    asm volatile("s_waitcnt vmcnt(0)" ::: "memory");
    __syncthreads();
    if (threadIdx.x == 0) { __builtin_amdgcn_fence(__ATOMIC_RELEASE, "agent"); asm volatile("s_waitcnt vmcnt(0)" ::: "memory"); (void)xb_add(w, 1u); }
}
DI void wait_count(unsigned* w, unsigned target) {
    if (threadIdx.x == 0) {
        unsigned sp = 0;
        while (xb_ld(w) < target) { __builtin_amdgcn_s_sleep(4); if (++sp > (1u << 24)) break; }
        __builtin_amdgcn_fence(__ATOMIC_ACQUIRE, "agent");
        asm volatile("s_waitcnt vmcnt(0)" ::: "memory");
    }
    __syncthreads();
}

constexpr int LROW = 144;
constexpr int LTILE = 256 * LROW;
constexpr int LSTAGE = 2 * LTILE;
constexpr int LDS_BYTES = 2 * LSTAGE;

template <int AMODE, int NRB, int NCB>
DI void gemm_acc(f32x16 (&acc)[NRB][NCB], const bf16* __restrict__ A, const long lda, const int arow0,
                 const bf16* __restrict__ Bt, const long ldb, const int brow0, const int K, ldsp lds) {
    int tid_ = threadIdx.x; asm volatile("" : "+v"(tid_));
    const int tid = tid_, lane = tid & 63, w = tid >> 6, wm = w >> 2, wn = w & 3, r = lane & 31, h = lane >> 5;
    const int v = tid & 7, lr = tid >> 3;
    const int avoff = AMODE ? ((v >> 1) * 256 + (v & 1) * 8) : v * 8;
    const int akstep = AMODE ? 1024 : 64;
    const bf16* ag = A + (long)(arow0 + lr) * lda + avoff;
    const bf16* bg = Bt + (long)(brow0 + lr) * ldb + v * 8;
    const int nk = K >> 6;
    u32x4 ra[NRB], rb[2 * NCB];
#pragma unroll
    for (int i = 0; i < NRB; ++i) ra[i] = *(const u32x4*)(ag + (long)i * 64 * lda);
#pragma unroll
    for (int i = 0; i < 2 * NCB; ++i) rb[i] = *(const u32x4*)(bg + (long)i * 64 * ldb);
    ldsp wr = lds + lr * LROW + v * 16;
#pragma unroll
    for (int i = 0; i < NRB; ++i) *(LAS u32x4*)(wr + i * 64 * LROW) = ra[i];
#pragma unroll
    for (int i = 0; i < 2 * NCB; ++i) *(LAS u32x4*)(wr + LTILE + i * 64 * LROW) = rb[i];
    __syncthreads();
    cldsp la = lds + (wm * 32 * NRB + r) * LROW + h * 16;
    cldsp lb = lds + LTILE + (wn * 32 * NCB + r) * LROW + h * 16;
    for (int kt = 0; kt < nk; ++kt) {
        const int buf = kt & 1;
        const bool more = (kt + 1 < nk);
        if (more) {
            ag += akstep; bg += 64;
#pragma unroll
            for (int i = 0; i < NRB; ++i) ra[i] = *(const u32x4*)(ag + (long)i * 64 * lda);
#pragma unroll
            for (int i = 0; i < 2 * NCB; ++i) rb[i] = *(const u32x4*)(bg + (long)i * 64 * ldb);
        }
        __builtin_amdgcn_sched_barrier(0);
        cldsp pa = la + buf * LSTAGE; cldsp pb = lb + buf * LSTAGE;
#pragma unroll
        for (int s = 0; s < 4; ++s) {
            bf16x8 af[NRB], bfr[NCB];
#pragma unroll
            for (int rb_ = 0; rb_ < NRB; ++rb_) af[rb_] = *(const LAS bf16x8*)(pa + rb_ * 32 * LROW + s * 32);
#pragma unroll
            for (int cb = 0; cb < NCB; ++cb) bfr[cb] = *(const LAS bf16x8*)(pb + cb * 32 * LROW + s * 32);
#pragma unroll
            for (int rb_ = 0; rb_ < NRB; ++rb_)
#pragma unroll
                for (int cb = 0; cb < NCB; ++cb) acc[rb_][cb] = MFMA(af[rb_], bfr[cb], acc[rb_][cb]);
        }
        __builtin_amdgcn_sched_barrier(0);
        if (more) {
            ldsp w2 = wr + (buf ^ 1) * LSTAGE;
#pragma unroll
            for (int i = 0; i < NRB; ++i) *(LAS u32x4*)(w2 + i * 64 * LROW) = ra[i];
#pragma unroll
            for (int i = 0; i < 2 * NCB; ++i) *(LAS u32x4*)(w2 + LTILE + i * 64 * LROW) = rb[i];
        }
        __syncthreads();
    }
}
template <int NRB, int NCB>
DI void zero_acc(f32x16 (&acc)[NRB][NCB]) {
#pragma unroll
    for (int a = 0; a < NRB; ++a)
#pragma unroll
        for (int b = 0; b < NCB; ++b)
#pragma unroll
            for (int i = 0; i < 16; ++i) acc[a][b][i] = 0.f;
}
#define ACC_ROW(rb, i) (wm * 128 + (rb) * 32 + ((i) & 3) + 8 * ((i) >> 2) + 4 * h)
#define ACC_COL(cb) (wn * 64 + (cb) * 32 + r)
#define TID_VARS int tid_ = threadIdx.x; asm volatile("" : "+v"(tid_)); const int tid = tid_, lane = tid & 63, w = tid >> 6, wm = w >> 2, wn = w & 3, r = lane & 31, h = lane >> 5; (void)wm; (void)wn; (void)r; (void)h; (void)lane; (void)w;

DI const float* mods_ptr(const Params& p, int cond, int l, int j) { return (const float*)(p.ws + O_MODS) + ((size_t)(cond * 2 + l) * 9 + j) * 1024; }


namespace pg8 {
#define PG8_LAS __attribute__((address_space(3)))
typedef unsigned short bf16_t;
typedef short bf16x8 __attribute__((ext_vector_type(8)));
typedef float f32x4 __attribute__((ext_vector_type(4)));
typedef unsigned u32x4 __attribute__((ext_vector_type(4)));
constexpr int BM = 256, BK = 64, HALF = 128, HTB = HALF * BK * 2  , STAGE_BYTES = 8 * HTB, NXCD = 8, WGM = 8;

__host__ __device__ __forceinline__ int lds_byte(int r, int c) { const int st = (r >> 4) * 2 + (c >> 5), rr = r & 15, cc = c & 31, ob = rr * 64 + cc * 2; return st * 1024 + (ob ^ (((ob >> 9) & 1) << 5)); }
__host__ __device__ __forceinline__ void stage_rc(int b, int& R, int& C) { const int st = b / 1024, sb = b % 1024, swz = sb ^ (((sb >> 9) & 1) << 5); R = (st >> 1) * 16 + swz / 64; C = (st & 1) * 32 + (swz % 64) / 2; }
__host__ __device__ __forceinline__ int perm32(int rho) { const int n = rho >> 4, i = rho & 15; return 8 * (i >> 2) + 4 * n + (i & 3); }

struct Unit { int pm, pn; };
struct Gemm { const bf16_t* A; const bf16_t* Bt; int K, ld; };

struct StaticOrder {
    int nM, nN, nwg, G, c;
    __host__ __device__ void init(int M, int N, int G_, int c_) { nM = M / BM; nN = N / BM; nwg = nM * nN; G = G_; c = c_; }
    __host__ __device__ bool next(int i, Unit& u) const {
        const long L = (long)i * G + c; if (L >= nwg) return false;
        int wgid = (int)L; { const int q = nwg / NXCD, r = nwg % NXCD, xcd = wgid % NXCD, off = wgid / NXCD; wgid = (xcd < r ? xcd * (q + 1) : r * (q + 1) + (xcd - r) * q) + off; }
        const int nig = WGM * nN, gid = wgid / nig, fm = gid * WGM, gsz = (nM - fm) < WGM ? (nM - fm) : WGM;
        u.pm = fm + ((wgid % nig) % gsz); u.pn = (wgid % nig) / gsz; return true;
    }
    __device__ __forceinline__ void a_ready(const Unit&) const {}
    __device__ __forceinline__ void done(const Unit&) const {}
};

template <class Epi, class Sched, bool ALIGN_EPI = false, bool SP2 = false>
__device__ __forceinline__ void gemm_phase(PG8_LAS unsigned char* lds, const Gemm g, const Sched& S, const Epi& E) {
    int tid_ = threadIdx.x; asm volatile("" : "+v"(tid_));
    const int tid = tid_, wid = __builtin_amdgcn_readfirstlane(tid >> 6), lane = tid & 63, wr = wid >> 2, wc = wid & 3, fr = lane & 15, fq = lane >> 4;
    int K_ = g.K; asm volatile("" : "+s"(K_));
    const int K = K_, nt = K / BK;
    unsigned voffA[2], voffB[2];
#pragma unroll
    for (int i = 0; i < 2; ++i) { int R, C; stage_rc(tid * 16 + i * 8192, R, C); const int Rb = Epi::PERM ? ((R & ~31) + perm32(R & 31)) : R;
        voffA[i] = (unsigned)(R * g.ld + C) * 2u; voffB[i] = (unsigned)(Rb * g.ld + C) * 2u; }
    const size_t kstep = (size_t)(BK * 2);
    const size_t hstep = (size_t)HALF * g.ld * 2;
    const size_t tstep = 2 * hstep;
    const unsigned ldsw = (unsigned)wid * 1024u;
    const int aoff = lds_byte(wr * 64 + fr, fq * 8), boff = lds_byte(wc * 32 + fr, fq * 8);
#define PG8_SA(b, h) (((b) * 2 + (h)) * HTB)
#define PG8_SB(b, h) ((4 + (b) * 2 + (h)) * HTB)
#define PG8_STAGE(bufoff, gbase, voff) do { _Pragma("unroll") for (int _i = 0; _i < 2; ++_i) \
        __builtin_amdgcn_global_load_lds((const unsigned*)((const char*)(gbase) + (voff)[_i]), (PG8_LAS unsigned*)(lds + (bufoff) + ldsw + _i * 8192), 16, 0, 0); } while (0)
#define PG8_LDA(dst, b, h) do { _Pragma("unroll") for (int m = 0; m < 4; ++m) _Pragma("unroll") for (int k = 0; k < 2; ++k) dst[m][k] = *(const PG8_LAS bf16x8*)(lds + PG8_SA(b, h) + aoff + m * 2048 + k * 1024); } while (0)
#define PG8_LDB(dst, b, h) do { _Pragma("unroll") for (int n = 0; n < 2; ++n) _Pragma("unroll") for (int k = 0; k < 2; ++k) dst[n][k] = *(const PG8_LAS bf16x8*)(lds + PG8_SB(b, h) + boff + n * 2048 + k * 1024); } while (0)
#define PG8_MMA(ai, bj, At, Bt) do { __builtin_amdgcn_s_setprio(1); _Pragma("unroll") for (int m = 0; m < 4; ++m) _Pragma("unroll") for (int n = 0; n < 2; ++n) _Pragma("unroll") for (int k = 0; k < 2; ++k) \
        acc[ai][bj][m][n] = __builtin_amdgcn_mfma_f32_16x16x32_bf16(Bt[n][k], At[m][k], acc[ai][bj][m][n], 0, 0, 0); __builtin_amdgcn_s_setprio(0); } while (0)
#define PG8_WAIT_V(n) asm volatile("s_waitcnt vmcnt(" #n ")" ::: "memory")
#define PG8_WAIT_L(n) asm volatile("s_waitcnt lgkmcnt(" #n ")" ::: "memory")
#define PG8_BAR __builtin_amdgcn_s_barrier()
#define PG8_SCHED __builtin_amdgcn_sched_barrier(0)
    Unit cur, nxt; int ui = 0;
    if (!S.next(0, cur)) return;
    f32x4 acc[2][2][4][2];
#pragma unroll
    for (int a = 0; a < 2; ++a)
#pragma unroll
        for (int b = 0; b < 2; ++b)
#pragma unroll
            for (int m = 0; m < 4; ++m)
#pragma unroll
                for (int n = 0; n < 2; ++n) acc[a][b][m][n] = (f32x4){0.f, 0.f, 0.f, 0.f};
    bf16x8 At[4][2], B0[2][2], B1[2][2];
    const char* cA = (const char*)g.A + (size_t)cur.pm * tstep; const char* cB = (const char*)g.Bt + (size_t)cur.pn * tstep;
    S.a_ready(cur);
    if constexpr (SP2) {
        PG8_STAGE(PG8_SB(0, 0), cB, voffB); PG8_STAGE(PG8_SB(0, 1), cB + hstep, voffB); PG8_STAGE(PG8_SA(0, 0), cA, voffA); PG8_STAGE(PG8_SA(0, 1), cA + hstep, voffA);
        if (wr == 1) PG8_BAR;
        PG8_WAIT_V(2); PG8_BAR;
        PG8_STAGE(PG8_SB(1, 0), cB + kstep, voffB); PG8_STAGE(PG8_SA(1, 0), cA + kstep, voffA); PG8_STAGE(PG8_SB(1, 1), cB + hstep + kstep, voffB);
        PG8_WAIT_V(6); PG8_BAR;
    } else {
        PG8_STAGE(PG8_SB(0, 0), cB, voffB); PG8_STAGE(PG8_SA(0, 0), cA, voffA); PG8_STAGE(PG8_SB(0, 1), cB + hstep, voffB); PG8_STAGE(PG8_SA(0, 1), cA + hstep, voffA);
        if (wr == 1) PG8_BAR;
        PG8_WAIT_V(4); PG8_BAR;
        PG8_STAGE(PG8_SB(1, 0), cB + kstep, voffB); PG8_STAGE(PG8_SA(1, 0), cA + kstep, voffA); PG8_STAGE(PG8_SB(1, 1), cB + hstep + kstep, voffB);
        PG8_WAIT_V(6); PG8_BAR;
    }
    for (;;) {
        const bool has_next = S.next(ui + 1, nxt);
        const char* nA = has_next ? (const char*)g.A + (size_t)nxt.pm * tstep : cA; const char* nB = has_next ? (const char*)g.Bt + (size_t)nxt.pn * tstep : cB;
        for (int t = 0; t < nt; t += 2) {
            const bool last = (t == nt - 2);
            const char* a1 = cA + (size_t)(t + 1) * kstep;
            const char* a2 = last ? nA : cA + (size_t)(t + 2) * kstep; const char* b2 = last ? nB : cB + (size_t)(t + 2) * kstep;
            const char* a3 = a2 + kstep; const char* b3 = b2 + kstep;
            if (last && has_next) S.a_ready(nxt);
            if constexpr (SP2) {
            PG8_LDB(B0, 0, 0); PG8_LDB(B1, 0, 1); PG8_SCHED; PG8_LDA(At, 0, 0); PG8_STAGE(PG8_SA(1, 1), a1 + hstep, voffA);
            PG8_WAIT_V(8); PG8_WAIT_L(0); PG8_BAR; PG8_MMA(0, 0, At, B0); PG8_MMA(0, 1, At, B1); PG8_BAR; PG8_SCHED;
            PG8_LDA(At, 0, 1); PG8_STAGE(PG8_SB(0, 0), b2, voffB); PG8_STAGE(PG8_SB(0, 1), b2 + hstep, voffB); PG8_STAGE(PG8_SA(0, 0), a2, voffA);
            PG8_WAIT_V(8); PG8_WAIT_L(0); PG8_BAR; PG8_MMA(1, 0, At, B0); PG8_MMA(1, 1, At, B1); PG8_BAR; PG8_SCHED;
            PG8_LDB(B0, 1, 0); PG8_LDB(B1, 1, 1); PG8_SCHED; PG8_LDA(At, 1, 0); PG8_STAGE(PG8_SA(0, 1), a2 + hstep, voffA);
            PG8_WAIT_V(8); PG8_WAIT_L(0); PG8_BAR; PG8_MMA(0, 0, At, B0); PG8_MMA(0, 1, At, B1); PG8_BAR; PG8_SCHED;
            PG8_LDA(At, 1, 1); PG8_STAGE(PG8_SB(1, 0), b3, voffB); PG8_STAGE(PG8_SB(1, 1), b3 + hstep, voffB); PG8_STAGE(PG8_SA(1, 0), a3, voffA);
            PG8_WAIT_V(8); PG8_WAIT_L(0); PG8_BAR; PG8_MMA(1, 0, At, B0); PG8_MMA(1, 1, At, B1); PG8_BAR; PG8_SCHED;
            } else {
            PG8_LDB(B0, 0, 0); PG8_SCHED; PG8_LDA(At, 0, 0); PG8_STAGE(PG8_SA(1, 1), a1 + hstep, voffA);
            PG8_WAIT_L(8); PG8_BAR; PG8_WAIT_L(0); PG8_MMA(0, 0, At, B0); PG8_BAR; PG8_SCHED;
            PG8_LDB(B1, 0, 1); PG8_STAGE(PG8_SB(0, 0), b2, voffB);
            PG8_BAR; PG8_WAIT_L(0); PG8_MMA(0, 1, At, B1); PG8_BAR;
            PG8_LDA(At, 0, 1); PG8_STAGE(PG8_SA(0, 0), a2, voffA);
            PG8_BAR; PG8_WAIT_L(0); PG8_MMA(1, 0, At, B0); PG8_BAR; PG8_SCHED;
            PG8_STAGE(PG8_SB(0, 1), b2 + hstep, voffB);
            PG8_WAIT_V(6); PG8_BAR; PG8_MMA(1, 1, At, B1); PG8_BAR;
            PG8_LDB(B0, 1, 0); PG8_SCHED; PG8_LDA(At, 1, 0); PG8_STAGE(PG8_SA(0, 1), a2 + hstep, voffA);
            PG8_WAIT_L(8); PG8_BAR; PG8_WAIT_L(0); PG8_MMA(0, 0, At, B0); PG8_BAR; PG8_SCHED;
            PG8_LDB(B1, 1, 1); PG8_STAGE(PG8_SB(1, 0), b3, voffB);
            PG8_BAR; PG8_WAIT_L(0); PG8_MMA(0, 1, At, B1); PG8_BAR;
            PG8_LDA(At, 1, 1); PG8_STAGE(PG8_SA(1, 0), a3, voffA);
            PG8_BAR; PG8_WAIT_L(0); PG8_MMA(1, 0, At, B0); PG8_BAR; PG8_SCHED;
            PG8_STAGE(PG8_SB(1, 1), b3 + hstep, voffB);
            PG8_WAIT_V(6); PG8_BAR; PG8_MMA(1, 1, At, B1); PG8_BAR;
            }
        }
        if constexpr (ALIGN_EPI) { if (wr == 0) PG8_BAR; }
        if constexpr (!Epi::AFTER_DRAIN) { E(acc, cur, wr, wc, fr, fq); S.done(cur); }
        if (!has_next) break;
#pragma unroll
        for (int a = 0; a < 2; ++a)
#pragma unroll
            for (int b = 0; b < 2; ++b)
#pragma unroll
                for (int m = 0; m < 4; ++m)
#pragma unroll
                    for (int n = 0; n < 2; ++n) acc[a][b][m][n] = (f32x4){0.f, 0.f, 0.f, 0.f};
        cur = nxt; cA = nA; cB = nB; ++ui;
        if constexpr (ALIGN_EPI) { if (wr == 1) PG8_BAR; }
    }
    PG8_WAIT_V(0);
    if constexpr (!ALIGN_EPI) { if (wr == 0) PG8_BAR; }
    PG8_BAR;
    if constexpr (Epi::AFTER_DRAIN) { E.fused(acc, cur, wr, wc, fr, fq, lds, wid, lane); S.done(cur); }
#undef PG8_SA
#undef PG8_SB
#undef PG8_STAGE
#undef PG8_LDA
#undef PG8_LDB
#undef PG8_MMA
#undef PG8_WAIT_V
#undef PG8_WAIT_L
#undef PG8_BAR
#undef PG8_SCHED
}
}

struct OneUnit {
    int pm, pn; bool have;
    DI bool next(int i, pg8::Unit& u) const { if (i > 0 || !have) return false; u.pm = pm; u.pn = pn; return true; }
    DI void a_ready(const pg8::Unit&) const {}
    DI void done(const pg8::Unit&) const {}
};
struct EpiFfnA {
    static constexpr bool PERM = true, AFTER_DRAIN = false;
    bf16* hid;
    DI void operator()(const f32x4 (&acc)[2][2][4][2], const pg8::Unit& u, int wr, int wc, int fr, int fq) const {
        asm volatile("" : "+v"(fr), "+v"(fq), "+s"(wr), "+s"(wc));
        const int row0 = u.pm * 256 + wr * 64 + fr, hc0 = u.pn * 128 + wc * 32 + 8 * fq;
#pragma unroll
        for (int ai = 0; ai < 2; ++ai)
#pragma unroll
            for (int m = 0; m < 4; ++m) {
                const int row = row0 + ai * 128 + m * 16;
                float v[8];
#pragma unroll
                for (int n = 0; n < 2; ++n)
#pragma unroll
                    for (int j = 0; j < 4; ++j) { const float g = acc[ai][0][m][n][j], up = acc[ai][1][m][n][j]; v[n * 4 + j] = g * sigmoidf_(g) * up; }
                u32x4 o; o.x = pk2(v[0], v[1]); o.y = pk2(v[2], v[3]); o.z = pk2(v[4], v[5]); o.w = pk2(v[6], v[7]);
                AT(u32x4, hid, (row * DFF + hc0) >> 3) = o;
            }
    }
};
struct EpiResid {
    static constexpr bool PERM = true, AFTER_DRAIN = false;
    float* X; const float* resid; const float* gate; float scale; bool atomic;
    DI void operator()(const f32x4 (&acc)[2][2][4][2], const pg8::Unit& u, int wr, int wc, int fr, int fq) const {
        asm volatile("" : "+v"(fr), "+v"(fq), "+s"(wr), "+s"(wc));
        const int row0 = u.pm * 256 + wr * 64 + fr;
#pragma unroll
        for (int bj = 0; bj < 2; ++bj) {
            const int c0 = u.pn * 256 + bj * 128 + wc * 32 + 8 * fq;
            const f32x4 g0 = *(const f32x4*)(gate + c0) * scale, g1 = *(const f32x4*)(gate + c0 + 4) * scale;
            if (atomic) {
#pragma unroll
                for (int ai = 0; ai < 2; ++ai)
#pragma unroll
                    for (int m = 0; m < 4; ++m) {
                        const int row = row0 + ai * 128 + m * 16;
                        const f32x4 d0 = g0 * acc[ai][bj][m][0], d1 = g1 * acc[ai][bj][m][1];
#pragma unroll
                        for (int j = 0; j < 4; ++j) { atomicAdd(&AT(float, X, row * D + c0 + j), d0[j]); atomicAdd(&AT(float, X, row * D + c0 + 4 + j), d1[j]); }
                    }
            } else {
                f32x4 r0[8], r1[8];
#pragma unroll
                for (int q = 0; q < 8; ++q) { const int row = row0 + (q >> 2) * 128 + (q & 3) * 16; r0[q] = AT(const f32x4, resid, (row * D + c0) >> 2); r1[q] = AT(const f32x4, resid, (row * D + c0 + 4) >> 2); }
#pragma unroll
                for (int q = 0; q < 8; ++q) {
                    const int row = row0 + (q >> 2) * 128 + (q & 3) * 16;
                    AT(f32x4, X, (row * D + c0) >> 2) = r0[q] + g0 * acc[q >> 2][bj][q & 3][0]; AT(f32x4, X, (row * D + c0 + 4) >> 2) = r1[q] + g1 * acc[q >> 2][bj][q & 3][1];
                }
            }
        }
    }
};
struct EpiInproj {
    static constexpr bool PERM = true, AFTER_DRAIN = false;
    char* ws; const float* gq; const float* gk;
    DI void operator()(const f32x4 (&acc)[2][2][4][2], const pg8::Unit& u, int wr, int wc, int fr, int fq) const {
        asm volatile("" : "+v"(fr), "+v"(fq), "+s"(wr), "+s"(wc));
        const int pn = u.pn, row0 = u.pm * 256 + wr * 64 + fr;
        if (pn < 2 || pn > 4) {
            bf16* dst; int ld, cb;
            if (pn == 0) { dst = (bf16*)(ws + O_A); ld = 256; cb = 0; } else if (pn == 1) { dst = (bf16*)(ws + O_S); ld = 256; cb = 0; } else { dst = (bf16*)(ws + O_BIG); ld = 3072; cb = (pn - 5) * 256; }
            const bool sg = pn > 4;
#pragma unroll
            for (int bj = 0; bj < 2; ++bj) {
                const int c0 = cb + bj * 128 + wc * 32 + 8 * fq;
#pragma unroll
                for (int ai = 0; ai < 2; ++ai)
#pragma unroll
                    for (int m = 0; m < 4; ++m) {
                        const int row = row0 + ai * 128 + m * 16;
                        float v[8];
#pragma unroll
                        for (int n = 0; n < 2; ++n)
#pragma unroll
                            for (int j = 0; j < 4; ++j) { const float x = acc[ai][bj][m][n][j]; v[n * 4 + j] = sg ? sigmoidf_(x) : x; }
                        u32x4 o; o.x = pk2(v[0], v[1]); o.y = pk2(v[2], v[3]); o.z = pk2(v[4], v[5]); o.w = pk2(v[6], v[7]);
                        AT(u32x4, dst, (row * ld + c0) >> 3) = o;
                    }
            }
        } else if (pn < 4 || wc < 2) {
            const bool isq = pn < 4;
            const float* gv = isq ? gq : gk;
            const float2* rope = (const float2*)(ws + O_ROPE);
            const bool latent = u.pm < 64;
            const float osc = isq ? 0.125f * 1.4426950408889634f : 1.f, sgn = (fq >= 2) ? 1.f : -1.f;
            bf16* dst = (bf16*)(ws + (isq ? O_Q : O_K));
            const int ld = isq ? 512 : 128, hb = (isq ? (pn - 2) * 4 + wc : wc) * 64 + 8 * fq, i0 = 8 * (fq & 1);
#pragma unroll
            for (int ai = 0; ai < 2; ++ai)
#pragma unroll
                for (int m = 0; m < 4; ++m) {
                    const int row = row0 + ai * 128 + m * 16;
                    float v[2][8]; float ss = 0.f;
#pragma unroll
                    for (int bj = 0; bj < 2; ++bj)
#pragma unroll
                        for (int n = 0; n < 2; ++n)
#pragma unroll
                            for (int j = 0; j < 4; ++j) { const float x = acc[ai][bj][m][n][j]; v[bj][n * 4 + j] = x; ss += x * x; }
                    ss += __shfl_xor(ss, 16); ss += __shfl_xor(ss, 32);
                    const float rstd = rsqrtf(ss * (1.f / 64.f) + 1e-6f);
#pragma unroll
                    for (int bj = 0; bj < 2; ++bj) {
#pragma unroll
                        for (int e = 0; e < 8; ++e) v[bj][e] *= rstd * AT(const float, gv, 32 * bj + 8 * fq + e);
                        if (latent) {
                            const int pos = bj == 0 ? (row >> 6) : (row & 63);
#pragma unroll
                            for (int e = 0; e < 8; ++e) {
                                const float2 cs = AT(const float2, rope, pos * 16 + i0 + e);
                                const float pr = __shfl_xor(v[bj][e], 32);
                                v[bj][e] = v[bj][e] * cs.x + sgn * pr * cs.y;
                            }
                        }
                        u32x4 o; o.x = pk2(v[bj][0] * osc, v[bj][1] * osc); o.y = pk2(v[bj][2] * osc, v[bj][3] * osc); o.z = pk2(v[bj][4] * osc, v[bj][5] * osc); o.w = pk2(v[bj][6] * osc, v[bj][7] * osc);
                        AT(u32x4, dst, (row * ld + hb + 32 * bj) >> 3) = o;
                    }
                    asm volatile("" ::: "memory");
                }
        } else {
            bf16* vt = (bf16*)(ws + O_VT);
#pragma unroll
            for (int bj = 0; bj < 2; ++bj)
#pragma unroll
                for (int ai = 0; ai < 2; ++ai)
#pragma unroll
                    for (int m = 0; m < 4; ++m) {
                        const int row = row0 + ai * 128 + m * 16;
#pragma unroll
                        for (int n = 0; n < 2; ++n)
#pragma unroll
                            for (int j = 0; j < 4; ++j) AT(bf16, vt, ((wc - 2) * 64 + 32 * bj + 8 * fq + 4 * n + j) * NT + row) = f2bf(acc[ai][bj][m][n][j]);
                    }
        }
    }
};
typedef PG8_LAS unsigned char* pg8lds;
DI void big_ffn_a(const Params& p, int f, int M, ldsp lds) {
    pg8::Gemm g{(const pg8::bf16_t*)(p.ws + O_H), (const pg8::bf16_t*)(p.ws + O_W13) + (size_t)f * 5632 * 1024, 1024, 1024};
    pg8::StaticOrder S; S.init(M, 5632, gridDim.x, blockIdx.x);
    EpiFfnA E{(bf16*)(p.ws + O_BIG)};
    pg8::gemm_phase<EpiFfnA, pg8::StaticOrder, true, true>((pg8lds)lds, g, S, E);
}
#define PANEL_CNT(l, prod, pm) (4096 + ((l) * 3 + (prod)) * 80 + (pm))
DI unsigned panel_arrive_wait(unsigned* w, unsigned target, ldsp lds) {
    asm volatile("s_waitcnt vmcnt(0)" ::: "memory");
    __syncthreads();
    LAS unsigned* flag = (LAS unsigned*)lds;
    if (threadIdx.x == 0) {
        __builtin_amdgcn_fence(__ATOMIC_RELEASE, "agent");
        asm volatile("s_waitcnt vmcnt(0)" ::: "memory");
        const unsigned old = xb_add(w, 1u);
        unsigned sp = 0;
        while (xb_ld(w) < target) { __builtin_amdgcn_s_sleep(2); if (++sp > (1u << 24)) break; }
        __builtin_amdgcn_fence(__ATOMIC_ACQUIRE, "agent");
        asm volatile("s_waitcnt vmcnt(0)" ::: "memory");
        *flag = old;
    }
    __syncthreads();
    const unsigned r = *flag;
    __syncthreads();
    return r;
}
DI void norm_rows(const Params& p, int nl, int nwhich, bool fin, int r0, int nrows) {
    const int lane = threadIdx.x & 63, w = threadIdx.x >> 6;
    const int cond = r0 >= NL, per = nrows >> 3;
    f32x4 gm[4], sv[4];
#pragma unroll
    for (int j = 0; j < 4; ++j) {
        const int c = lane * 4 + 256 * j;
        if (fin) { gm[j] = *(const f32x4*)(p.in[I_FG] + c); sv[j] = (f32x4){0.f, 0.f, 0.f, 0.f}; }
        else {
            const float* g = p.in[I_NORMG] + (size_t)(nl * 3 + nwhich) * D;
            gm[j] = *(const f32x4*)(g + c) * (*(const f32x4*)(mods_ptr(p, cond, nl, 3 * nwhich + 1) + c) + 1.f);
            sv[j] = *(const f32x4*)(mods_ptr(p, cond, nl, 3 * nwhich) + c);
        }
    }
    const int wbeg = r0 + w * per, wend = wbeg + per;
#pragma unroll 1
    for (int rb = wbeg; rb < wend; rb += 4) {
        const int n = min(4, wend - rb);
        f32x4 x[4][4];
#pragma unroll
        for (int q = 0; q < 4; ++q)
#pragma unroll
            for (int j = 0; j < 4; ++j) x[q][j] = *(const f32x4*)((const float*)(p.ws + O_X) + (size_t)(rb + (q < n ? q : 0)) * D + lane * 4 + 256 * j);
#pragma unroll
        for (int q = 0; q < 4; ++q) {
            if (q < n) {
                float ss = 0.f;
#pragma unroll
                for (int j = 0; j < 4; ++j) ss += x[q][j][0] * x[q][j][0] + x[q][j][1] * x[q][j][1] + x[q][j][2] * x[q][j][2] + x[q][j][3] * x[q][j][3];
                ss = wave_sum(ss);
                const float rstd = __builtin_amdgcn_rsqf(ss * (1.f / 1024.f) + 1e-6f);
#pragma unroll
                for (int j = 0; j < 4; ++j) {
                    const int c = lane * 4 + 256 * j;
                    const f32x4 o = x[q][j] * rstd * gm[j] + sv[j];
                    if (fin) *(f32x4*)(p.out + (size_t)(rb + q) * D + c) = o;
                    else { u32x2 pk; pk.x = pk2(o[0], o[1]); pk.y = pk2(o[2], o[3]); *(u32x2*)((bf16*)(p.ws + O_H) + (size_t)(rb + q) * D + c) = pk; }
                }
            }
        }
    }
}
DI void big_resid(const Params& p, const bf16* A, const bf16* Bt, int K, int l, int gate_j, float scale, bool resid_in, bool ctx, int prod, int nl, int nwhich, bool fin, ldsp lds) {
    float* X = (float*)(p.ws + O_X);
    unsigned* cw = (unsigned*)(p.ws + O_BAR);
    if (ctx) {
        const int j = blockIdx.x, nsplit = K / 256;
        OneUnit S{64, j & 3, j < 4 * nsplit};
        pg8::Gemm g{(const pg8::bf16_t*)A + (j >> 2) * 256, (const pg8::bf16_t*)Bt + (j >> 2) * 256, 256, K};
        EpiResid E{X, X, mods_ptr(p, 1, l, gate_j), scale, true};
        pg8::gemm_phase<EpiResid, OneUnit, false, true>((pg8lds)lds, g, S, E);
        if (j < 4 * nsplit) {
            const unsigned k = panel_arrive_wait(cw + PANEL_CNT(l, prod, 64), 4u * nsplit, lds);
            if (k < 16u) norm_rows(p, nl, nwhich, false, NL + (int)k * 16, 16);
        }
    }
    pg8::Gemm g{(const pg8::bf16_t*)A, (const pg8::bf16_t*)Bt, K, K};
    pg8::StaticOrder S; S.init(NL, 1024, gridDim.x, blockIdx.x);
    EpiResid E{X, resid_in ? p.in[I_X] : X, mods_ptr(p, 0, l, gate_j), scale, false};
    pg8::gemm_phase<EpiResid, pg8::StaticOrder, false, true>((pg8lds)lds, g, S, E);
    pg8::Unit u;
    for (int i = 0; S.next(i, u); ++i) {
        const unsigned k = panel_arrive_wait(cw + PANEL_CNT(l, prod, u.pm), 4u, lds);
        norm_rows(p, nl, nwhich, fin, u.pm * 256 + (int)(k & 3u) * 64, 64);
    }
}
template <int MODE>
struct EpiMix {
    static constexpr bool PERM = true, AFTER_DRAIN = false;
    bf16* M; const bf16* G;
    DI void operator()(const f32x4 (&acc)[2][2][4][2], const pg8::Unit& u, int wr, int wc, int fr, int fq) const {
        asm volatile("" : "+v"(fr), "+v"(fq), "+s"(wr), "+s"(wc));
        const int row0 = u.pm * 256 + wr * 64 + fr;
#pragma unroll
        for (int bj = 0; bj < (MODE == 2 ? 1 : 2); ++bj) {
            const int c0 = (MODE == 2) ? (u.pn * 128 + wc * 32 + 8 * fq) : (u.pn * 256 + bj * 128 + wc * 32 + 8 * fq);
            const int gofs = (MODE == 0) ? 0 : (MODE == 1) ? 2048 : 1024;
            u32x4 gg[8], mm[8];
#pragma unroll
            for (int q = 0; q < 8; ++q) {
                const int row = row0 + (q >> 2) * 128 + (q & 3) * 16;
                gg[q] = AT(const u32x4, G, (row * 3072 + gofs + c0) >> 3);
                if (MODE != 0) mm[q] = AT(const u32x4, M, (row * D + c0) >> 3);
            }
#pragma unroll
            for (int q = 0; q < 8; ++q) {
                const int row = row0 + (q >> 2) * 128 + (q & 3) * 16, ai = q >> 2, m = q & 3;
                float v[8];
#pragma unroll
                for (int n = 0; n < 2; ++n)
#pragma unroll
                    for (int j = 0; j < 4; ++j) {
                        if (MODE == 2) v[n * 4 + j] = acc[ai][0][m][n][j] * sigmoidf_(acc[ai][1][m][n][j]);
                        else v[n * 4 + j] = acc[ai][bj][m][n][j];
                    }
                v[0] *= bflo(gg[q].x); v[1] *= bfhi(gg[q].x); v[2] *= bflo(gg[q].y); v[3] *= bfhi(gg[q].y); v[4] *= bflo(gg[q].z); v[5] *= bfhi(gg[q].z); v[6] *= bflo(gg[q].w); v[7] *= bfhi(gg[q].w);
                if (MODE != 0) { v[0] += bflo(mm[q].x); v[1] += bfhi(mm[q].x); v[2] += bflo(mm[q].y); v[3] += bfhi(mm[q].y); v[4] += bflo(mm[q].z); v[5] += bfhi(mm[q].z); v[6] += bflo(mm[q].w); v[7] += bfhi(mm[q].w); }
                u32x4 o; o.x = pk2(v[0], v[1]); o.y = pk2(v[2], v[3]); o.z = pk2(v[4], v[5]); o.w = pk2(v[6], v[7]);
                AT(u32x4, M, (row * D + c0) >> 3) = o;
            }
        }
    }
};
struct GluOrder {
    pg8::StaticOrder S;
    DI bool next(int i, pg8::Unit& u) const { pg8::Unit t; if (!S.next(i >> 1, t)) return false; u.pm = t.pm; u.pn = 2 * t.pn + (i & 1); return true; }
    DI void a_ready(const pg8::Unit&) const {}
    DI void done(const pg8::Unit&) const {}
};
DI void big_mix1(const Params& p, int M, ldsp lds) {
    bf16* Mx = (bf16*)(p.ws + O_H); const bf16* G = (const bf16*)(p.ws + O_BIG);
    pg8::StaticOrder S; S.init(M, 1024, gridDim.x, blockIdx.x);
    {   pg8::Gemm g{(const pg8::bf16_t*)(p.ws + O_YP), (const pg8::bf16_t*)(p.ws + O_WP), 256, 256};
        EpiMix<0> E{Mx, G};
        pg8::gemm_phase<EpiMix<0>, pg8::StaticOrder, false, true>((pg8lds)lds, g, S, E); }
    {   pg8::Gemm g{(const pg8::bf16_t*)(p.ws + O_Q), (const pg8::bf16_t*)(p.ws + O_WAO), 512, 512};
        EpiMix<1> E{Mx, G};
        pg8::gemm_phase<EpiMix<1>, pg8::StaticOrder, false, true>((pg8lds)lds, g, S, E); }
    {   pg8::Gemm g{(const pg8::bf16_t*)(p.ws + O_YS), (const pg8::bf16_t*)(p.ws + O_WGLU), 256, 256};
        GluOrder SG{S};
        EpiMix<2> E{Mx, G};
        pg8::gemm_phase<EpiMix<2>, GluOrder, false, true>((pg8lds)lds, g, SG, E); }
}
DI void big_inproj(const Params& p, int l, ldsp lds) {
    pg8::Gemm g{(const pg8::bf16_t*)(p.ws + O_H), (const pg8::bf16_t*)(p.ws + O_WIN), 1024, 1024};
    pg8::StaticOrder S; S.init(NT, INW, gridDim.x, blockIdx.x);
    EpiInproj E{p.ws, p.in[I_QG] + l * 64, p.in[I_KG] + l * 64};
    pg8::gemm_phase<EpiInproj, pg8::StaticOrder, true, true>((pg8lds)lds, g, S, E);
}

DI void norm_item(const Params& p, int l, int which, int it) {
    const int tid = threadIdx.x, lane = tid & 63, w = tid >> 6;
    const int row = it * 8 + w;
    const int cond = row >= NL;
    const bool from_in = (l == 0 && which == 0);
    const float* src = from_in ? (cond ? p.in[I_CTX] + (size_t)(row - NL) * D : p.in[I_X] + (size_t)row * D) : (const float*)(p.ws + O_X) + (size_t)row * D;
    f32x4 x[4]; float ss = 0.f;
#pragma unroll
    for (int j = 0; j < 4; ++j) { x[j] = *(const f32x4*)(src + lane * 4 + 256 * j); ss += x[j][0] * x[j][0] + x[j][1] * x[j][1] + x[j][2] * x[j][2] + x[j][3] * x[j][3]; }
    if (from_in && cond) {
        float* xr = (float*)(p.ws + O_X) + (size_t)row * D;
#pragma unroll
        for (int j = 0; j < 4; ++j) *(f32x4*)(xr + lane * 4 + 256 * j) = x[j];
    }
    ss = wave_sum(ss);
    const float rstd = rsqrtf(ss * (1.f / 1024.f) + 1e-6f);
    const float* g = p.in[I_NORMG] + (size_t)(l * 3 + which) * D;
    const float* sh = mods_ptr(p, cond, l, 3 * which), *sc = mods_ptr(p, cond, l, 3 * which + 1);
    bf16* H = (bf16*)(p.ws + O_H) + (size_t)row * D;
#pragma unroll
    for (int j = 0; j < 4; ++j) {
        const int c = lane * 4 + 256 * j;
        const f32x4 gv = *(const f32x4*)(g + c), sv = *(const f32x4*)(sh + c), cv = *(const f32x4*)(sc + c);
        float o[4];
#pragma unroll
        for (int e = 0; e < 4; ++e) o[e] = x[j][e] * rstd * gv[e] * (1.f + cv[e]) + sv[e];
        u32x2 pk; pk.x = pk2(o[0], o[1]); pk.y = pk2(o[2], o[3]);
        *(u32x2*)(H + c) = pk;
    }
}
DI void final_norm_item(const Params& p, int it) {
    const int tid = threadIdx.x, lane = tid & 63, w = tid >> 6;
    const int row = it * 8 + w;
    const float* src = (const float*)(p.ws + O_X) + (size_t)row * D;
    f32x4 x[4]; float ss = 0.f;
#pragma unroll
    for (int j = 0; j < 4; ++j) { x[j] = *(const f32x4*)(src + lane * 4 + 256 * j); ss += x[j][0] * x[j][0] + x[j][1] * x[j][1] + x[j][2] * x[j][2] + x[j][3] * x[j][3]; }
    ss = wave_sum(ss);
    const float rstd = rsqrtf(ss * (1.f / 1024.f) + 1e-6f);
    const float* g = p.in[I_FG];
#pragma unroll
    for (int j = 0; j < 4; ++j) {
        const int c = lane * 4 + 256 * j;
        const f32x4 gv = *(const f32x4*)(g + c);
        f32x4 o;
#pragma unroll
        for (int e = 0; e < 4; ++e) o[e] = x[j][e] * rstd * gv[e];
        *(f32x4*)(p.out + (size_t)row * D + c) = o;
    }
}
DI void s1_item(const Params& p, int it, ldsp lds) {
    TID_VARS
    const int g = it & 15, mt = it >> 4;
    f32x16 acc[4][2]; zero_acc<4, 2>(acc);
    gemm_acc<1, 4, 2>(acc, (const bf16*)(p.ws + O_S) + g * 16, 8192, mt * 256, (const bf16*)(p.ws + O_W1S) + (unsigned)g * 256 * 512, 512, 0, 512, lds);
    float* E = (float*)(p.ws + O_E);
#pragma unroll
    for (int rb = 0; rb < 4; ++rb)
#pragma unroll
        for (int cb = 0; cb < 2; ++cb)
#pragma unroll
            for (int i = 0; i < 16; ++i) {
                const int c = mt * 256 + ACC_ROW(rb, i);
                if (c < NCH) AT(float, E, (c * 16 + g) * 256 + ACC_COL(cb)) = acc[rb][cb][i];
            }
}
DI void s2_item(const Params& p, int it) {
    const int sidx = it * 512 + threadIdx.x;
    const int g = sidx >> 7, dir = (sidx >> 6) & 1, pp = sidx & 63;
    const float2 aT = ((const float2*)(p.ws + O_PW))[(unsigned)((dir * 16 + g) * 64 + pp) * 33 + 32];
    const float* E = (const float*)(p.ws + O_E) + g * 256 + dir * 128 + pp;
    bf16* C = (bf16*)(p.ws + O_CARRY) + g * 256 + dir * 128 + pp;
    float cr = 0.f, ci = 0.f;
#pragma unroll 8
    for (int n = 0; n < NCH; ++n) {
        int c;
        if (dir == 0) c = (n < 8) ? 512 + n : n - 8;
        else c = 519 - n;
        const float er = E[(unsigned)c * 4096], ei = E[(unsigned)c * 4096 + 64];
        C[(unsigned)c * 4096] = f2bf(cr); C[(unsigned)c * 4096 + 64] = f2bf(ci);
        const float nr = aT.x * cr - aT.y * ci + er, ni = aT.x * ci + aT.y * cr + ei;
        cr = nr; ci = ni;
    }
}
DI float gelu_tanh(float x) { const float u = 0.7978845608028654f * (x + 0.044715f * x * x * x); return x * sigmoidf_(2.f * u); }
DI void s3_item(const Params& p, int it, ldsp lds) {
    TID_VARS
    const int g = it & 15, rest = it >> 4, nt = rest & 1, mt = rest >> 1;
    f32x16 acc[4][2]; zero_acc<4, 2>(acc);
    gemm_acc<1, 4, 2>(acc, (const bf16*)(p.ws + O_S) + g * 16, 8192, mt * 256, (const bf16*)(p.ws + O_TOEP) + (unsigned)g * 512 * 512, 512, nt * 256, 512, lds);
    gemm_acc<0, 4, 2>(acc, (const bf16*)(p.ws + O_CARRY) + g * 256, 4096, mt * 256, (const bf16*)(p.ws + O_W3S) + (unsigned)g * 512 * 256, 256, nt * 256, 256, lds);
    bf16* Ys = (bf16*)(p.ws + O_YS);
#pragma unroll
    for (int rb = 0; rb < 4; ++rb)
#pragma unroll
        for (int cb = 0; cb < 2; ++cb)
#pragma unroll
            for (int i = 0; i < 16; ++i) {
                const int c = mt * 256 + ACC_ROW(rb, i);
                const int n = nt * 256 + ACC_COL(cb), j = n >> 4, hh = n & 15;
                if (c < NCH) AT(bf16, Ys, (c * 32 + j) * 256 + g * 16 + hh) = f2bf(gelu_tanh(acc[rb][cb][i]));
            }
}
DI void pool_item(const Params& p, int it) {
    const int tid = threadIdx.x, cv = tid & 31, rg = tid >> 5;
    const bf16* A = (const bf16*)(p.ws + O_A);
    bf16* Y = (bf16*)(p.ws + O_YP);
    const int half = 1 << (cv >> 3);
#pragma unroll 1
    for (int i = 0; i < 4; ++i) {
        const int row = it * 64 + rg + 16 * i;
        const int base = row >= NL ? NL : 0, n = row >= NL ? NC : NL, t = row - base;
        const int lo = max(t - half, 0), hi = min(t + half, n);
        float s[8];
#pragma unroll
        for (int e = 0; e < 8; ++e) s[e] = 0.f;
        for (int u = lo; u < hi; ++u) {
            const u32x4 v = *(const u32x4*)(A + (unsigned)(base + u) * 256 + cv * 8);
            s[0] += bflo(v.x); s[1] += bfhi(v.x); s[2] += bflo(v.y); s[3] += bfhi(v.y); s[4] += bflo(v.z); s[5] += bfhi(v.z); s[6] += bflo(v.w); s[7] += bfhi(v.w);
        }
        const u32x4 v = *(const u32x4*)(A + (unsigned)row * 256 + cv * 8);
        const float inv = 1.f / (float)(hi - lo);
        u32x4 o;
        o.x = pk2(s[0] * inv - bflo(v.x), s[1] * inv - bfhi(v.x)); o.y = pk2(s[2] * inv - bflo(v.y), s[3] * inv - bfhi(v.y));
        o.z = pk2(s[4] * inv - bflo(v.z), s[5] * inv - bfhi(v.z)); o.w = pk2(s[6] * inv - bflo(v.w), s[7] * inv - bfhi(v.w));
        *(u32x4*)(Y + (unsigned)row * 256 + cv * 8) = o;
    }
}
DI int sig_perm(int r) { return (r & 0x13) | ((r & 4) << 1) | ((r & 8) >> 1); }
template <bool FIXED>
DI void attn_item(const Params& p, int qb, int head, float bound, ldsp lds) {
    TID_VARS
    const int kvh = head >> 2;
    bf16* Q = (bf16*)(p.ws + O_Q);
    const bf16* Kp = (const bf16*)(p.ws + O_K) + kvh * 64;
    const bf16* Vp = (const bf16*)(p.ws + O_VT) + (unsigned)kvh * 64 * NT;
    const int q0 = qb * 256 + w * 32;
    bf16x8 qf[4];
#pragma unroll
    for (int s = 0; s < 4; ++s) qf[s] = *(const bf16x8*)(Q + (unsigned)(q0 + r) * 512 + head * 64 + 16 * s + 8 * h);
    const int key0 = qb < 64 ? 0 : NL, ntile = qb < 64 ? NT / 64 : NC / 64;
    const int isv = tid >> 8, lrow = (tid & 255) >> 3, lv = tid & 7;
    const bf16* gp = isv ? (Vp + (unsigned)lrow * NT + key0 + lv * 8) : (Kp + (unsigned)(key0 + lrow) * 128 + lv * 8);
    const unsigned gstep = isv ? 64u : 64u * 128u, grow = isv ? 32u * NT : 32u * 128u;
    u32x4 rgA[2], rgB[2];
#pragma unroll
    for (int i = 0; i < 2; ++i) rgB[i] = *(const u32x4*)(gp + i * grow);
    ldsp wr = lds + isv * 9216 + lrow * LROW + lv * 16;
#pragma unroll
    for (int i = 0; i < 2; ++i) *(LAS u32x4*)(wr + i * 32 * LROW) = rgB[i];
    gp += gstep;
#pragma unroll
    for (int i = 0; i < 2; ++i) rgA[i] = *(const u32x4*)(gp + i * grow);
    __syncthreads();
    f32x16 o0, o1;
#pragma unroll
    for (int i = 0; i < 16; ++i) { o0[i] = 0.f; o1[i] = 0.f; }
    float m = -1e30f, lsum = 0.f, lsa = 0.f, lsb = 0.f;
    f32x16 cinit;
#pragma unroll
    for (int i = 0; i < 16; ++i) cinit[i] = FIXED ? -bound * 1.4426950408889634f : 0.f;
    cldsp lk = lds + sig_perm(r) * LROW + h * 16;
    cldsp lvv = lds + 9216 + r * LROW + h * 16;
#define ATT_TILE(buf, RL, RW, t)                                                                                                     \
    {                                                                                                                                \
        if ((t) + 2 < ntile) {                                                                                                       \
            gp += gstep;                                                                                                             \
            _Pragma("unroll") for (int i = 0; i < 2; ++i) RL[i] = *(const u32x4*)(gp + i * grow);                                    \
        }                                                                                                                            \
        __builtin_amdgcn_sched_barrier(0);                                                                                           \
        cldsp pk = lk + (buf) * 18432; cldsp pv = lvv + (buf) * 18432;                                                               \
        f32x16 s0, s1;                                                                                                               \
        {                                                                                                                            \
            const bf16x8 k0 = *(const LAS bf16x8*)(pk), k1 = *(const LAS bf16x8*)(pk + 32 * LROW);                                   \
            s0 = MFMA(k0, qf[0], cinit); s1 = MFMA(k1, qf[0], cinit);                                                                \
        }                                                                                                                            \
        _Pragma("unroll") for (int s = 1; s < 4; ++s) {                                                                              \
            const bf16x8 k0 = *(const LAS bf16x8*)(pk + s * 32), k1 = *(const LAS bf16x8*)(pk + 32 * LROW + s * 32);                 \
            s0 = MFMA(k0, qf[s], s0); s1 = MFMA(k1, qf[s], s1);                                                                      \
        }                                                                                                                            \
        if (!FIXED) {                                                                                                                \
            float mx = s0[0];                                                                                                        \
            _Pragma("unroll") for (int i = 1; i < 16; ++i) mx = fmaxf(mx, s0[i]);                                                    \
            _Pragma("unroll") for (int i = 0; i < 16; ++i) mx = fmaxf(mx, s1[i]);                                                    \
            mx = fmaxf(mx, __shfl_xor(mx, 32));                                                                                      \
            const float mnew = fmaxf(m, mx);                                                                                         \
            const float alpha = __builtin_amdgcn_exp2f(m - mnew);                                                                    \
            m = mnew;                                                                                                                \
            lsa *= alpha; lsb *= alpha;                                                                                              \
            _Pragma("unroll") for (int i = 0; i < 16; ++i) { o0[i] *= alpha; o1[i] *= alpha; s0[i] -= mnew; s1[i] -= mnew; }         \
        }                                                                                                                            \
        _Pragma("unroll") for (int i = 0; i < 16; ++i) {                                                                             \
            s0[i] = __builtin_amdgcn_exp2f(s0[i]); s1[i] = __builtin_amdgcn_exp2f(s1[i]);                                            \
            lsa += s0[i]; lsb += s1[i];                                                                                              \
        }                                                                                                                            \
        _Pragma("unroll") for (int kb = 0; kb < 2; ++kb)                                                                             \
            _Pragma("unroll") for (int s = 0; s < 2; ++s) {                                                                          \
                u32x4 pp;                                                                                                            \
                if (kb == 0) { pp.x = pk2(s0[8 * s], s0[8 * s + 1]); pp.y = pk2(s0[8 * s + 2], s0[8 * s + 3]); pp.z = pk2(s0[8 * s + 4], s0[8 * s + 5]); pp.w = pk2(s0[8 * s + 6], s0[8 * s + 7]); } \
                else         { pp.x = pk2(s1[8 * s], s1[8 * s + 1]); pp.y = pk2(s1[8 * s + 2], s1[8 * s + 3]); pp.z = pk2(s1[8 * s + 4], s1[8 * s + 5]); pp.w = pk2(s1[8 * s + 6], s1[8 * s + 7]); } \
                const bf16x8 pf = __builtin_bit_cast(bf16x8, pp);                                                                    \
                const bf16x8 v0 = *(const LAS bf16x8*)(pv + (kb * 32 + 16 * s) * 2), v1 = *(const LAS bf16x8*)(pv + 32 * LROW + (kb * 32 + 16 * s) * 2); \
                o0 = MFMA(v0, pf, o0); o1 = MFMA(v1, pf, o1);                                                                        \
            }                                                                                                                        \
        __builtin_amdgcn_sched_barrier(0);                                                                                           \
        if ((t) + 1 < ntile) {                                                                                                       \
            ldsp w2 = wr + ((buf) ^ 1) * 18432;                                                                                      \
            _Pragma("unroll") for (int i = 0; i < 2; ++i) *(LAS u32x4*)(w2 + i * 32 * LROW) = RW[i];                                 \
        }                                                                                                                            \
        __syncthreads();                                                                                                             \
    }
    for (int t = 0; t < ntile; t += 2) {
        ATT_TILE(0, rgB, rgA, t)
        ATT_TILE(1, rgA, rgB, t + 1)
    }
#undef ATT_TILE
    lsum = lsa + lsb;
    lsum += __shfl_xor(lsum, 32);
    const float inv = 1.f / lsum;
    bf16* orow = Q + (unsigned)(q0 + r) * 512 + head * 64;
#pragma unroll
    for (int q = 0; q < 4; ++q) {
        u32x2 a, b;
        a.x = pk2(o0[4 * q] * inv, o0[4 * q + 1] * inv); a.y = pk2(o0[4 * q + 2] * inv, o0[4 * q + 3] * inv);
        b.x = pk2(o1[4 * q] * inv, o1[4 * q + 1] * inv); b.y = pk2(o1[4 * q + 2] * inv, o1[4 * q + 3] * inv);
        *(u32x2*)(orow + 8 * q + 4 * h) = a;
        *(u32x2*)(orow + 32 + 8 * q + 4 * h) = b;
    }
}
DI float attn_bound(const Params& p, int l) {
    const int lane = threadIdx.x & 63;
    float a = fabsf(p.in[I_QG][l * 64 + lane]), b = fabsf(p.in[I_KG][l * 64 + lane]);
#pragma unroll
    for (int o = 32; o >= 1; o >>= 1) { a = fmaxf(a, __shfl_xor(a, o)); b = fmaxf(b, __shfl_xor(b, o)); }
    return 8.f * 1.02f * a * b;
}
DI void attn_dispatch(const Params& p, int l, int qb, int head, ldsp lds) {
    const float bound = attn_bound(p, l);
    if (bound < 40.f) attn_item<true>(p, qb, head, bound, lds);
    else attn_item<false>(p, qb, head, 0.f, lds);
}
DI void conv_tile(const float* src, bf16* dst, int K, int N, int permmode, int tile, ldsp lds) {
    const int tid = threadIdx.x & 255, half = threadIdx.x >> 8;
    tile = tile * 2 + half;
    const int ntn = N / 64, tk = tile / ntn, tn = tile % ntn;
    LAS float* L = (LAS float*)lds + half * (64 * 65);
#pragma unroll
    for (int i = 0; i < 4; ++i) {
        const int kk = (tid >> 4) + 16 * i, c4 = (tid & 15) * 4;
        const f32x4 v = *(const f32x4*)(src + (size_t)(tk * 64 + kk) * N + tn * 64 + c4);
        L[kk * 65 + c4] = v[0]; L[kk * 65 + c4 + 1] = v[1]; L[kk * 65 + c4 + 2] = v[2]; L[kk * 65 + c4 + 3] = v[3];
    }
    __syncthreads();
    const int n = tid >> 2, ks = (tid & 3) * 16;
    int nn = tn * 64 + n;
    if (permmode == 1) { const int hN = N >> 1, b = nn >= hN, hc = b ? nn - hN : nn; nn = 256 * (hc >> 7) + 128 * b + (hc & 127); }
    else if (permmode == 2 && nn >= 512 && nn < 1280) {
        if (nn < 1024) { const int hd = (nn - 512) >> 6, d = nn & 63; nn = (2 + (hd >> 2)) * 256 + 128 * (d >> 5) + 32 * (hd & 3) + (d & 31); }
        else { const int hd = (nn - 1024) >> 6, d = nn & 63; nn = 1024 + 128 * (d >> 5) + 32 * hd + (d & 31); }
    }
    u32x4 o0, o1;
    o0.x = pk2(L[(ks + 0) * 65 + n], L[(ks + 1) * 65 + n]); o0.y = pk2(L[(ks + 2) * 65 + n], L[(ks + 3) * 65 + n]);
    o0.z = pk2(L[(ks + 4) * 65 + n], L[(ks + 5) * 65 + n]); o0.w = pk2(L[(ks + 6) * 65 + n], L[(ks + 7) * 65 + n]);
    o1.x = pk2(L[(ks + 8) * 65 + n], L[(ks + 9) * 65 + n]); o1.y = pk2(L[(ks + 10) * 65 + n], L[(ks + 11) * 65 + n]);
    o1.z = pk2(L[(ks + 12) * 65 + n], L[(ks + 13) * 65 + n]); o1.w = pk2(L[(ks + 14) * 65 + n], L[(ks + 15) * 65 + n]);
    bf16* d = dst + (size_t)nn * K + tk * 64 + ks;
    *(u32x4*)d = o0; *(u32x4*)(d + 8) = o1;
    __syncthreads();
}
constexpr int CV0 = 704, CV1 = 1408, CV2 = 1760, CV3 = 2112, CV4 = 2656, CV5 = 2720, CV6 = 2784, CV_TOTAL = 2912;
DI void conv_item(const Params& p, int l, int it, ldsp lds) {
    if (it < CV0) conv_tile(p.in[I_W13] + (size_t)(l * 2 + 0) * 1024 * 5632, (bf16*)(p.ws + O_W13), 1024, 5632, 1, it, lds);
    else if (it < CV1) conv_tile(p.in[I_W13] + (size_t)(l * 2 + 1) * 1024 * 5632, (bf16*)(p.ws + O_W13) + (size_t)5632 * 1024, 1024, 5632, 1, it - CV0, lds);
    else if (it < CV2) conv_tile(p.in[I_W2] + (size_t)(l * 2 + 0) * 2816 * 1024, (bf16*)(p.ws + O_W2), 2816, 1024, 0, it - CV1, lds);
    else if (it < CV3) conv_tile(p.in[I_W2] + (size_t)(l * 2 + 1) * 2816 * 1024, (bf16*)(p.ws + O_W2) + (size_t)1024 * 2816, 2816, 1024, 0, it - CV2, lds);
    else if (it < CV4) conv_tile(p.in[I_WIN] + (size_t)l * 1024 * INW, (bf16*)(p.ws + O_WIN), 1024, INW, 2, it - CV3, lds);
    else if (it < CV5) conv_tile(p.in[I_GLU] + (size_t)l * 256 * 2048, (bf16*)(p.ws + O_WGLU), 256, 2048, 1, it - CV4, lds);
    else if (it < CV6) conv_tile(p.in[I_AO] + (size_t)l * 512 * 1024, (bf16*)(p.ws + O_WAO), 512, 1024, 0, it - CV5, lds);
    else conv_tile(p.in[I_WO] + (size_t)l * 1024 * 1024, (bf16*)(p.ws + O_WOUT), 1024, 1024, 0, it - CV6, lds);
}
DI void mod_item(const Params& p, int it, ldsp lds) {
    const int tid = threadIdx.x, lane = tid & 63, w = tid >> 6;
    const int c0 = it * 256 + lane * 4, l = c0 / 9216, col = c0 % 9216;
    const float* W = p.in[I_MODW] + (size_t)l * 1024 * 9216 + col;
    f32x4 a0 = {0.f, 0.f, 0.f, 0.f}, a1 = {0.f, 0.f, 0.f, 0.f};
#pragma unroll 8
    for (int k = w * 128; k < w * 128 + 128; ++k) {
        const f32x4 wv = *(const f32x4*)(W + (size_t)k * 9216);
        const float c = p.in[I_C][k], cc = p.in[I_CCTX][k];
        const float s0 = c * sigmoidf_(c), s1 = cc * sigmoidf_(cc);
        a0 += wv * s0; a1 += wv * s1;
    }
    LAS f32x4* L = (LAS f32x4*)lds;
    L[(w * 64 + lane) * 2] = a0; L[(w * 64 + lane) * 2 + 1] = a1;
    __syncthreads();
    if (w == 0) {
        f32x4 b = *(const f32x4*)(p.in[I_MODB] + (size_t)l * 9216 + col);
        f32x4 r0 = b, r1 = b;
#pragma unroll
        for (int q = 0; q < 8; ++q) { r0 += L[(q * 64 + lane) * 2]; r1 += L[(q * 64 + lane) * 2 + 1]; }
        float* M = (float*)(p.ws + O_MODS);
        *(f32x4*)(M + (size_t)(0 * 2 + l) * 9216 + col) = r0;
        *(f32x4*)(M + (size_t)(1 * 2 + l) * 9216 + col) = r1;
    }
    __syncthreads();
}
DI void pw_item(const Params& p, int l, int it) {
    const int idx = it * 512 + threadIdx.x;
    if (idx >= 2048 * 33) return;
    const int st = idx / 33, e = idx % 33;
    const int dg = st >> 6;
    const double are = p.in[I_ARE][(size_t)l * 2048 + st], aim = p.in[I_AIM][(size_t)l * 2048 + st];
    const double dt = dexp((double)p.in[I_LOGDT][l * 32 + dg]);
    const double mag = dexp(are * dt * e);
    double s, c; dsincos(aim * dt * e, s, c);
    ((float2*)(p.ws + O_PW))[idx] = make_float2((float)(mag * c), (float)(mag * s));
    if (e == 1) {
        const double nr = mag * c - 1.0, ni = mag * s, den = are * are + aim * aim;
        ((float2*)(p.ws + O_CF))[st] = make_float2((float)((nr * are + ni * aim) / den), (float)((ni * are - nr * aim) / den));
    }
}
DI void wp_item(const Params& p, int l, int it) {
    const int k = it >> 1, n = (it & 1) * 512 + threadIdx.x, g = k >> 6, c = k & 63;
    const float* pw = p.in[I_POOLW] + (size_t)l * 4 * 64 * 64 + (size_t)(g * 64 + c) * 64;
    const float* ps = p.in[I_POOLS] + l * 256 + g * 64;
    const float* po = p.in[I_POOLO] + (size_t)l * 256 * 1024 + (size_t)(g * 64) * 1024 + n;
    float s = 0.f;
#pragma unroll 8
    for (int d = 0; d < 64; ++d) s += pw[d] * ps[d] * po[(size_t)d * 1024];
    ((bf16*)(p.ws + O_WP))[(size_t)n * 256 + k] = f2bf(s);
}
DI void rope_item(const Params& p, int it) {
    const int idx = it * 512 + threadIdx.x;
    const int pos = idx >> 4, i = idx & 15;
    const double inv = dexp(-(double)i * (9.210340371976184 / 16.0));
    double s, c; dsincos((double)pos * inv, s, c);
    ((float2*)(p.ws + O_ROPE))[idx] = make_float2((float)c, (float)s);
}
DI void ktab_item(const Params& p, int l, int it, ldsp lds) {
    const int tid = threadIdx.x & 255, half = threadIdx.x >> 8;
    const int lag = (it & 15) * 2 + half, dg = it >> 4;
    LAS f32x2* Wl = (LAS f32x2*)lds + half * 64;
    if (tid < 64) {
        const float2 z = ((const float2*)(p.ws + O_PW))[(size_t)(dg * 64 + tid) * 33 + lag], cf = ((const float2*)(p.ws + O_CF))[dg * 64 + tid];
        Wl[tid] = (f32x2){z.x * cf.x - z.y * cf.y, z.x * cf.y + z.y * cf.x};
    }
    __syncthreads();
    const int hp = tid >> 4, hh = tid & 15;
    const size_t pb = (size_t)(l * 32 + dg) * 1024;
    const float* cre = p.in[I_CRE] + pb + hp * 64, *cim = p.in[I_CIM] + pb + hp * 64;
    const float* bre = p.in[I_BRE] + pb + hh, *bim = p.in[I_BIM] + pb + hh;
    float s = 0.f;
#pragma unroll 8
    for (int q = 0; q < 64; ++q) {
        const f32x2 wv = Wl[q];
        const float br = bre[q * 16], bi = bim[q * 16];
        const float tr = wv.x * br - wv.y * bi, ti = wv.x * bi + wv.y * br;
        s += cre[q] * tr - cim[q] * ti;
    }
    ((float*)(p.ws + O_KTAB))[(size_t)(dg * 32 + lag) * 256 + tid] = s;
    __syncthreads();
}
DI void w1_item(const Params& p, int l, int it) {
    const int idx = it * 512 + threadIdx.x;
    const int k8 = idx & 63, n = (idx >> 6) & 255, g = idx >> 14;
    const int dir = n >> 7, ri = (n >> 6) & 1, pp = n & 63, j = k8 >> 1, h0 = (k8 & 1) * 8;
    const int e = dir ? j : 31 - j, st = (dir * 16 + g) * 64 + pp;
    const float2 z = ((const float2*)(p.ws + O_PW))[(size_t)st * 33 + e], cf = ((const float2*)(p.ws + O_CF))[st];
    const float wr = z.x * cf.x - z.y * cf.y, wi = z.x * cf.y + z.y * cf.x;
    const float* bre = p.in[I_BRE] + (size_t)(l * 32 + dir * 16 + g) * 1024 + pp * 16 + h0;
    const float* bim = p.in[I_BIM] + (size_t)(l * 32 + dir * 16 + g) * 1024 + pp * 16 + h0;
    float o[8];
#pragma unroll
    for (int q = 0; q < 8; ++q) o[q] = ri ? (wr * bim[q] + wi * bre[q]) : (wr * bre[q] - wi * bim[q]);
    u32x4 v; v.x = pk2(o[0], o[1]); v.y = pk2(o[2], o[3]); v.z = pk2(o[4], o[5]); v.w = pk2(o[6], o[7]);
    *(u32x4*)((bf16*)(p.ws + O_W1S) + ((size_t)g * 256 + n) * 512 + k8 * 8) = v;
}
DI void w3_item(const Params& p, int l, int it) {
    const int idx = it * 512 + threadIdx.x;
    const int k8 = idx & 31, n = (idx >> 5) & 511, g = idx >> 14;
    const int dir = k8 >> 4, ri = (k8 >> 3) & 1, p0 = (k8 & 7) * 8, j = n >> 4, hp = n & 15;
    const int e = dir ? 32 - j : j + 1;
    const float* cre = p.in[I_CRE] + (size_t)(l * 32 + dir * 16 + g) * 1024 + hp * 64 + p0;
    const float* cim = p.in[I_CIM] + (size_t)(l * 32 + dir * 16 + g) * 1024 + hp * 64 + p0;
    const float2* pw = (const float2*)(p.ws + O_PW) + (size_t)((dir * 16 + g) * 64 + p0) * 33 + e;
    float o[8];
#pragma unroll
    for (int q = 0; q < 8; ++q) { const float2 z = pw[q * 33]; o[q] = ri ? -(cre[q] * z.y + cim[q] * z.x) : (cre[q] * z.x - cim[q] * z.y); }
    u32x4 v; v.x = pk2(o[0], o[1]); v.y = pk2(o[2], o[3]); v.z = pk2(o[4], o[5]); v.w = pk2(o[6], o[7]);
    *(u32x4*)((bf16*)(p.ws + O_W3S) + ((size_t)g * 512 + n) * 256 + k8 * 8) = v;
}
DI void toep_item(const Params& p, int l, int it) {
    const int idx = it * 512 + threadIdx.x;
    const int k8 = idx & 63, n = (idx >> 6) & 511, g = idx >> 15;
    const int j2 = k8 >> 1, h0 = (k8 & 1) * 8, j = n >> 4, hp = n & 15;
    const float* KT = (const float*)(p.ws + O_KTAB);
    float o[8];
#pragma unroll
    for (int q = 0; q < 8; ++q) o[q] = 0.f;
    if (j2 <= j) { const float* kf = KT + ((size_t)(0 * 16 + g) * 32 + (j - j2)) * 256 + hp * 16 + h0;
#pragma unroll
        for (int q = 0; q < 8; ++q) o[q] += kf[q]; }
    if (j2 >= j) { const float* kb = KT + ((size_t)(1 * 16 + g) * 32 + (j2 - j)) * 256 + hp * 16 + h0;
#pragma unroll
        for (int q = 0; q < 8; ++q) o[q] += kb[q]; }
    if (j2 == j) {
        const float dd = p.in[I_SD][l * 256 + g * 16 + hp];
#pragma unroll
        for (int q = 0; q < 8; ++q) if (h0 + q == hp) o[q] += dd;
    }
    u32x4 v; v.x = pk2(o[0], o[1]); v.y = pk2(o[2], o[3]); v.z = pk2(o[4], o[5]); v.w = pk2(o[6], o[7]);
    *(u32x4*)((bf16*)(p.ws + O_TOEP) + ((size_t)g * 512 + n) * 512 + k8 * 8) = v;
}

constexpr int PH_PER_LAYER = 14, N_PHASES = 2 * PH_PER_LAYER + 1;
#define SUBLOOP(n, call) { for (int it = ((b - off) % G + G) % G; it < (n); it += G) { call; } off = (off + (n)) % G; }
DI void run_phase(const Params& p, const int ph, ldsp lds) {
    const int G = gridDim.x, b = blockIdx.x;
    if (ph == 2 * PH_PER_LAYER) { for (int it = b; it < NL / 8; it += G) final_norm_item(p, it); return; }
    const int l = ph / PH_PER_LAYER, s = ph % PH_PER_LAYER;
    const int mtiles = (l == 1) ? 64 : 65;
    const bf16* HID = (const bf16*)(p.ws + O_BIG);
    const bf16* W2 = (const bf16*)(p.ws + O_W2);
    int off = 0;
#ifdef ONLY_S
    if (s != ONLY_S) return;
#endif
    switch (s) {
    case 0: {
        if (l == 0 && G == 256) {
            unsigned* cm = (unsigned*)(p.ws + O_BAR) + XB_CNT(6);
            if (b < 72) {
                mod_item(p, b, lds); signal_count(cm);
                for (int it = b; it < 132; it += 72) pw_item(p, l, it);
                if (b < 8) rope_item(p, b);
            } else {
                for (int it = b - 72; it < 512; it += 184) wp_item(p, l, it);
                for (int it = b - 72; it < CV_TOTAL; it += 184) conv_item(p, l, it, lds);
            }
            wait_count(cm, 72u);
            SUBLOOP(NT / 8, norm_item(p, l, 0, it))
        } else {
            SUBLOOP(((l == 0) ? 72 : 0), mod_item(p, it, lds))
            SUBLOOP(132, pw_item(p, l, it))
            SUBLOOP(512, wp_item(p, l, it))
            SUBLOOP(((l == 0) ? 8 : 0), rope_item(p, it))
            SUBLOOP(CV_TOTAL, conv_item(p, l, it, lds))
        }
    } break;
    case 1: if (l == 0 && G != 256) { SUBLOOP(NT / 8, norm_item(p, l, 0, it)) } break;
    case 2: {
        big_ffn_a(p, 0, NT, lds);
        const int busy = 65 * 22 - 5 * G;
        if (G == 256 && b >= busy) for (int it = b - busy; it < 512; it += G - busy) ktab_item(p, l, it, lds);
        else if (G != 256) { SUBLOOP(512, ktab_item(p, l, it, lds)) }
    } break;
    case 3: big_resid(p, HID, W2, DFF, l, 2, 0.5f, l == 0, true, 0, l, 1, false, lds); break;
    case 4: break;
    case 5: {
        big_inproj(p, l, lds);
        const int busy = 65 * 17 - 4 * G;
        if (G == 256 && b >= busy) {
            const int nb = G - busy;
            for (int it = b - busy; it < 2048; it += nb) { if (it < 512) w1_item(p, l, it); else if (it < 1024) w3_item(p, l, it - 512); else toep_item(p, l, it - 1024); }
        } else if (G != 256) { SUBLOOP(512, w1_item(p, l, it)) SUBLOOP(512, w3_item(p, l, it)) SUBLOOP(1024, toep_item(p, l, it)) }
    } break;
    case 6: {
        unsigned* cw = (unsigned*)(p.ws + O_BAR);
        unsigned* c1 = cw + XB_CNT(2 * l), *c2 = cw + XB_CNT(2 * l + 1);
        if (b < 48) { s1_item(p, b, lds); signal_count(c1); }
        else if (b < 52) { wait_count(c1, 48u); s2_item(p, b - 48); signal_count(c2); }
        if (b < 160) for (int it = b; it < mtiles * 4; it += 160) pool_item(p, it);
        off = 52;
        SUBLOOP(((l == 0) ? 8 : 0), attn_dispatch(p, l, 64, it, lds))
        SUBLOOP(512, attn_dispatch(p, l, it >> 3, it & 7, lds))
        wait_count(c2, 4u);
        for (int it = G - 1 - b; it < 96; it += G) s3_item(p, it, lds);
    } break;
    case 7: break;
    case 8: break;
    case 9: big_mix1(p, mtiles * 256, lds); break;
    case 10: big_resid(p, (const bf16*)(p.ws + O_H), (const bf16*)(p.ws + O_WOUT), D, l, 5, 1.0f, false, l == 0, 1, l, 2, false, lds); break;
    case 11: break;
    case 12: big_ffn_a(p, 1, mtiles * 256, lds); break;
    case 13: big_resid(p, HID, W2 + (size_t)1024 * DFF, DFF, l, 8, 0.5f, false, l == 0, 2, l + 1, 0, l == 1, lds); break;
    }
}

__global__ void __launch_bounds__(512, 2) hybrid_fwd(Params p, int ph_lo, int ph_hi) {
    __shared__ __attribute__((aligned(16))) char lds_raw[LDS_BYTES];
    ldsp lds = (ldsp)lds_raw;
    __shared__ uint4 xb_words;
    if (p.ws == nullptr) cg::this_grid().sync();
    XcdBarrier bar;
    const bool multi = (ph_hi - ph_lo) > 1;
    if (multi) {
        if (threadIdx.x == 0) xb_words = make_uint4(0u, 0u, 0u, 0u);
        __syncthreads();
        bar = xcd_barrier_post((unsigned*)(p.ws + O_BAR), (volatile LAS unsigned*)&xb_words);
    }
#define PH(k) if (ph_lo <= (k) && (k) < ph_hi) { if ((k) > ph_lo) xcd_barrier(bar); run_phase(p, (k), lds); }
    PH(0) if (gridDim.x != 256) { PH(1) } PH(2) PH(3) PH(5) PH(6) PH(9) PH(10) PH(12) PH(13)
    PH(14) PH(16) PH(17) PH(19) PH(20) PH(23) PH(24) PH(26) PH(27)
}

extern "C" void kernel_launch(void* const* d_in, const int* in_sizes, int n_in, void* d_out, int out_size, void* d_ws, size_t ws_size, hipStream_t stream) {
    (void)in_sizes; (void)n_in; (void)out_size;
    if (ws_size < O_END) { fprintf(stderr, "workspace too small: %zu < %zu\n", ws_size, (size_t)O_END); return; }
    static int grid_blocks = 0;
    if (!grid_blocks) {
        int dev = 0, cus = 0, per_cu = 0;
        (void)hipGetDevice(&dev);
        (void)hipDeviceGetAttribute(&cus, hipDeviceAttributeMultiprocessorCount, dev);
        (void)hipOccupancyMaxActiveBlocksPerMultiprocessor(&per_cu, hybrid_fwd, 512, 0);
        if (per_cu > 1) per_cu = 1;
        if (per_cu < 1) per_cu = 1;
        grid_blocks = cus * per_cu;
    }
    Params p{};
    for (int i = 0; i < 27; ++i) p.in[i] = (const float*)d_in[i];
    p.out = (float*)d_out; p.ws = (char*)d_ws;
#if MK_ONE_LAUNCH
    (void)hipMemsetAsync(d_ws, 0, 32768, stream);
    int lo = 0, hi = N_PHASES;
    void* args[] = {&p, &lo, &hi};
    hipError_t e = hipLaunchCooperativeKernel((void*)hybrid_fwd, dim3(grid_blocks), dim3(512), args, 0, stream);
    if (e != hipSuccess) fprintf(stderr, "cooperative launch failed: %s (grid %d)\n", hipGetErrorString(e), grid_blocks);
#else
    for (int ph = 0; ph < N_PHASES; ++ph) hipLaunchKernelGGL(hybrid_fwd, dim3(grid_blocks), dim3(512), 0, stream, p, ph, ph + 1);
#endif
}
```

```cpp
#include <hip/hip_runtime.h>
#include <hip/hip_cooperative_groups.h>
#include <cstdio>
#include <cstdint>
namespace cg = cooperative_groups;

#define DI __device__ __forceinline__
#define LAS __attribute__((address_space(3)))
typedef __attribute__((address_space(3))) char* ldsp;
typedef const __attribute__((address_space(3))) char* cldsp;
typedef unsigned short bf16;
typedef short bf16x8 __attribute__((ext_vector_type(8)));
typedef float f32x16 __attribute__((ext_vector_type(16)));
typedef float f32x4 __attribute__((ext_vector_type(4)));
typedef float f32x2 __attribute__((ext_vector_type(2)));
typedef unsigned u32x4 __attribute__((ext_vector_type(4)));
typedef unsigned u32x2 __attribute__((ext_vector_type(2)));
typedef __bf16 hbf2 __attribute__((ext_vector_type(2)));

#ifndef MK_ONE_LAUNCH
#define MK_ONE_LAUNCH 1
#endif

constexpr int D = 1024, NL = 16384, NC = 256, NT = NL + NC, DFF = 2816, INW = 4352;
constexpr int NCH = NT / 32;

enum { I_X = 0, I_C, I_CTX, I_CCTX, I_MODW, I_MODB, I_NORMG, I_W13, I_W2, I_WIN, I_POOLW, I_POOLS, I_POOLO, I_ARE, I_AIM, I_LOGDT,
       I_BRE, I_BIM, I_CRE, I_CIM, I_SD, I_GLU, I_QG, I_KG, I_AO, I_WO, I_FG };

constexpr size_t al(size_t x) { return (x + 255) & ~(size_t)255; }
constexpr size_t O_BAR = 0;
constexpr size_t O_X = 32768;
constexpr size_t O_H = O_X + al((size_t)NT * D * 4);
constexpr size_t O_BIG = O_H + al((size_t)NT * D * 2);
constexpr size_t O_Q = O_BIG + al((size_t)NT * 3072 * 2);
constexpr size_t O_K = O_Q + al((size_t)NT * 512 * 2);
constexpr size_t O_VT = O_K + al((size_t)NT * 128 * 2);
constexpr size_t O_A = O_VT + al((size_t)NT * 128 * 2);
constexpr size_t O_S = O_A + al((size_t)NT * 256 * 2);
constexpr size_t O_YP = O_S + al((size_t)NT * 256 * 2);
constexpr size_t O_YS = O_YP + al((size_t)NT * 256 * 2);
constexpr size_t O_CARRY = O_YS + al((size_t)NT * 256 * 2);
constexpr size_t O_E = O_CARRY + al((size_t)NCH * 16 * 256 * 2);
constexpr size_t O_W13 = O_E + al((size_t)NCH * 16 * 256 * 4);
constexpr size_t O_W2 = O_W13 + al((size_t)2 * 5632 * 1024 * 2);
constexpr size_t O_WIN = O_W2 + al((size_t)2 * 1024 * 2816 * 2);
constexpr size_t O_WGLU = O_WIN + al((size_t)INW * 1024 * 2);
constexpr size_t O_WAO = O_WGLU + al((size_t)2048 * 256 * 2);
constexpr size_t O_WOUT = O_WAO + al((size_t)1024 * 512 * 2);
constexpr size_t O_WP = O_WOUT + al((size_t)1024 * 1024 * 2);
constexpr size_t O_TOEP = O_WP + al((size_t)1024 * 256 * 2);
constexpr size_t O_W1S = O_TOEP + al((size_t)16 * 512 * 512 * 2);
constexpr size_t O_W3S = O_W1S + al((size_t)16 * 256 * 512 * 2);
constexpr size_t O_KTAB = O_W3S + al((size_t)16 * 512 * 256 * 2);
constexpr size_t O_PW = O_KTAB + al((size_t)2 * 16 * 32 * 256 * 4);
constexpr size_t O_CF = O_PW + al((size_t)2048 * 33 * 8);
constexpr size_t O_MODS = O_CF + al((size_t)2048 * 8);
constexpr size_t O_ROPE = O_MODS + al((size_t)2 * 2 * 9216 * 4);
constexpr size_t O_END = O_ROPE + al((size_t)256 * 16 * 8);

struct Params { const float* in[27]; float* out; char* ws; };

DI unsigned pk2(float a, float b) { f32x2 v = {a, b}; return __builtin_bit_cast(unsigned, __builtin_convertvector(v, hbf2)); }
DI bf16 f2bf(float a) { return (bf16)(pk2(a, 0.f) & 0xffffu); }
DI float bf2f(bf16 b) { return __uint_as_float(((unsigned)b) << 16); }
DI float bflo(unsigned u) { return __uint_as_float(u << 16); }
DI float bfhi(unsigned u) { return __uint_as_float(u & 0xffff0000u); }
DI float sigmoidf_(float x) { return __builtin_amdgcn_rcpf(1.f + __builtin_amdgcn_exp2f(-1.4426950408889634f * x)); }
DI float wave_sum(float v) {
#pragma unroll
    for (int o = 32; o >= 1; o >>= 1) v += __shfl_xor(v, o);
    return v;
}
#define AT(T, base, idx) (*(T*)((char*)(base) + (unsigned)((unsigned)(idx) * (unsigned)sizeof(T))))
#define MFMA(a, b, c) __builtin_amdgcn_mfma_f32_32x32x16_bf16((a), (b), (c), 0, 0, 0)

DI double dexp(double x) {
    const double n = __builtin_rint(x * 1.4426950408889634);
    const double r = x - n * 0.6931471805599453;
    double t = 1.0;
#pragma unroll
    for (int k = 16; k >= 1; --k) t = 1.0 + t * r * (1.0 / (double)k);
    const long long e = (long long)n + 1023;
    return t * __longlong_as_double(e << 52);
}
DI void dsincos(double th, double& s, double& c) {
    const double k = __builtin_rint(th * 0.15915494309189535);
    const double x = th - k * 6.283185307179586 - k * 2.4492935982947064e-16;
    const double x2 = x * x;
    double cs = 1.0, sn = 1.0;
#pragma unroll
    for (int j = 17; j >= 1; --j) {
        cs = 1.0 - cs * x2 * (1.0 / (double)((2 * j - 1) * (2 * j)));
        sn = 1.0 - sn * x2 * (1.0 / (double)((2 * j) * (2 * j + 1)));
    }
    c = cs; s = sn * x;
}

#define XB_TMO      128
#define XB_XCNT(j)  (256  + 64 * (j))
#define XB_XSUB(j)  (1280 + 64 * (j))
#define XB_XGEN(j)  (2304 + 64 * (j))
#define XB_TOP      3328
#define XB_TOPGEN   3392
#define XCD_BAR_WORDS 3456
#define XB_SPIN_CAP (1u << 22)
DI unsigned xb_ld(unsigned* p)              { return __hip_atomic_load(p, __ATOMIC_RELAXED, __HIP_MEMORY_SCOPE_AGENT); }
DI unsigned xb_add(unsigned* p, unsigned v) { return __hip_atomic_fetch_add(p, v, __ATOMIC_RELAXED, __HIP_MEMORY_SCOPE_AGENT); }
DI unsigned xb_xcc_id() { return (unsigned)__builtin_amdgcn_s_getreg((3 << 11) | 20) & 0xFu; }
#define XB_SPIN(cond, bar) do { unsigned _sp = 0; while (cond) { __builtin_amdgcn_s_sleep(1); \
    if ((++_sp & 255u) == 0u) { if (xb_ld(&(bar)[XB_TMO])) break; if (_sp > XB_SPIN_CAP) { atomicAdd(&(bar)[XB_TMO], 1u); break; } } } } while (0)
struct XcdBarrier { unsigned* bar; unsigned x; volatile LAS unsigned* st; };
DI XcdBarrier xcd_barrier_post(unsigned* bar, volatile LAS unsigned* st) {
    XcdBarrier b; b.bar = bar; b.x = xb_xcc_id(); b.st = st;
    if (threadIdx.x == 0) (void)xb_add(&bar[XB_XCNT(b.x)], 1u);
    return b;
}
DI void xcd_barrier_complete(unsigned* bar, unsigned x, unsigned& nloc, unsigned& nx) {
    const unsigned G = gridDim.x * gridDim.y * gridDim.z;
    unsigned sum, cnt, mine, sp = 0u;
    for (;;) {
        sum = 0u; cnt = 0u; mine = 0u;
#pragma unroll
        for (unsigned j = 0; j < 16; ++j) { const unsigned c = xb_ld(&bar[XB_XCNT(j)]); sum += c; cnt += (c > 0u) ? 1u : 0u; mine = (j == x) ? c : mine; }
        if (sum == G) break;
        __builtin_amdgcn_s_sleep(1);
        if ((++sp & 255u) == 0u) { if (xb_ld(&bar[XB_TMO])) break; if (sp > XB_SPIN_CAP) { atomicAdd(&bar[XB_TMO], 1u); break; } }
    }
    nloc = mine > 0u ? mine : 1u; nx = cnt > 0u ? cnt : 1u;
}
DI void xcd_barrier(const XcdBarrier& b) {
    asm volatile("s_waitcnt vmcnt(0)" ::: "memory");
    __syncthreads();
    if (threadIdx.x == 0) {
        unsigned* bar = b.bar;
        __builtin_amdgcn_s_waitcnt(0);
        unsigned nloc = b.st[0], nx = b.st[1];
        if (nloc == 0u) { xcd_barrier_complete(bar, b.x, nloc, nx); b.st[0] = nloc; b.st[1] = nx; }
        const unsigned old = xb_add(&bar[XB_XSUB(b.x)], 1u);
        const unsigned gen = old / nloc;
        if (old + 1u == (gen + 1u) * nloc) {
            __builtin_amdgcn_fence(__ATOMIC_RELEASE, "agent");
            asm volatile("s_waitcnt vmcnt(0)" ::: "memory");
            const unsigned og = xb_add(&bar[XB_TOP], 1u);
            const unsigned tg = og / nx;
            if (og + 1u == (tg + 1u) * nx) xb_add(&bar[XB_TOPGEN], 1u);
            else XB_SPIN(xb_ld(&bar[XB_TOPGEN]) == tg, bar);
            __builtin_amdgcn_fence(__ATOMIC_ACQUIRE, "agent");
            xb_add(&bar[XB_XGEN(b.x)], 1u);
            asm volatile("s_waitcnt vmcnt(0)" ::: "memory");
        } else {
            XB_SPIN(xb_ld(&bar[XB_XGEN(b.x)]) == gen, bar);
            __builtin_amdgcn_fence(__ATOMIC_ACQUIRE, "agent");
            asm volatile("s_waitcnt vmcnt(0)" ::: "memory");
        }
    }
    __syncthreads();
}


#define XB_CNT(k) (3584 + 64 * (k))
DI void signal_count(unsigned* w) {
    asm volatile("s_waitcnt vmcnt(0)" ::: "memory");
    __syncthreads();
    if (threadIdx.x == 0) { __builtin_amdgcn_fence(__ATOMIC_RELEASE, "agent"); asm volatile("s_waitcnt vmcnt(0)" ::: "memory"); (void)xb_add(w, 1u); }
}
DI void wait_count(unsigned* w, unsigned target) {
    if (threadIdx.x == 0) {
        unsigned sp = 0;
        while (xb_ld(w) < target) { __builtin_amdgcn_s_sleep(4); if (++sp > (1u << 24)) break; }
        __builtin_amdgcn_fence(__ATOMIC_ACQUIRE, "agent");
        asm volatile("s_waitcnt vmcnt(0)" ::: "memory");
    }
    __syncthreads();
}

constexpr int LROW = 144;
constexpr int LTILE = 256 * LROW;
constexpr int LSTAGE = 2 * LTILE;
constexpr int LDS_BYTES = 2 * LSTAGE;

template <int AMODE, int NRB, int NCB>
DI void gemm_acc(f32x16 (&acc)[NRB][NCB], const bf16* __restrict__ A, const long lda, const int arow0,
                 const bf16* __restrict__ Bt, const long ldb, const int brow0, const int K, ldsp lds) {
    int tid_ = threadIdx.x; asm volatile("" : "+v"(tid_));
    const int tid = tid_, lane = tid & 63, w = tid >> 6, wm = w >> 2, wn = w & 3, r = lane & 31, h = lane >> 5;
    const int v = tid & 7, lr = tid >> 3;
    const int avoff = AMODE ? ((v >> 1) * 256 + (v & 1) * 8) : v * 8;
    const int akstep = AMODE ? 1024 : 64;
    const bf16* ag = A + (long)(arow0 + lr) * lda + avoff;
    const bf16* bg = Bt + (long)(brow0 + lr) * ldb + v * 8;
    const int nk = K >> 6;
    u32x4 ra[NRB], rb[2 * NCB];
#pragma unroll
    for (int i = 0; i < NRB; ++i) ra[i] = *(const u32x4*)(ag + (long)i * 64 * lda);
#pragma unroll
    for (int i = 0; i < 2 * NCB; ++i) rb[i] = *(const u32x4*)(bg + (long)i * 64 * ldb);
    ldsp wr = lds + lr * LROW + v * 16;
#pragma unroll
    for (int i = 0; i < NRB; ++i) *(LAS u32x4*)(wr + i * 64 * LROW) = ra[i];
#pragma unroll
    for (int i = 0; i < 2 * NCB; ++i) *(LAS u32x4*)(wr + LTILE + i * 64 * LROW) = rb[i];
    __syncthreads();
    cldsp la = lds + (wm * 32 * NRB + r) * LROW + h * 16;
    cldsp lb = lds + LTILE + (wn * 32 * NCB + r) * LROW + h * 16;
    for (int kt = 0; kt < nk; ++kt) {
        const int buf = kt & 1;
        const bool more = (kt + 1 < nk);
        if (more) {
            ag += akstep; bg += 64;
#pragma unroll
            for (int i = 0; i < NRB; ++i) ra[i] = *(const u32x4*)(ag + (long)i * 64 * lda);
#pragma unroll
            for (int i = 0; i < 2 * NCB; ++i) rb[i] = *(const u32x4*)(bg + (long)i * 64 * ldb);
        }
        __builtin_amdgcn_sched_barrier(0);
        cldsp pa = la + buf * LSTAGE; cldsp pb = lb + buf * LSTAGE;
#pragma unroll
        for (int s = 0; s < 4; ++s) {
            bf16x8 af[NRB], bfr[NCB];
#pragma unroll
            for (int rb_ = 0; rb_ < NRB; ++rb_) af[rb_] = *(const LAS bf16x8*)(pa + rb_ * 32 * LROW + s * 32);
#pragma unroll
            for (int cb = 0; cb < NCB; ++cb) bfr[cb] = *(const LAS bf16x8*)(pb + cb * 32 * LROW + s * 32);
#pragma unroll
            for (int rb_ = 0; rb_ < NRB; ++rb_)
#pragma unroll
                for (int cb = 0; cb < NCB; ++cb) acc[rb_][cb] = MFMA(af[rb_], bfr[cb], acc[rb_][cb]);
        }
        __builtin_amdgcn_sched_barrier(0);
        if (more) {
            ldsp w2 = wr + (buf ^ 1) * LSTAGE;
#pragma unroll
            for (int i = 0; i < NRB; ++i) *(LAS u32x4*)(w2 + i * 64 * LROW) = ra[i];
#pragma unroll
            for (int i = 0; i < 2 * NCB; ++i) *(LAS u32x4*)(w2 + LTILE + i * 64 * LROW) = rb[i];
        }
        __syncthreads();
    }
}
template <int NRB, int NCB>
DI void zero_acc(f32x16 (&acc)[NRB][NCB]) {
#pragma unroll
    for (int a = 0; a < NRB; ++a)
#pragma unroll
        for (int b = 0; b < NCB; ++b)
#pragma unroll
            for (int i = 0; i < 16; ++i) acc[a][b][i] = 0.f;
}
#define ACC_ROW(rb, i) (wm * 128 + (rb) * 32 + ((i) & 3) + 8 * ((i) >> 2) + 4 * h)
#define ACC_COL(cb) (wn * 64 + (cb) * 32 + r)
#define TID_VARS int tid_ = threadIdx.x; asm volatile("" : "+v"(tid_)); const int tid = tid_, lane = tid & 63, w = tid >> 6, wm = w >> 2, wn = w & 3, r = lane & 31, h = lane >> 5; (void)wm; (void)wn; (void)r; (void)h; (void)lane; (void)w;

DI const float* mods_ptr(const Params& p, int cond, int l, int j) { return (const float*)(p.ws + O_MODS) + ((size_t)(cond * 2 + l) * 9 + j) * 1024; }


namespace pg8 {
#define PG8_LAS __attribute__((address_space(3)))
typedef unsigned short bf16_t;
typedef short bf16x8 __attribute__((ext_vector_type(8)));
typedef float f32x4 __attribute__((ext_vector_type(4)));
typedef unsigned u32x4 __attribute__((ext_vector_type(4)));
constexpr int BM = 256, BK = 64, HALF = 128, HTB = HALF * BK * 2  , STAGE_BYTES = 8 * HTB, NXCD = 8, WGM = 8;

__host__ __device__ __forceinline__ int lds_byte(int r, int c) { const int st = (r >> 4) * 2 + (c >> 5), rr = r & 15, cc = c & 31, ob = rr * 64 + cc * 2; return st * 1024 + (ob ^ (((ob >> 9) & 1) << 5)); }
__host__ __device__ __forceinline__ void stage_rc(int b, int& R, int& C) { const int st = b / 1024, sb = b % 1024, swz = sb ^ (((sb >> 9) & 1) << 5); R = (st >> 1) * 16 + swz / 64; C = (st & 1) * 32 + (swz % 64) / 2; }
__host__ __device__ __forceinline__ int perm32(int rho) { const int n = rho >> 4, i = rho & 15; return 8 * (i >> 2) + 4 * n + (i & 3); }

struct Unit { int pm, pn; };
struct Gemm { const bf16_t* A; const bf16_t* Bt; int K, ld; };

struct StaticOrder {
    int nM, nN, nwg, G, c;
    __host__ __device__ void init(int M, int N, int G_, int c_) { nM = M / BM; nN = N / BM; nwg = nM * nN; G = G_; c = c_; }
    __host__ __device__ bool next(int i, Unit& u) const {
        const long L = (long)i * G + c; if (L >= nwg) return false;
        int wgid = (int)L; { const int q = nwg / NXCD, r = nwg % NXCD, xcd = wgid % NXCD, off = wgid / NXCD; wgid = (xcd < r ? xcd * (q + 1) : r * (q + 1) + (xcd - r) * q) + off; }
        const int nig = WGM * nN, gid = wgid / nig, fm = gid * WGM, gsz = (nM - fm) < WGM ? (nM - fm) : WGM;
        u.pm = fm + ((wgid % nig) % gsz); u.pn = (wgid % nig) / gsz; return true;
    }
    __device__ __forceinline__ void a_ready(const Unit&) const {}
    __device__ __forceinline__ void done(const Unit&) const {}
};

template <class Epi, class Sched, bool ALIGN_EPI = false, bool SP2 = false>
__device__ __forceinline__ void gemm_phase(PG8_LAS unsigned char* lds, const Gemm g, const Sched& S, const Epi& E) {
    int tid_ = threadIdx.x; asm volatile("" : "+v"(tid_));
    const int tid = tid_, wid = __builtin_amdgcn_readfirstlane(tid >> 6), lane = tid & 63, wr = wid >> 2, wc = wid & 3, fr = lane & 15, fq = lane >> 4;
    int K_ = g.K; asm volatile("" : "+s"(K_));
    const int K = K_, nt = K / BK;
    unsigned voffA[2], voffB[2];
#pragma unroll
    for (int i = 0; i < 2; ++i) { int R, C; stage_rc(tid * 16 + i * 8192, R, C); const int Rb = Epi::PERM ? ((R & ~31) + perm32(R & 31)) : R;
        voffA[i] = (unsigned)(R * g.ld + C) * 2u; voffB[i] = (unsigned)(Rb * g.ld + C) * 2u; }
    const size_t kstep = (size_t)(BK * 2);
    const size_t hstep = (size_t)HALF * g.ld * 2;
    const size_t tstep = 2 * hstep;
    const unsigned ldsw = (unsigned)wid * 1024u;
    const int aoff = lds_byte(wr * 64 + fr, fq * 8), boff = lds_byte(wc * 32 + fr, fq * 8);
#define PG8_SA(b, h) (((b) * 2 + (h)) * HTB)
#define PG8_SB(b, h) ((4 + (b) * 2 + (h)) * HTB)
#define PG8_STAGE(bufoff, gbase, voff) do { _Pragma("unroll") for (int _i = 0; _i < 2; ++_i) \
        __builtin_amdgcn_global_load_lds((const unsigned*)((const char*)(gbase) + (voff)[_i]), (PG8_LAS unsigned*)(lds + (bufoff) + ldsw + _i * 8192), 16, 0, 0); } while (0)
#define PG8_LDA(dst, b, h) do { _Pragma("unroll") for (int m = 0; m < 4; ++m) _Pragma("unroll") for (int k = 0; k < 2; ++k) dst[m][k] = *(const PG8_LAS bf16x8*)(lds + PG8_SA(b, h) + aoff + m * 2048 + k * 1024); } while (0)
#define PG8_LDB(dst, b, h) do { _Pragma("unroll") for (int n = 0; n < 2; ++n) _Pragma("unroll") for (int k = 0; k < 2; ++k) dst[n][k] = *(const PG8_LAS bf16x8*)(lds + PG8_SB(b, h) + boff + n * 2048 + k * 1024); } while (0)
#define PG8_MMA(ai, bj, At, Bt) do { __builtin_amdgcn_s_setprio(1); _Pragma("unroll") for (int m = 0; m < 4; ++m) _Pragma("unroll") for (int n = 0; n < 2; ++n) _Pragma("unroll") for (int k = 0; k < 2; ++k) \
        acc[ai][bj][m][n] = __builtin_amdgcn_mfma_f32_16x16x32_bf16(Bt[n][k], At[m][k], acc[ai][bj][m][n], 0, 0, 0); __builtin_amdgcn_s_setprio(0); } while (0)
#define PG8_WAIT_V(n) asm volatile("s_waitcnt vmcnt(" #n ")" ::: "memory")
#define PG8_WAIT_L(n) asm volatile("s_waitcnt lgkmcnt(" #n ")" ::: "memory")
#define PG8_BAR __builtin_amdgcn_s_barrier()
#define PG8_SCHED __builtin_amdgcn_sched_barrier(0)
    Unit cur, nxt; int ui = 0;
    if (!S.next(0, cur)) return;
    f32x4 acc[2][2][4][2];
#pragma unroll
    for (int a = 0; a < 2; ++a)
#pragma unroll
        for (int b = 0; b < 2; ++b)
#pragma unroll
            for (int m = 0; m < 4; ++m)
#pragma unroll
                for (int n = 0; n < 2; ++n) acc[a][b][m][n] = (f32x4){0.f, 0.f, 0.f, 0.f};
    bf16x8 At[4][2], B0[2][2], B1[2][2];
    const char* cA = (const char*)g.A + (size_t)cur.pm * tstep; const char* cB = (const char*)g.Bt + (size_t)cur.pn * tstep;
    S.a_ready(cur);
    if constexpr (SP2) {
        PG8_STAGE(PG8_SB(0, 0), cB, voffB); PG8_STAGE(PG8_SB(0, 1), cB + hstep, voffB); PG8_STAGE(PG8_SA(0, 0), cA, voffA); PG8_STAGE(PG8_SA(0, 1), cA + hstep, voffA);
        if (wr == 1) PG8_BAR;
        PG8_WAIT_V(2); PG8_BAR;
        PG8_STAGE(PG8_SB(1, 0), cB + kstep, voffB); PG8_STAGE(PG8_SA(1, 0), cA + kstep, voffA); PG8_STAGE(PG8_SB(1, 1), cB + hstep + kstep, voffB);
        PG8_WAIT_V(6); PG8_BAR;
    } else {
        PG8_STAGE(PG8_SB(0, 0), cB, voffB); PG8_STAGE(PG8_SA(0, 0), cA, voffA); PG8_STAGE(PG8_SB(0, 1), cB + hstep, voffB); PG8_STAGE(PG8_SA(0, 1), cA + hstep, voffA);
        if (wr == 1) PG8_BAR;
        PG8_WAIT_V(4); PG8_BAR;
        PG8_STAGE(PG8_SB(1, 0), cB + kstep, voffB); PG8_STAGE(PG8_SA(1, 0), cA + kstep, voffA); PG8_STAGE(PG8_SB(1, 1), cB + hstep + kstep, voffB);
        PG8_WAIT_V(6); PG8_BAR;
    }
    for (;;) {
        const bool has_next = S.next(ui + 1, nxt);
        const char* nA = has_next ? (const char*)g.A + (size_t)nxt.pm * tstep : cA; const char* nB = has_next ? (const char*)g.Bt + (size_t)nxt.pn * tstep : cB;
        for (int t = 0; t < nt; t += 2) {
            const bool last = (t == nt - 2);
            const char* a1 = cA + (size_t)(t + 1) * kstep;
            const char* a2 = last ? nA : cA + (size_t)(t + 2) * kstep; const char* b2 = last ? nB : cB + (size_t)(t + 2) * kstep;
            const char* a3 = a2 + kstep; const char* b3 = b2 + kstep;
            if (last && has_next) S.a_ready(nxt);
            if constexpr (SP2) {
            PG8_LDB(B0, 0, 0); PG8_LDB(B1, 0, 1); PG8_SCHED; PG8_LDA(At, 0, 0); PG8_STAGE(PG8_SA(1, 1), a1 + hstep, voffA);
            PG8_WAIT_V(8); PG8_WAIT_L(0); PG8_BAR; PG8_MMA(0, 0, At, B0); PG8_MMA(0, 1, At, B1); PG8_BAR; PG8_SCHED;
            PG8_LDA(At, 0, 1); PG8_STAGE(PG8_SB(0, 0), b2, voffB); PG8_STAGE(PG8_SB(0, 1), b2 + hstep, voffB); PG8_STAGE(PG8_SA(0, 0), a2, voffA);
            PG8_WAIT_V(8); PG8_WAIT_L(0); PG8_BAR; PG8_MMA(1, 0, At, B0); PG8_MMA(1, 1, At, B1); PG8_BAR; PG8_SCHED;
            PG8_LDB(B0, 1, 0); PG8_LDB(B1, 1, 1); PG8_SCHED; PG8_LDA(At, 1, 0); PG8_STAGE(PG8_SA(0, 1), a2 + hstep, voffA);
            PG8_WAIT_V(8); PG8_WAIT_L(0); PG8_BAR; PG8_MMA(0, 0, At, B0); PG8_MMA(0, 1, At, B1); PG8_BAR; PG8_SCHED;
            PG8_LDA(At, 1, 1); PG8_STAGE(PG8_SB(1, 0), b3, voffB); PG8_STAGE(PG8_SB(1, 1), b3 + hstep, voffB); PG8_STAGE(PG8_SA(1, 0), a3, voffA);
            PG8_WAIT_V(8); PG8_WAIT_L(0); PG8_BAR; PG8_MMA(1, 0, At, B0); PG8_MMA(1, 1, At, B1); PG8_BAR; PG8_SCHED;
            } else {
            PG8_LDB(B0, 0, 0); PG8_SCHED; PG8_LDA(At, 0, 0); PG8_STAGE(PG8_SA(1, 1), a1 + hstep, voffA);
            PG8_WAIT_L(8); PG8_BAR; PG8_WAIT_L(0); PG8_MMA(0, 0, At, B0); PG8_BAR; PG8_SCHED;
            PG8_LDB(B1, 0, 1); PG8_STAGE(PG8_SB(0, 0), b2, voffB);
            PG8_BAR; PG8_WAIT_L(0); PG8_MMA(0, 1, At, B1); PG8_BAR;
            PG8_LDA(At, 0, 1); PG8_STAGE(PG8_SA(0, 0), a2, voffA);
            PG8_BAR; PG8_WAIT_L(0); PG8_MMA(1, 0, At, B0); PG8_BAR; PG8_SCHED;
            PG8_STAGE(PG8_SB(0, 1), b2 + hstep, voffB);
            PG8_WAIT_V(6); PG8_BAR; PG8_MMA(1, 1, At, B1); PG8_BAR;
            PG8_LDB(B0, 1, 0); PG8_SCHED; PG8_LDA(At, 1, 0); PG8_STAGE(PG8_SA(0, 1), a2 + hstep, voffA);
            PG8_WAIT_L(8); PG8_BAR; PG8_WAIT_L(0); PG8_MMA(0, 0, At, B0); PG8_BAR; PG8_SCHED;
            PG8_LDB(B1, 1, 1); PG8_STAGE(PG8_SB(1, 0), b3, voffB);
            PG8_BAR; PG8_WAIT_L(0); PG8_MMA(0, 1, At, B1); PG8_BAR;
            PG8_LDA(At, 1, 1); PG8_STAGE(PG8_SA(1, 0), a3, voffA);
            PG8_BAR; PG8_WAIT_L(0); PG8_MMA(1, 0, At, B0); PG8_BAR; PG8_SCHED;
            PG8_STAGE(PG8_SB(1, 1), b3 + hstep, voffB);
            PG8_WAIT_V(6); PG8_BAR; PG8_MMA(1, 1, At, B1); PG8_BAR;
            }
        }
        if constexpr (ALIGN_EPI) { if (wr == 0) PG8_BAR; }
        if constexpr (!Epi::AFTER_DRAIN) { E(acc, cur, wr, wc, fr, fq); S.done(cur); }
        if (!has_next) break;
#pragma unroll
        for (int a = 0; a < 2; ++a)
#pragma unroll
            for (int b = 0; b < 2; ++b)
#pragma unroll
                for (int m = 0; m < 4; ++m)
#pragma unroll
                    for (int n = 0; n < 2; ++n) acc[a][b][m][n] = (f32x4){0.f, 0.f, 0.f, 0.f};
        cur = nxt; cA = nA; cB = nB; ++ui;
        if constexpr (ALIGN_EPI) { if (wr == 1) PG8_BAR; }
    }
    PG8_WAIT_V(0);
    if constexpr (!ALIGN_EPI) { if (wr == 0) PG8_BAR; }
    PG8_BAR;
    if constexpr (Epi::AFTER_DRAIN) { E.fused(acc, cur, wr, wc, fr, fq, lds, wid, lane); S.done(cur); }
#undef PG8_SA
#undef PG8_SB
#undef PG8_STAGE
#undef PG8_LDA
#undef PG8_LDB
#undef PG8_MMA
#undef PG8_WAIT_V
#undef PG8_WAIT_L
#undef PG8_BAR
#undef PG8_SCHED
}
}

struct OneUnit {
    int pm, pn; bool have;
    DI bool next(int i, pg8::Unit& u) const { if (i > 0 || !have) return false; u.pm = pm; u.pn = pn; return true; }
    DI void a_ready(const pg8::Unit&) const {}
    DI void done(const pg8::Unit&) const {}
};
struct EpiFfnA {
    static constexpr bool PERM = true, AFTER_DRAIN = false;
    bf16* hid;
    DI void operator()(const f32x4 (&acc)[2][2][4][2], const pg8::Unit& u, int wr, int wc, int fr, int fq) const {
        asm volatile("" : "+v"(fr), "+v"(fq), "+s"(wr), "+s"(wc));
        const int row0 = u.pm * 256 + wr * 64 + fr, hc0 = u.pn * 128 + wc * 32 + 8 * fq;
#pragma unroll
        for (int ai = 0; ai < 2; ++ai)
#pragma unroll
            for (int m = 0; m < 4; ++m) {
                const int row = row0 + ai * 128 + m * 16;
                float v[8];
#pragma unroll
                for (int n = 0; n < 2; ++n)
#pragma unroll
                    for (int j = 0; j < 4; ++j) { const float g = acc[ai][0][m][n][j], up = acc[ai][1][m][n][j]; v[n * 4 + j] = g * sigmoidf_(g) * up; }
                u32x4 o; o.x = pk2(v[0], v[1]); o.y = pk2(v[2], v[3]); o.z = pk2(v[4], v[5]); o.w = pk2(v[6], v[7]);
                AT(u32x4, hid, (row * DFF + hc0) >> 3) = o;
            }
    }
};
struct EpiResid {
    static constexpr bool PERM = true, AFTER_DRAIN = false;
    float* X; const float* resid; const float* gate; float scale; bool atomic;
    DI void operator()(const f32x4 (&acc)[2][2][4][2], const pg8::Unit& u, int wr, int wc, int fr, int fq) const {
        asm volatile("" : "+v"(fr), "+v"(fq), "+s"(wr), "+s"(wc));
        const int row0 = u.pm * 256 + wr * 64 + fr;
#pragma unroll
        for (int bj = 0; bj < 2; ++bj) {
            const int c0 = u.pn * 256 + bj * 128 + wc * 32 + 8 * fq;
            const f32x4 g0 = *(const f32x4*)(gate + c0) * scale, g1 = *(const f32x4*)(gate + c0 + 4) * scale;
            if (atomic) {
#pragma unroll
                for (int ai = 0; ai < 2; ++ai)
#pragma unroll
                    for (int m = 0; m < 4; ++m) {
                        const int row = row0 + ai * 128 + m * 16;
                        const f32x4 d0 = g0 * acc[ai][bj][m][0], d1 = g1 * acc[ai][bj][m][1];
#pragma unroll
                        for (int j = 0; j < 4; ++j) { atomicAdd(&AT(float, X, row * D + c0 + j), d0[j]); atomicAdd(&AT(float, X, row * D + c0 + 4 + j), d1[j]); }
                    }
            } else {
                f32x4 r0[8], r1[8];
#pragma unroll
                for (int q = 0; q < 8; ++q) { const int row = row0 + (q >> 2) * 128 + (q & 3) * 16; r0[q] = AT(const f32x4, resid, (row * D + c0) >> 2); r1[q] = AT(const f32x4, resid, (row * D + c0 + 4) >> 2); }
#pragma unroll
                for (int q = 0; q < 8; ++q) {
                    const int row = row0 + (q >> 2) * 128 + (q & 3) * 16;
                    AT(f32x4, X, (row * D + c0) >> 2) = r0[q] + g0 * acc[q >> 2][bj][q & 3][0]; AT(f32x4, X, (row * D + c0 + 4) >> 2) = r1[q] + g1 * acc[q >> 2][bj][q & 3][1];
                }
            }
        }
    }
};
struct EpiInproj {
    static constexpr bool PERM = true, AFTER_DRAIN = false;
    char* ws; const float* gq; const float* gk;
    DI void operator()(const f32x4 (&acc)[2][2][4][2], const pg8::Unit& u, int wr, int wc, int fr, int fq) const {
        asm volatile("" : "+v"(fr), "+v"(fq), "+s"(wr), "+s"(wc));
        const int pn = u.pn, row0 = u.pm * 256 + wr * 64 + fr;
        if (pn < 2 || pn > 4) {
            bf16* dst; int ld, cb;
            if (pn == 0) { dst = (bf16*)(ws + O_A); ld = 256; cb = 0; } else if (pn == 1) { dst = (bf16*)(ws + O_S); ld = 256; cb = 0; } else { dst = (bf16*)(ws + O_BIG); ld = 3072; cb = (pn - 5) * 256; }
            const bool sg = pn > 4;
#pragma unroll
            for (int bj = 0; bj < 2; ++bj) {
                const int c0 = cb + bj * 128 + wc * 32 + 8 * fq;
#pragma unroll
                for (int ai = 0; ai < 2; ++ai)
#pragma unroll
                    for (int m = 0; m < 4; ++m) {
                        const int row = row0 + ai * 128 + m * 16;
                        float v[8];
#pragma unroll
                        for (int n = 0; n < 2; ++n)
#pragma unroll
                            for (int j = 0; j < 4; ++j) { const float x = acc[ai][bj][m][n][j]; v[n * 4 + j] = sg ? sigmoidf_(x) : x; }
                        u32x4 o; o.x = pk2(v[0], v[1]); o.y = pk2(v[2], v[3]); o.z = pk2(v[4], v[5]); o.w = pk2(v[6], v[7]);
                        AT(u32x4, dst, (row * ld + c0) >> 3) = o;
                    }
            }
        } else if (pn < 4 || wc < 2) {
            const bool isq = pn < 4;
            const float* gv = isq ? gq : gk;
            const float2* rope = (const float2*)(ws + O_ROPE);
            const bool latent = u.pm < 64;
            const float osc = isq ? 0.125f * 1.4426950408889634f : 1.f, sgn = (fq >= 2) ? 1.f : -1.f;
            bf16* dst = (bf16*)(ws + (isq ? O_Q : O_K));
            const int ld = isq ? 512 : 128, hb = (isq ? (pn - 2) * 4 + wc : wc) * 64 + 8 * fq, i0 = 8 * (fq & 1);
#pragma unroll
            for (int ai = 0; ai < 2; ++ai)
#pragma unroll
                for (int m = 0; m < 4; ++m) {
                    const int row = row0 + ai * 128 + m * 16;
                    float v[2][8]; float ss = 0.f;
#pragma unroll
                    for (int bj = 0; bj < 2; ++bj)
#pragma unroll
                        for (int n = 0; n < 2; ++n)
#pragma unroll
                            for (int j = 0; j < 4; ++j) { const float x = acc[ai][bj][m][n][j]; v[bj][n * 4 + j] = x; ss += x * x; }
                    ss += __shfl_xor(ss, 16); ss += __shfl_xor(ss, 32);
                    const float rstd = rsqrtf(ss * (1.f / 64.f) + 1e-6f);
#pragma unroll
                    for (int bj = 0; bj < 2; ++bj) {
#pragma unroll
                        for (int e = 0; e < 8; ++e) v[bj][e] *= rstd * AT(const float, gv, 32 * bj + 8 * fq + e);
                        if (latent) {
                            const int pos = bj == 0 ? (row >> 6) : (row & 63);
#pragma unroll
                            for (int e = 0; e < 8; ++e) {
                                const float2 cs = AT(const float2, rope, pos * 16 + i0 + e);
                                const float pr = __shfl_xor(v[bj][e], 32);
                                v[bj][e] = v[bj][e] * cs.x + sgn * pr * cs.y;
                            }
                        }
                        u32x4 o; o.x = pk2(v[bj][0] * osc, v[bj][1] * osc); o.y = pk2(v[bj][2] * osc, v[bj][3] * osc); o.z = pk2(v[bj][4] * osc, v[bj][5] * osc); o.w = pk2(v[bj][6] * osc, v[bj][7] * osc);
                        AT(u32x4, dst, (row * ld + hb + 32 * bj) >> 3) = o;
                    }
                    asm volatile("" ::: "memory");
                }
        } else {
            bf16* vt = (bf16*)(ws + O_VT);
#pragma unroll
            for (int bj = 0; bj < 2; ++bj)
#pragma unroll
                for (int ai = 0; ai < 2; ++ai)
#pragma unroll
                    for (int m = 0; m < 4; ++m) {
                        const int row = row0 + ai * 128 + m * 16;
#pragma unroll
                        for (int n = 0; n < 2; ++n)
#pragma unroll
                            for (int j = 0; j < 4; ++j) AT(bf16, vt, ((wc - 2) * 64 + 32 * bj + 8 * fq + 4 * n + j) * NT + row) = f2bf(acc[ai][bj][m][n][j]);
                    }
        }
    }
};
typedef PG8_LAS unsigned char* pg8lds;
DI void big_ffn_a(const Params& p, int f, int M, ldsp lds) {
    pg8::Gemm g{(const pg8::bf16_t*)(p.ws + O_H), (const pg8::bf16_t*)(p.ws + O_W13) + (size_t)f * 5632 * 1024, 1024, 1024};
    pg8::StaticOrder S; S.init(M, 5632, gridDim.x, blockIdx.x);
    EpiFfnA E{(bf16*)(p.ws + O_BIG)};
    pg8::gemm_phase<EpiFfnA, pg8::StaticOrder, true, true>((pg8lds)lds, g, S, E);
}
#define PANEL_CNT(l, prod, pm) (4096 + ((l) * 3 + (prod)) * 80 + (pm))
DI unsigned panel_arrive_wait(unsigned* w, unsigned target, ldsp lds) {
    asm volatile("s_waitcnt vmcnt(0)" ::: "memory");
    __syncthreads();
    LAS unsigned* flag = (LAS unsigned*)lds;
    if (threadIdx.x == 0) {
        __builtin_amdgcn_fence(__ATOMIC_RELEASE, "agent");
        asm volatile("s_waitcnt vmcnt(0)" ::: "memory");
        const unsigned old = xb_add(w, 1u);
        unsigned sp = 0;
        while (xb_ld(w) < target) { __builtin_amdgcn_s_sleep(2); if (++sp > (1u << 24)) break; }
        __builtin_amdgcn_fence(__ATOMIC_ACQUIRE, "agent");
        asm volatile("s_waitcnt vmcnt(0)" ::: "memory");
        *flag = old;
    }
    __syncthreads();
    const unsigned r = *flag;
    __syncthreads();
    return r;
}
DI void norm_rows(const Params& p, int nl, int nwhich, bool fin, int r0, int nrows) {
    const int lane = threadIdx.x & 63, w = threadIdx.x >> 6;
    const int cond = r0 >= NL, per = nrows >> 3;
    f32x4 gm[4], sv[4];
#pragma unroll
    for (int j = 0; j < 4; ++j) {
        const int c = lane * 4 + 256 * j;
        if (fin) { gm[j] = *(const f32x4*)(p.in[I_FG] + c); sv[j] = (f32x4){0.f, 0.f, 0.f, 0.f}; }
        else {
            const float* g = p.in[I_NORMG] + (size_t)(nl * 3 + nwhich) * D;
            gm[j] = *(const f32x4*)(g + c) * (*(const f32x4*)(mods_ptr(p, cond, nl, 3 * nwhich + 1) + c) + 1.f);
            sv[j] = *(const f32x4*)(mods_ptr(p, cond, nl, 3 * nwhich) + c);
        }
    }
    const int wbeg = r0 + w * per, wend = wbeg + per;
#pragma unroll 1
    for (int rb = wbeg; rb < wend; rb += 4) {
        const int n = min(4, wend - rb);
        f32x4 x[4][4];
#pragma unroll
        for (int q = 0; q < 4; ++q)
#pragma unroll
            for (int j = 0; j < 4; ++j) x[q][j] = *(const f32x4*)((const float*)(p.ws + O_X) + (size_t)(rb + (q < n ? q : 0)) * D + lane * 4 + 256 * j);
#pragma unroll
        for (int q = 0; q < 4; ++q) {
            if (q < n) {
                float ss = 0.f;
#pragma unroll
                for (int j = 0; j < 4; ++j) ss += x[q][j][0] * x[q][j][0] + x[q][j][1] * x[q][j][1] + x[q][j][2] * x[q][j][2] + x[q][j][3] * x[q][j][3];
                ss = wave_sum(ss);
                const float rstd = __builtin_amdgcn_rsqf(ss * (1.f / 1024.f) + 1e-6f);
#pragma unroll
                for (int j = 0; j < 4; ++j) {
                    const int c = lane * 4 + 256 * j;
                    const f32x4 o = x[q][j] * rstd * gm[j] + sv[j];
                    if (fin) *(f32x4*)(p.out + (size_t)(rb + q) * D + c) = o;
                    else { u32x2 pk; pk.x = pk2(o[0], o[1]); pk.y = pk2(o[2], o[3]); *(u32x2*)((bf16*)(p.ws + O_H) + (size_t)(rb + q) * D + c) = pk; }
                }
            }
        }
    }
}
DI void big_resid(const Params& p, const bf16* A, const bf16* Bt, int K, int l, int gate_j, float scale, bool resid_in, bool ctx, int prod, int nl, int nwhich, bool fin, ldsp lds) {
    float* X = (float*)(p.ws + O_X);
    unsigned* cw = (unsigned*)(p.ws + O_BAR);
    if (ctx) {
        const int j = blockIdx.x, nsplit = K / 256;
        OneUnit S{64, j & 3, j < 4 * nsplit};
        pg8::Gemm g{(const pg8::bf16_t*)A + (j >> 2) * 256, (const pg8::bf16_t*)Bt + (j >> 2) * 256, 256, K};
        EpiResid E{X, X, mods_ptr(p, 1, l, gate_j), scale, true};
        pg8::gemm_phase<EpiResid, OneUnit, false, true>((pg8lds)lds, g, S, E);
        if (j < 4 * nsplit) {
            const unsigned k = panel_arrive_wait(cw + PANEL_CNT(l, prod, 64), 4u * nsplit, lds);
            if (k < 16u) norm_rows(p, nl, nwhich, false, NL + (int)k * 16, 16);
        }
    }
    pg8::Gemm g{(const pg8::bf16_t*)A, (const pg8::bf16_t*)Bt, K, K};
    pg8::StaticOrder S; S.init(NL, 1024, gridDim.x, blockIdx.x);
    EpiResid E{X, resid_in ? p.in[I_X] : X, mods_ptr(p, 0, l, gate_j), scale, false};
    pg8::gemm_phase<EpiResid, pg8::StaticOrder, false, true>((pg8lds)lds, g, S, E);
    pg8::Unit u;
    for (int i = 0; S.next(i, u); ++i) {
        const unsigned k = panel_arrive_wait(cw + PANEL_CNT(l, prod, u.pm), 4u, lds);
        norm_rows(p, nl, nwhich, fin, u.pm * 256 + (int)(k & 3u) * 64, 64);
    }
}
template <int MODE>
struct EpiMix {
    static constexpr bool PERM = true, AFTER_DRAIN = false;
    bf16* M; const bf16* G;
    DI void operator()(const f32x4 (&acc)[2][2][4][2], const pg8::Unit& u, int wr, int wc, int fr, int fq) const {
        asm volatile("" : "+v"(fr), "+v"(fq), "+s"(wr), "+s"(wc));
        const int row0 = u.pm * 256 + wr * 64 + fr;
#pragma unroll
        for (int bj = 0; bj < (MODE == 2 ? 1 : 2); ++bj) {
            const int c0 = (MODE == 2) ? (u.pn * 128 + wc * 32 + 8 * fq) : (u.pn * 256 + bj * 128 + wc * 32 + 8 * fq);
            const int gofs = (MODE == 0) ? 0 : (MODE == 1) ? 2048 : 1024;
            u32x4 gg[8], mm[8];
#pragma unroll
            for (int q = 0; q < 8; ++q) {
                const int row = row0 + (q >> 2) * 128 + (q & 3) * 16;
                gg[q] = AT(const u32x4, G, (row * 3072 + gofs + c0) >> 3);
                if (MODE != 0) mm[q] = AT(const u32x4, M, (row * D + c0) >> 3);
            }
#pragma unroll
            for (int q = 0; q < 8; ++q) {
                const int row = row0 + (q >> 2) * 128 + (q & 3) * 16, ai = q >> 2, m = q & 3;
                float v[8];
#pragma unroll
                for (int n = 0; n < 2; ++n)
#pragma unroll
                    for (int j = 0; j < 4; ++j) {
                        if (MODE == 2) v[n * 4 + j] = acc[ai][0][m][n][j] * sigmoidf_(acc[ai][1][m][n][j]);
                        else v[n * 4 + j] = acc[ai][bj][m][n][j];
                    }
                v[0] *= bflo(gg[q].x); v[1] *= bfhi(gg[q].x); v[2] *= bflo(gg[q].y); v[3] *= bfhi(gg[q].y); v[4] *= bflo(gg[q].z); v[5] *= bfhi(gg[q].z); v[6] *= bflo(gg[q].w); v[7] *= bfhi(gg[q].w);
                if (MODE != 0) { v[0] += bflo(mm[q].x); v[1] += bfhi(mm[q].x); v[2] += bflo(mm[q].y); v[3] += bfhi(mm[q].y); v[4] += bflo(mm[q].z); v[5] += bfhi(mm[q].z); v[6] += bflo(mm[q].w); v[7] += bfhi(mm[q].w); }
                u32x4 o; o.x = pk2(v[0], v[1]); o.y = pk2(v[2], v[3]); o.z = pk2(v[4], v[5]); o.w = pk2(v[6], v[7]);
                AT(u32x4, M, (row * D + c0) >> 3) = o;
            }
        }
    }
};
struct GluOrder {
    pg8::StaticOrder S;
    DI bool next(int i, pg8::Unit& u) const { pg8::Unit t; if (!S.next(i >> 1, t)) return false; u.pm = t.pm; u.pn = 2 * t.pn + (i & 1); return true; }
    DI void a_ready(const pg8::Unit&) const {}
    DI void done(const pg8::Unit&) const {}
};
DI void big_mix1(const Params& p, int M, ldsp lds) {
    bf16* Mx = (bf16*)(p.ws + O_H); const bf16* G = (const bf16*)(p.ws + O_BIG);
    pg8::StaticOrder S; S.init(M, 1024, gridDim.x, blockIdx.x);
    {   pg8::Gemm g{(const pg8::bf16_t*)(p.ws + O_YP), (const pg8::bf16_t*)(p.ws + O_WP), 256, 256};
        EpiMix<0> E{Mx, G};
        pg8::gemm_phase<EpiMix<0>, pg8::StaticOrder, false, true>((pg8lds)lds, g, S, E); }
    {   pg8::Gemm g{(const pg8::bf16_t*)(p.ws + O_Q), (const pg8::bf16_t*)(p.ws + O_WAO), 512, 512};
        EpiMix<1> E{Mx, G};
        pg8::gemm_phase<EpiMix<1>, pg8::StaticOrder, false, true>((pg8lds)lds, g, S, E); }
    {   pg8::Gemm g{(const pg8::bf16_t*)(p.ws + O_YS), (const pg8::bf16_t*)(p.ws + O_WGLU), 256, 256};
        GluOrder SG{S};
        EpiMix<2> E{Mx, G};
        pg8::gemm_phase<EpiMix<2>, GluOrder, false, true>((pg8lds)lds, g, SG, E); }
}
DI void big_inproj(const Params& p, int l, ldsp lds) {
    pg8::Gemm g{(const pg8::bf16_t*)(p.ws + O_H), (const pg8::bf16_t*)(p.ws + O_WIN), 1024, 1024};
    pg8::StaticOrder S; S.init(NT, INW, gridDim.x, blockIdx.x);
    EpiInproj E{p.ws, p.in[I_QG] + l * 64, p.in[I_KG] + l * 64};
    pg8::gemm_phase<EpiInproj, pg8::StaticOrder, true, true>((pg8lds)lds, g, S, E);
}

DI void norm_item(const Params& p, int l, int which, int it) {
    const int tid = threadIdx.x, lane = tid & 63, w = tid >> 6;
    const int row = it * 8 + w;
    const int cond = row >= NL;
    const bool from_in = (l == 0 && which == 0);
    const float* src = from_in ? (cond ? p.in[I_CTX] + (size_t)(row - NL) * D : p.in[I_X] + (size_t)row * D) : (const float*)(p.ws + O_X) + (size_t)row * D;
    f32x4 x[4]; float ss = 0.f;
#pragma unroll
    for (int j = 0; j < 4; ++j) { x[j] = *(const f32x4*)(src + lane * 4 + 256 * j); ss += x[j][0] * x[j][0] + x[j][1] * x[j][1] + x[j][2] * x[j][2] + x[j][3] * x[j][3]; }
    if (from_in && cond) {
        float* xr = (float*)(p.ws + O_X) + (size_t)row * D;
#pragma unroll
        for (int j = 0; j < 4; ++j) *(f32x4*)(xr + lane * 4 + 256 * j) = x[j];
    }
    ss = wave_sum(ss);
    const float rstd = rsqrtf(ss * (1.f / 1024.f) + 1e-6f);
    const float* g = p.in[I_NORMG] + (size_t)(l * 3 + which) * D;
    const float* sh = mods_ptr(p, cond, l, 3 * which), *sc = mods_ptr(p, cond, l, 3 * which + 1);
    bf16* H = (bf16*)(p.ws + O_H) + (size_t)row * D;
#pragma unroll
    for (int j = 0; j < 4; ++j) {
        const int c = lane * 4 + 256 * j;
        const f32x4 gv = *(const f32x4*)(g + c), sv = *(const f32x4*)(sh + c), cv = *(const f32x4*)(sc + c);
        float o[4];
#pragma unroll
        for (int e = 0; e < 4; ++e) o[e] = x[j][e] * rstd * gv[e] * (1.f + cv[e]) + sv[e];
        u32x2 pk; pk.x = pk2(o[0], o[1]); pk.y = pk2(o[2], o[3]);
        *(u32x2*)(H + c) = pk;
    }
}
DI void final_norm_item(const Params& p, int it) {
    const int tid = threadIdx.x, lane = tid & 63, w = tid >> 6;
    const int row = it * 8 + w;
    const float* src = (const float*)(p.ws + O_X) + (size_t)row * D;
    f32x4 x[4]; float ss = 0.f;
#pragma unroll
    for (int j = 0; j < 4; ++j) { x[j] = *(const f32x4*)(src + lane * 4 + 256 * j); ss += x[j][0] * x[j][0] + x[j][1] * x[j][1] + x[j][2] * x[j][2] + x[j][3] * x[j][3]; }
    ss = wave_sum(ss);
    const float rstd = rsqrtf(ss * (1.f / 1024.f) + 1e-6f);
    const float* g = p.in[I_FG];
#pragma unroll
    for (int j = 0; j < 4; ++j) {
        const int c = lane * 4 + 256 * j;
        const f32x4 gv = *(const f32x4*)(g + c);
        f32x4 o;
#pragma unroll
        for (int e = 0; e < 4; ++e) o[e] = x[j][e] * rstd * gv[e];
        *(f32x4*)(p.out + (size_t)row * D + c) = o;
    }
}
DI void s1_item(const Params& p, int it, ldsp lds) {
    TID_VARS
    const int g = it & 15, mt = it >> 4;
    f32x16 acc[4][2]; zero_acc<4, 2>(acc);
    gemm_acc<1, 4, 2>(acc, (const bf16*)(p.ws + O_S) + g * 16, 8192, mt * 256, (const bf16*)(p.ws + O_W1S) + (unsigned)g * 256 * 512, 512, 0, 512, lds);
    float* E = (float*)(p.ws + O_E);
#pragma unroll
    for (int rb = 0; rb < 4; ++rb)
#pragma unroll
        for (int cb = 0; cb < 2; ++cb)
#pragma unroll
            for (int i = 0; i < 16; ++i) {
                const int c = mt * 256 + ACC_ROW(rb, i);
                if (c < NCH) AT(float, E, (c * 16 + g) * 256 + ACC_COL(cb)) = acc[rb][cb][i];
            }
}
DI void s2_item(const Params& p, int it) {
    const int sidx = it * 512 + threadIdx.x;
    const int g = sidx >> 7, dir = (sidx >> 6) & 1, pp = sidx & 63;
    const float2 aT = ((const float2*)(p.ws + O_PW))[(unsigned)((dir * 16 + g) * 64 + pp) * 33 + 32];
    const float* E = (const float*)(p.ws + O_E) + g * 256 + dir * 128 + pp;
    bf16* C = (bf16*)(p.ws + O_CARRY) + g * 256 + dir * 128 + pp;
    float cr = 0.f, ci = 0.f;
#pragma unroll 8
    for (int n = 0; n < NCH; ++n) {
        int c;
        if (dir == 0) c = (n < 8) ? 512 + n : n - 8;
        else c = 519 - n;
        const float er = E[(unsigned)c * 4096], ei = E[(unsigned)c * 4096 + 64];
        C[(unsigned)c * 4096] = f2bf(cr); C[(unsigned)c * 4096 + 64] = f2bf(ci);
        const float nr = aT.x * cr - aT.y * ci + er, ni = aT.x * ci + aT.y * cr + ei;
        cr = nr; ci = ni;
    }
}
DI float gelu_tanh(float x) { const float u = 0.7978845608028654f * (x + 0.044715f * x * x * x); return x * sigmoidf_(2.f * u); }
DI void s3_item(const Params& p, int it, ldsp lds) {
    TID_VARS
    const int g = it & 15, rest = it >> 4, nt = rest & 1, mt = rest >> 1;
    f32x16 acc[4][2]; zero_acc<4, 2>(acc);
    gemm_acc<1, 4, 2>(acc, (const bf16*)(p.ws + O_S) + g * 16, 8192, mt * 256, (const bf16*)(p.ws + O_TOEP) + (unsigned)g * 512 * 512, 512, nt * 256, 512, lds);
    gemm_acc<0, 4, 2>(acc, (const bf16*)(p.ws + O_CARRY) + g * 256, 4096, mt * 256, (const bf16*)(p.ws + O_W3S) + (unsigned)g * 512 * 256, 256, nt * 256, 256, lds);
    bf16* Ys = (bf16*)(p.ws + O_YS);
#pragma unroll
    for (int rb = 0; rb < 4; ++rb)
#pragma unroll
        for (int cb = 0; cb < 2; ++cb)
#pragma unroll
            for (int i = 0; i < 16; ++i) {
                const int c = mt * 256 + ACC_ROW(rb, i);
                const int n = nt * 256 + ACC_COL(cb), j = n >> 4, hh = n & 15;
                if (c < NCH) AT(bf16, Ys, (c * 32 + j) * 256 + g * 16 + hh) = f2bf(gelu_tanh(acc[rb][cb][i]));
            }
}
DI void pool_item(const Params& p, int it) {
    const int tid = threadIdx.x, cv = tid & 31, rg = tid >> 5;
    const bf16* A = (const bf16*)(p.ws + O_A);
    bf16* Y = (bf16*)(p.ws + O_YP);
    const int half = 1 << (cv >> 3);
#pragma unroll 1
    for (int i = 0; i < 4; ++i) {
        const int row = it * 64 + rg + 16 * i;
        const int base = row >= NL ? NL : 0, n = row >= NL ? NC : NL, t = row - base;
        const int lo = max(t - half, 0), hi = min(t + half, n);
        float s[8];
#pragma unroll
        for (int e = 0; e < 8; ++e) s[e] = 0.f;
        for (int u = lo; u < hi; ++u) {
            const u32x4 v = *(const u32x4*)(A + (unsigned)(base + u) * 256 + cv * 8);
            s[0] += bflo(v.x); s[1] += bfhi(v.x); s[2] += bflo(v.y); s[3] += bfhi(v.y); s[4] += bflo(v.z); s[5] += bfhi(v.z); s[6] += bflo(v.w); s[7] += bfhi(v.w);
        }
        const u32x4 v = *(const u32x4*)(A + (unsigned)row * 256 + cv * 8);
        const float inv = 1.f / (float)(hi - lo);
        u32x4 o;
        o.x = pk2(s[0] * inv - bflo(v.x), s[1] * inv - bfhi(v.x)); o.y = pk2(s[2] * inv - bflo(v.y), s[3] * inv - bfhi(v.y));
        o.z = pk2(s[4] * inv - bflo(v.z), s[5] * inv - bfhi(v.z)); o.w = pk2(s[6] * inv - bflo(v.w), s[7] * inv - bfhi(v.w));
        *(u32x4*)(Y + (unsigned)row * 256 + cv * 8) = o;
    }
}
DI int sig_perm(int r) { return (r & 0x13) | ((r & 4) << 1) | ((r & 8) >> 1); }
template <bool FIXED>
DI void attn_item(const Params& p, int qb, int head, float bound, ldsp lds) {
    TID_VARS
    const int kvh = head >> 2;
    bf16* Q = (bf16*)(p.ws + O_Q);
    const bf16* Kp = (const bf16*)(p.ws + O_K) + kvh * 64;
    const bf16* Vp = (const bf16*)(p.ws + O_VT) + (unsigned)kvh * 64 * NT;
    const int q0 = qb * 256 + w * 32;
    bf16x8 qf[4];
#pragma unroll
    for (int s = 0; s < 4; ++s) qf[s] = *(const bf16x8*)(Q + (unsigned)(q0 + r) * 512 + head * 64 + 16 * s + 8 * h);
    const int key0 = qb < 64 ? 0 : NL, ntile = qb < 64 ? NT / 64 : NC / 64;
    const int isv = tid >> 8, lrow = (tid & 255) >> 3, lv = tid & 7;
    const bf16* gp = isv ? (Vp + (unsigned)lrow * NT + key0 + lv * 8) : (Kp + (unsigned)(key0 + lrow) * 128 + lv * 8);
    const unsigned gstep = isv ? 64u : 64u * 128u, grow = isv ? 32u * NT : 32u * 128u;
    u32x4 rgA[2], rgB[2];
#pragma unroll
    for (int i = 0; i < 2; ++i) rgB[i] = *(const u32x4*)(gp + i * grow);
    ldsp wr = lds + isv * 9216 + lrow * LROW + lv * 16;
#pragma unroll
    for (int i = 0; i < 2; ++i) *(LAS u32x4*)(wr + i * 32 * LROW) = rgB[i];
    gp += gstep;
#pragma unroll
    for (int i = 0; i < 2; ++i) rgA[i] = *(const u32x4*)(gp + i * grow);
    __syncthreads();
    f32x16 o0, o1;
#pragma unroll
    for (int i = 0; i < 16; ++i) { o0[i] = 0.f; o1[i] = 0.f; }
    float m = -1e30f, lsum = 0.f, lsa = 0.f, lsb = 0.f;
    f32x16 cinit;
#pragma unroll
    for (int i = 0; i < 16; ++i) cinit[i] = FIXED ? -bound * 1.4426950408889634f : 0.f;
    cldsp lk = lds + sig_perm(r) * LROW + h * 16;
    cldsp lvv = lds + 9216 + r * LROW + h * 16;
#define ATT_TILE(buf, RL, RW, t)                                                                                                     \
    {                                                                                                                                \
        if ((t) + 2 < ntile) {                                                                                                       \
            gp += gstep;                                                                                                             \
            _Pragma("unroll") for (int i = 0; i < 2; ++i) RL[i] = *(const u32x4*)(gp + i * grow);                                    \
        }                                                                                                                            \
        __builtin_amdgcn_sched_barrier(0);                                                                                           \
        cldsp pk = lk + (buf) * 18432; cldsp pv = lvv + (buf) * 18432;                                                               \
        f32x16 s0, s1;                                                                                                               \
        {                                                                                                                            \
            const bf16x8 k0 = *(const LAS bf16x8*)(pk), k1 = *(const LAS bf16x8*)(pk + 32 * LROW);                                   \
            s0 = MFMA(k0, qf[0], cinit); s1 = MFMA(k1, qf[0], cinit);                                                                \
        }                                                                                                                            \
        _Pragma("unroll") for (int s = 1; s < 4; ++s) {                                                                              \
            const bf16x8 k0 = *(const LAS bf16x8*)(pk + s * 32), k1 = *(const LAS bf16x8*)(pk + 32 * LROW + s * 32);                 \
            s0 = MFMA(k0, qf[s], s0); s1 = MFMA(k1, qf[s], s1);                                                                      \
        }                                                                                                                            \
        if (!FIXED) {                                                                                                                \
            float mx = s0[0];                                                                                                        \
            _Pragma("unroll") for (int i = 1; i < 16; ++i) mx = fmaxf(mx, s0[i]);                                                    \
            _Pragma("unroll") for (int i = 0; i < 16; ++i) mx = fmaxf(mx, s1[i]);                                                    \
            mx = fmaxf(mx, __shfl_xor(mx, 32));                                                                                      \
            const float mnew = fmaxf(m, mx);                                                                                         \
            const float alpha = __builtin_amdgcn_exp2f(m - mnew);                                                                    \
            m = mnew;                                                                                                                \
            lsa *= alpha; lsb *= alpha;                                                                                              \
            _Pragma("unroll") for (int i = 0; i < 16; ++i) { o0[i] *= alpha; o1[i] *= alpha; s0[i] -= mnew; s1[i] -= mnew; }         \
        }                                                                                                                            \
        _Pragma("unroll") for (int i = 0; i < 16; ++i) {                                                                             \
            s0[i] = __builtin_amdgcn_exp2f(s0[i]); s1[i] = __builtin_amdgcn_exp2f(s1[i]);                                            \
            lsa += s0[i]; lsb += s1[i];                                                                                              \
        }                                                                                                                            \
        _Pragma("unroll") for (int kb = 0; kb < 2; ++kb)                                                                             \
            _Pragma("unroll") for (int s = 0; s < 2; ++s) {                                                                          \
                u32x4 pp;                                                                                                            \
                if (kb == 0) { pp.x = pk2(s0[8 * s], s0[8 * s + 1]); pp.y = pk2(s0[8 * s + 2], s0[8 * s + 3]); pp.z = pk2(s0[8 * s + 4], s0[8 * s + 5]); pp.w = pk2(s0[8 * s + 6], s0[8 * s + 7]); } \
                else         { pp.x = pk2(s1[8 * s], s1[8 * s + 1]); pp.y = pk2(s1[8 * s + 2], s1[8 * s + 3]); pp.z = pk2(s1[8 * s + 4], s1[8 * s + 5]); pp.w = pk2(s1[8 * s + 6], s1[8 * s + 7]); } \
                const bf16x8 pf = __builtin_bit_cast(bf16x8, pp);                                                                    \
                const bf16x8 v0 = *(const LAS bf16x8*)(pv + (kb * 32 + 16 * s) * 2), v1 = *(const LAS bf16x8*)(pv + 32 * LROW + (kb * 32 + 16 * s) * 2); \
                o0 = MFMA(v0, pf, o0); o1 = MFMA(v1, pf, o1);                                                                        \
            }                                                                                                                        \
        __builtin_amdgcn_sched_barrier(0);                                                                                           \
        if ((t) + 1 < ntile) {                                                                                                       \
            ldsp w2 = wr + ((buf) ^ 1) * 18432;                                                                                      \
            _Pragma("unroll") for (int i = 0; i < 2; ++i) *(LAS u32x4*)(w2 + i * 32 * LROW) = RW[i];                                 \
        }                                                                                                                            \
        __syncthreads();                                                                                                             \
    }
    for (int t = 0; t < ntile; t += 2) {
        ATT_TILE(0, rgB, rgA, t)
        ATT_TILE(1, rgA, rgB, t + 1)
    }
#undef ATT_TILE
    lsum = lsa + lsb;
    lsum += __shfl_xor(lsum, 32);
    const float inv = 1.f / lsum;
    bf16* orow = Q + (unsigned)(q0 + r) * 512 + head * 64;
#pragma unroll
    for (int q = 0; q < 4; ++q) {
        u32x2 a, b;
        a.x = pk2(o0[4 * q] * inv, o0[4 * q + 1] * inv); a.y = pk2(o0[4 * q + 2] * inv, o0[4 * q + 3] * inv);
        b.x = pk2(o1[4 * q] * inv, o1[4 * q + 1] * inv); b.y = pk2(o1[4 * q + 2] * inv, o1[4 * q + 3] * inv);
        *(u32x2*)(orow + 8 * q + 4 * h) = a;
        *(u32x2*)(orow + 32 + 8 * q + 4 * h) = b;
    }
}
DI float attn_bound(const Params& p, int l) {
    const int lane = threadIdx.x & 63;
    float a = fabsf(p.in[I_QG][l * 64 + lane]), b = fabsf(p.in[I_KG][l * 64 + lane]);
#pragma unroll
    for (int o = 32; o >= 1; o >>= 1) { a = fmaxf(a, __shfl_xor(a, o)); b = fmaxf(b, __shfl_xor(b, o)); }
    return 8.f * 1.02f * a * b;
}
DI void attn_dispatch(const Params& p, int l, int qb, int head, ldsp lds) {
    const float bound = attn_bound(p, l);
    if (bound < 40.f) attn_item<true>(p, qb, head, bound, lds);
    else attn_item<false>(p, qb, head, 0.f, lds);
}
DI void conv_tile(const float* src, bf16* dst, int K, int N, int permmode, int tile, ldsp lds) {
    const int tid = threadIdx.x & 255, half = threadIdx.x >> 8;
    tile = tile * 2 + half;
    const int ntn = N / 64, tk = tile / ntn, tn = tile % ntn;
    LAS float* L = (LAS float*)lds + half * (64 * 65);
#pragma unroll
    for (int i = 0; i < 4; ++i) {
        const int kk = (tid >> 4) + 16 * i, c4 = (tid & 15) * 4;
        const f32x4 v = *(const f32x4*)(src + (size_t)(tk * 64 + kk) * N + tn * 64 + c4);
        L[kk * 65 + c4] = v[0]; L[kk * 65 + c4 + 1] = v[1]; L[kk * 65 + c4 + 2] = v[2]; L[kk * 65 + c4 + 3] = v[3];
    }
    __syncthreads();
    const int n = tid >> 2, ks = (tid & 3) * 16;
    int nn = tn * 64 + n;
    if (permmode == 1) { const int hN = N >> 1, b = nn >= hN, hc = b ? nn - hN : nn; nn = 256 * (hc >> 7) + 128 * b + (hc & 127); }
    else if (permmode == 2 && nn >= 512 && nn < 1280) {
        if (nn < 1024) { const int hd = (nn - 512) >> 6, d = nn & 63; nn = (2 + (hd >> 2)) * 256 + 128 * (d >> 5) + 32 * (hd & 3) + (d & 31); }
        else { const int hd = (nn - 1024) >> 6, d = nn & 63; nn = 1024 + 128 * (d >> 5) + 32 * hd + (d & 31); }
    }
    u32x4 o0, o1;
    o0.x = pk2(L[(ks + 0) * 65 + n], L[(ks + 1) * 65 + n]); o0.y = pk2(L[(ks + 2) * 65 + n], L[(ks + 3) * 65 + n]);
    o0.z = pk2(L[(ks + 4) * 65 + n], L[(ks + 5) * 65 + n]); o0.w = pk2(L[(ks + 6) * 65 + n], L[(ks + 7) * 65 + n]);
    o1.x = pk2(L[(ks + 8) * 65 + n], L[(ks + 9) * 65 + n]); o1.y = pk2(L[(ks + 10) * 65 + n], L[(ks + 11) * 65 + n]);
    o1.z = pk2(L[(ks + 12) * 65 + n], L[(ks + 13) * 65 + n]); o1.w = pk2(L[(ks + 14) * 65 + n], L[(ks + 15) * 65 + n]);
    bf16* d = dst + (size_t)nn * K + tk * 64 + ks;
    *(u32x4*)d = o0; *(u32x4*)(d + 8) = o1;
    __syncthreads();
}
constexpr int CV0 = 704, CV1 = 1408, CV2 = 1760, CV3 = 2112, CV4 = 2656, CV5 = 2720, CV6 = 2784, CV_TOTAL = 2912;
DI void conv_item(const Params& p, int l, int it, ldsp lds) {
    if (it < CV0) conv_tile(p.in[I_W13] + (size_t)(l * 2 + 0) * 1024 * 5632, (bf16*)(p.ws + O_W13), 1024, 5632, 1, it, lds);
    else if (it < CV1) conv_tile(p.in[I_W13] + (size_t)(l * 2 + 1) * 1024 * 5632, (bf16*)(p.ws + O_W13) + (size_t)5632 * 1024, 1024, 5632, 1, it - CV0, lds);
    else if (it < CV2) conv_tile(p.in[I_W2] + (size_t)(l * 2 + 0) * 2816 * 1024, (bf16*)(p.ws + O_W2), 2816, 1024, 0, it - CV1, lds);
    else if (it < CV3) conv_tile(p.in[I_W2] + (size_t)(l * 2 + 1) * 2816 * 1024, (bf16*)(p.ws + O_W2) + (size_t)1024 * 2816, 2816, 1024, 0, it - CV2, lds);
    else if (it < CV4) conv_tile(p.in[I_WIN] + (size_t)l * 1024 * INW, (bf16*)(p.ws + O_WIN), 1024, INW, 2, it - CV3, lds);
    else if (it < CV5) conv_tile(p.in[I_GLU] + (size_t)l * 256 * 2048, (bf16*)(p.ws + O_WGLU), 256, 2048, 1, it - CV4, lds);
    else if (it < CV6) conv_tile(p.in[I_AO] + (size_t)l * 512 * 1024, (bf16*)(p.ws + O_WAO), 512, 1024, 0, it - CV5, lds);
    else conv_tile(p.in[I_WO] + (size_t)l * 1024 * 1024, (bf16*)(p.ws + O_WOUT), 1024, 1024, 0, it - CV6, lds);
}
DI void mod_item(const Params& p, int it, ldsp lds) {
    const int tid = threadIdx.x, lane = tid & 63, w = tid >> 6;
    const int c0 = it * 256 + lane * 4, l = c0 / 9216, col = c0 % 9216;
    const float* W = p.in[I_MODW] + (size_t)l * 1024 * 9216 + col;
    f32x4 a0 = {0.f, 0.f, 0.f, 0.f}, a1 = {0.f, 0.f, 0.f, 0.f};
#pragma unroll 8
    for (int k = w * 128; k < w * 128 + 128; ++k) {
        const f32x4 wv = *(const f32x4*)(W + (size_t)k * 9216);
        const float c = p.in[I_C][k], cc = p.in[I_CCTX][k];
        const float s0 = c * sigmoidf_(c), s1 = cc * sigmoidf_(cc);
        a0 += wv * s0; a1 += wv * s1;
    }
    LAS f32x4* L = (LAS f32x4*)lds;
    L[(w * 64 + lane) * 2] = a0; L[(w * 64 + lane) * 2 + 1] = a1;
    __syncthreads();
    if (w == 0) {
        f32x4 b = *(const f32x4*)(p.in[I_MODB] + (size_t)l * 9216 + col);
        f32x4 r0 = b, r1 = b;
#pragma unroll
        for (int q = 0; q < 8; ++q) { r0 += L[(q * 64 + lane) * 2]; r1 += L[(q * 64 + lane) * 2 + 1]; }
        float* M = (float*)(p.ws + O_MODS);
        *(f32x4*)(M + (size_t)(0 * 2 + l) * 9216 + col) = r0;
        *(f32x4*)(M + (size_t)(1 * 2 + l) * 9216 + col) = r1;
    }
    __syncthreads();
}
DI void pw_item(const Params& p, int l, int it) {
    const int idx = it * 512 + threadIdx.x;
    if (idx >= 2048 * 33) return;
    const int st = idx / 33, e = idx % 33;
    const int dg = st >> 6;
    const double are = p.in[I_ARE][(size_t)l * 2048 + st], aim = p.in[I_AIM][(size_t)l * 2048 + st];
    const double dt = dexp((double)p.in[I_LOGDT][l * 32 + dg]);
    const double mag = dexp(are * dt * e);
    double s, c; dsincos(aim * dt * e, s, c);
    ((float2*)(p.ws + O_PW))[idx] = make_float2((float)(mag * c), (float)(mag * s));
    if (e == 1) {
        const double nr = mag * c - 1.0, ni = mag * s, den = are * are + aim * aim;
        ((float2*)(p.ws + O_CF))[st] = make_float2((float)((nr * are + ni * aim) / den), (float)((ni * are - nr * aim) / den));
    }
}
DI void wp_item(const Params& p, int l, int it) {
    const int k = it >> 1, n = (it & 1) * 512 + threadIdx.x, g = k >> 6, c = k & 63;
    const float* pw = p.in[I_POOLW] + (size_t)l * 4 * 64 * 64 + (size_t)(g * 64 + c) * 64;
    const float* ps = p.in[I_POOLS] + l * 256 + g * 64;
    const float* po = p.in[I_POOLO] + (size_t)l * 256 * 1024 + (size_t)(g * 64) * 1024 + n;
    float s = 0.f;
#pragma unroll 8
    for (int d = 0; d < 64; ++d) s += pw[d] * ps[d] * po[(size_t)d * 1024];
    ((bf16*)(p.ws + O_WP))[(size_t)n * 256 + k] = f2bf(s);
}
DI void rope_item(const Params& p, int it) {
    const int idx = it * 512 + threadIdx.x;
    const int pos = idx >> 4, i = idx & 15;
    const double inv = dexp(-(double)i * (9.210340371976184 / 16.0));
    double s, c; dsincos((double)pos * inv, s, c);
    ((float2*)(p.ws + O_ROPE))[idx] = make_float2((float)c, (float)s);
}
DI void ktab_item(const Params& p, int l, int it, ldsp lds) {
    const int tid = threadIdx.x & 255, half = threadIdx.x >> 8;
    const int lag = (it & 15) * 2 + half, dg = it >> 4;
    LAS f32x2* Wl = (LAS f32x2*)lds + half * 64;
    if (tid < 64) {
        const float2 z = ((const float2*)(p.ws + O_PW))[(size_t)(dg * 64 + tid) * 33 + lag], cf = ((const float2*)(p.ws + O_CF))[dg * 64 + tid];
        Wl[tid] = (f32x2){z.x * cf.x - z.y * cf.y, z.x * cf.y + z.y * cf.x};
    }
    __syncthreads();
    const int hp = tid >> 4, hh = tid & 15;
    const size_t pb = (size_t)(l * 32 + dg) * 1024;
    const float* cre = p.in[I_CRE] + pb + hp * 64, *cim = p.in[I_CIM] + pb + hp * 64;
    const float* bre = p.in[I_BRE] + pb + hh, *bim = p.in[I_BIM] + pb + hh;
    float s = 0.f;
#pragma unroll 8
    for (int q = 0; q < 64; ++q) {
        const f32x2 wv = Wl[q];
        const float br = bre[q * 16], bi = bim[q * 16];
        const float tr = wv.x * br - wv.y * bi, ti = wv.x * bi + wv.y * br;
        s += cre[q] * tr - cim[q] * ti;
    }
    ((float*)(p.ws + O_KTAB))[(size_t)(dg * 32 + lag) * 256 + tid] = s;
    __syncthreads();
}
DI void w1_item(const Params& p, int l, int it) {
    const int idx = it * 512 + threadIdx.x;
    const int k8 = idx & 63, n = (idx >> 6) & 255, g = idx >> 14;
    const int dir = n >> 7, ri = (n >> 6) & 1, pp = n & 63, j = k8 >> 1, h0 = (k8 & 1) * 8;
    const int e = dir ? j : 31 - j, st = (dir * 16 + g) * 64 + pp;
    const float2 z = ((const float2*)(p.ws + O_PW))[(size_t)st * 33 + e], cf = ((const float2*)(p.ws + O_CF))[st];
    const float wr = z.x * cf.x - z.y * cf.y, wi = z.x * cf.y + z.y * cf.x;
    const float* bre = p.in[I_BRE] + (size_t)(l * 32 + dir * 16 + g) * 1024 + pp * 16 + h0;
    const float* bim = p.in[I_BIM] + (size_t)(l * 32 + dir * 16 + g) * 1024 + pp * 16 + h0;
    float o[8];
#pragma unroll
    for (int q = 0; q < 8; ++q) o[q] = ri ? (wr * bim[q] + wi * bre[q]) : (wr * bre[q] - wi * bim[q]);
    u32x4 v; v.x = pk2(o[0], o[1]); v.y = pk2(o[2], o[3]); v.z = pk2(o[4], o[5]); v.w = pk2(o[6], o[7]);
    *(u32x4*)((bf16*)(p.ws + O_W1S) + ((size_t)g * 256 + n) * 512 + k8 * 8) = v;
}
DI void w3_item(const Params& p, int l, int it) {
    const int idx = it * 512 + threadIdx.x;
    const int k8 = idx & 31, n = (idx >> 5) & 511, g = idx >> 14;
    const int dir = k8 >> 4, ri = (k8 >> 3) & 1, p0 = (k8 & 7) * 8, j = n >> 4, hp = n & 15;
    const int e = dir ? 32 - j : j + 1;
    const float* cre = p.in[I_CRE] + (size_t)(l * 32 + dir * 16 + g) * 1024 + hp * 64 + p0;
    const float* cim = p.in[I_CIM] + (size_t)(l * 32 + dir * 16 + g) * 1024 + hp * 64 + p0;
    const float2* pw = (const float2*)(p.ws + O_PW) + (size_t)((dir * 16 + g) * 64 + p0) * 33 + e;
    float o[8];
#pragma unroll
    for (int q = 0; q < 8; ++q) { const float2 z = pw[q * 33]; o[q] = ri ? -(cre[q] * z.y + cim[q] * z.x) : (cre[q] * z.x - cim[q] * z.y); }
    u32x4 v; v.x = pk2(o[0], o[1]); v.y = pk2(o[2], o[3]); v.z = pk2(o[4], o[5]); v.w = pk2(o[6], o[7]);
    *(u32x4*)((bf16*)(p.ws + O_W3S) + ((size_t)g * 512 + n) * 256 + k8 * 8) = v;
}
DI void toep_item(const Params& p, int l, int it) {
    const int idx = it * 512 + threadIdx.x;
    const int k8 = idx & 63, n = (idx >> 6) & 511, g = idx >> 15;
    const int j2 = k8 >> 1, h0 = (k8 & 1) * 8, j = n >> 4, hp = n & 15;
    const float* KT = (const float*)(p.ws + O_KTAB);
    float o[8];
#pragma unroll
    for (int q = 0; q < 8; ++q) o[q] = 0.f;
    if (j2 <= j) { const float* kf = KT + ((size_t)(0 * 16 + g) * 32 + (j - j2)) * 256 + hp * 16 + h0;
#pragma unroll
        for (int q = 0; q < 8; ++q) o[q] += kf[q]; }
    if (j2 >= j) { const float* kb = KT + ((size_t)(1 * 16 + g) * 32 + (j2 - j)) * 256 + hp * 16 + h0;
#pragma unroll
        for (int q = 0; q < 8; ++q) o[q] += kb[q]; }
    if (j2 == j) {
        const float dd = p.in[I_SD][l * 256 + g * 16 + hp];
#pragma unroll
        for (int q = 0; q < 8; ++q) if (h0 + q == hp) o[q] += dd;
    }
    u32x4 v; v.x = pk2(o[0], o[1]); v.y = pk2(o[2], o[3]); v.z = pk2(o[4], o[5]); v.w = pk2(o[6], o[7]);
    *(u32x4*)((bf16*)(p.ws + O_TOEP) + ((size_t)g * 512 + n) * 512 + k8 * 8) = v;
}

constexpr int PH_PER_LAYER = 14, N_PHASES = 2 * PH_PER_LAYER + 1;
#define SUBLOOP(n, call) { for (int it = ((b - off) % G + G) % G; it < (n); it += G) { call; } off = (off + (n)) % G; }
DI void run_phase(const Params& p, const int ph, ldsp lds) {
    const int G = gridDim.x, b = blockIdx.x;
    if (ph == 2 * PH_PER_LAYER) { for (int it = b; it < NL / 8; it += G) final_norm_item(p, it); return; }
    const int l = ph / PH_PER_LAYER, s = ph % PH_PER_LAYER;
    const int mtiles = (l == 1) ? 64 : 65;
    const bf16* HID = (const bf16*)(p.ws + O_BIG);
    const bf16* W2 = (const bf16*)(p.ws + O_W2);
    int off = 0;
#ifdef ONLY_S
    if (s != ONLY_S) return;
#endif
    switch (s) {
    case 0: {
        unsigned* cm = (unsigned*)(p.ws + O_BAR) + XB_CNT(6);
        SUBLOOP(((l == 0) ? 72 : 0), (mod_item(p, it, lds), signal_count(cm)))
        SUBLOOP(132, pw_item(p, l, it))
        SUBLOOP(512, wp_item(p, l, it))
        SUBLOOP(((l == 0) ? 8 : 0), rope_item(p, it))
        SUBLOOP(CV_TOTAL, conv_item(p, l, it, lds))
        if (l == 0) { wait_count(cm, 72u); SUBLOOP(NT / 8, norm_item(p, l, 0, it)) }
    } break;
    case 1: break;
    case 2: {
        big_ffn_a(p, 0, NT, lds);
        const int busy = 65 * 22 - 5 * G;
        if (G == 256 && b >= busy) for (int it = b - busy; it < 512; it += G - busy) ktab_item(p, l, it, lds);
        else if (G != 256) { SUBLOOP(512, ktab_item(p, l, it, lds)) }
    } break;
    case 3: big_resid(p, HID, W2, DFF, l, 2, 0.5f, l == 0, true, 0, l, 1, false, lds); break;
    case 4: break;
    case 5: {
        big_inproj(p, l, lds);
        const int busy = 65 * 17 - 4 * G;
        if (G == 256 && b >= busy) {
            const int nb = G - busy;
            for (int it = b - busy; it < 2048; it += nb) { if (it < 512) w1_item(p, l, it); else if (it < 1024) w3_item(p, l, it - 512); else toep_item(p, l, it - 1024); }
        } else if (G != 256) { SUBLOOP(512, w1_item(p, l, it)) SUBLOOP(512, w3_item(p, l, it)) SUBLOOP(1024, toep_item(p, l, it)) }
    } break;
    case 6: {
        unsigned* cw = (unsigned*)(p.ws + O_BAR);
        unsigned* c1 = cw + XB_CNT(2 * l), *c2 = cw + XB_CNT(2 * l + 1);
        if (b < 48) { s1_item(p, b, lds); signal_count(c1); }
        else if (b < 52) { wait_count(c1, 48u); s2_item(p, b - 48); signal_count(c2); }
        off = 52;
        SUBLOOP(mtiles * 4, pool_item(p, it))
        SUBLOOP(((l == 0) ? 8 : 0), attn_dispatch(p, l, 64, it, lds))
        SUBLOOP(512, attn_dispatch(p, l, it >> 3, it & 7, lds))
        wait_count(c2, 4u);
        for (int it = G - 1 - b; it < 96; it += G) s3_item(p, it, lds);
    } break;
    case 7: break;
    case 8: break;
    case 9: big_mix1(p, mtiles * 256, lds); break;
    case 10: big_resid(p, (const bf16*)(p.ws + O_H), (const bf16*)(p.ws + O_WOUT), D, l, 5, 1.0f, false, l == 0, 1, l, 2, false, lds); break;
    case 11: break;
    case 12: big_ffn_a(p, 1, mtiles * 256, lds); break;
    case 13: big_resid(p, HID, W2 + (size_t)1024 * DFF, DFF, l, 8, 0.5f, false, l == 0, 2, l + 1, 0, l == 1, lds); break;
    }
}

__global__ void __launch_bounds__(512, 2) hybrid_fwd(Params p, int ph_lo, int ph_hi) {
    __shared__ __attribute__((aligned(16))) char lds_raw[LDS_BYTES];
    ldsp lds = (ldsp)lds_raw;
    __shared__ uint4 xb_words;
    if (p.ws == nullptr) cg::this_grid().sync();
    XcdBarrier bar;
    const bool multi = (ph_hi - ph_lo) > 1;
    if (multi) {
        if (threadIdx.x == 0) xb_words = make_uint4(0u, 0u, 0u, 0u);
        __syncthreads();
        bar = xcd_barrier_post((unsigned*)(p.ws + O_BAR), (volatile LAS unsigned*)&xb_words);
    }
#define PH(k) if (ph_lo <= (k) && (k) < ph_hi) { if ((k) > ph_lo) xcd_barrier(bar); run_phase(p, (k), lds); }
    PH(0) PH(2) PH(3) PH(5) PH(6) PH(9) PH(10) PH(12) PH(13)
    PH(14) PH(16) PH(17) PH(19) PH(20) PH(23) PH(24) PH(26) PH(27)
}

extern "C" void kernel_launch(void* const* d_in, const int* in_sizes, int n_in, void* d_out, int out_size, void* d_ws, size_t ws_size, hipStream_t stream) {
    (void)in_sizes; (void)n_in; (void)out_size;
    if (ws_size < O_END) { fprintf(stderr, "workspace too small: %zu < %zu\n", ws_size, (size_t)O_END); return; }
    static int grid_blocks = 0;
    if (!grid_blocks) {
        int dev = 0, cus = 0, per_cu = 0;
        (void)hipGetDevice(&dev);
        (void)hipDeviceGetAttribute(&cus, hipDeviceAttributeMultiprocessorCount, dev);
        (void)hipOccupancyMaxActiveBlocksPerMultiprocessor(&per_cu, hybrid_fwd, 512, 0);
        if (per_cu > 1) per_cu = 1;
        if (per_cu < 1) per_cu = 1;
        grid_blocks = cus * per_cu;
    }
    Params p{};
    for (int i = 0; i < 27; ++i) p.in[i] = (const float*)d_in[i];
    p.out = (float*)d_out; p.ws = (char*)d_ws;
#if MK_ONE_LAUNCH
    (void)hipMemsetAsync(d_ws, 0, 32768, stream);
    int lo = 0, hi = N_PHASES;
    void* args[] = {&p, &lo, &hi};
    hipError_t e = hipLaunchCooperativeKernel((void*)hybrid_fwd, dim3(grid_blocks), dim3(512), args, 0, stream);
    if (e != hipSuccess) fprintf(stderr, "cooperative launch failed: %s (grid %d)\n", hipGetErrorString(e), grid_blocks);
#else
    for (int ph = 0; ph < N_PHASES; ++ph) hipLaunchKernelGGL(hybrid_fwd, dim3(grid_blocks), dim3(512), 0, stream, p, ph, ph + 1);
#endif
}
```

```cpp
#include <hip/hip_runtime.h>
#include <hip/hip_cooperative_groups.h>
#include <cstdio>
#include <cstdint>
namespace cg = cooperative_groups;

#define DI __device__ __forceinline__
#define LAS __attribute__((address_space(3)))
typedef __attribute__((address_space(3))) char* ldsp;
typedef const __attribute__((address_space(3))) char* cldsp;
typedef unsigned short bf16;
typedef short bf16x8 __attribute__((ext_vector_type(8)));
typedef float f32x16 __attribute__((ext_vector_type(16)));
typedef float f32x4 __attribute__((ext_vector_type(4)));
typedef float f32x2 __attribute__((ext_vector_type(2)));
typedef unsigned u32x4 __attribute__((ext_vector_type(4)));
typedef unsigned u32x2 __attribute__((ext_vector_type(2)));
typedef __bf16 hbf2 __attribute__((ext_vector_type(2)));

#ifndef MK_ONE_LAUNCH
#define MK_ONE_LAUNCH 1
#endif

constexpr int D = 1024, NL = 16384, NC = 256, NT = NL + NC, DFF = 2816, INW = 4352;
constexpr int NCH = NT / 32;

enum { I_X = 0, I_C, I_CTX, I_CCTX, I_MODW, I_MODB, I_NORMG, I_W13, I_W2, I_WIN, I_POOLW, I_POOLS, I_POOLO, I_ARE, I_AIM, I_LOGDT,
       I_BRE, I_BIM, I_CRE, I_CIM, I_SD, I_GLU, I_QG, I_KG, I_AO, I_WO, I_FG };

constexpr size_t al(size_t x) { return (x + 255) & ~(size_t)255; }
constexpr size_t O_BAR = 0;
constexpr size_t O_X = 32768;
constexpr size_t O_H = O_X + al((size_t)NT * D * 4);
constexpr size_t O_BIG = O_H + al((size_t)NT * D * 2);
constexpr size_t O_Q = O_BIG + al((size_t)NT * 3072 * 2);
constexpr size_t O_K = O_Q + al((size_t)NT * 512 * 2);
constexpr size_t O_VT = O_K + al((size_t)NT * 128 * 2);
constexpr size_t O_A = O_VT + al((size_t)NT * 128 * 2);
constexpr size_t O_S = O_A + al((size_t)NT * 256 * 2);
constexpr size_t O_YP = O_S + al((size_t)NT * 256 * 2);
constexpr size_t O_YS = O_YP + al((size_t)NT * 256 * 2);
constexpr size_t O_CARRY = O_YS + al((size_t)NT * 256 * 2);
constexpr size_t O_E = O_CARRY + al((size_t)NCH * 16 * 256 * 2);
constexpr size_t O_W13 = O_E + al((size_t)NCH * 16 * 256 * 4);
constexpr size_t O_W2 = O_W13 + al((size_t)2 * 5632 * 1024 * 2);
constexpr size_t O_WIN = O_W2 + al((size_t)2 * 1024 * 2816 * 2);
constexpr size_t O_WGLU = O_WIN + al((size_t)INW * 1024 * 2);
constexpr size_t O_WAO = O_WGLU + al((size_t)2048 * 256 * 2);
constexpr size_t O_WOUT = O_WAO + al((size_t)1024 * 512 * 2);
constexpr size_t O_WP = O_WOUT + al((size_t)1024 * 1024 * 2);
constexpr size_t O_TOEP = O_WP + al((size_t)1024 * 256 * 2);
constexpr size_t O_W1S = O_TOEP + al((size_t)16 * 512 * 512 * 2);
constexpr size_t O_W3S = O_W1S + al((size_t)16 * 256 * 512 * 2);
constexpr size_t O_KTAB = O_W3S + al((size_t)16 * 512 * 256 * 2);
constexpr size_t O_PW = O_KTAB + al((size_t)2 * 16 * 32 * 256 * 4);
constexpr size_t O_CF = O_PW + al((size_t)2048 * 33 * 8);
constexpr size_t O_MODS = O_CF + al((size_t)2048 * 8);
constexpr size_t O_ROPE = O_MODS + al((size_t)2 * 2 * 9216 * 4);
constexpr size_t O_END = O_ROPE + al((size_t)256 * 16 * 8);

struct Params { const float* in[27]; float* out; char* ws; };

DI unsigned pk2(float a, float b) { f32x2 v = {a, b}; return __builtin_bit_cast(unsigned, __builtin_convertvector(v, hbf2)); }
DI bf16 f2bf(float a) { return (bf16)(pk2(a, 0.f) & 0xffffu); }
DI float bf2f(bf16 b) { return __uint_as_float(((unsigned)b) << 16); }
DI float bflo(unsigned u) { return __uint_as_float(u << 16); }
DI float bfhi(unsigned u) { return __uint_as_float(u & 0xffff0000u); }
DI float sigmoidf_(float x) { return __builtin_amdgcn_rcpf(1.f + __builtin_amdgcn_exp2f(-1.4426950408889634f * x)); }
DI float wave_sum(float v) {
#pragma unroll
    for (int o = 32; o >= 1; o >>= 1) v += __shfl_xor(v, o);
    return v;
}
#define AT(T, base, idx) (*(T*)((char*)(base) + (unsigned)((unsigned)(idx) * (unsigned)sizeof(T))))
#define MFMA(a, b, c) __builtin_amdgcn_mfma_f32_32x32x16_bf16((a), (b), (c), 0, 0, 0)

DI double dexp(double x) {
    const double n = __builtin_rint(x * 1.4426950408889634);
    const double r = x - n * 0.6931471805599453;
    double t = 1.0;
#pragma unroll
    for (int k = 16; k >= 1; --k) t = 1.0 + t * r * (1.0 / (double)k);
    const long long e = (long long)n + 1023;
    return t * __longlong_as_double(e << 52);
}
DI void dsincos(double th, double& s, double& c) {
    const double k = __builtin_rint(th * 0.15915494309189535);
    const double x = th - k * 6.283185307179586 - k * 2.4492935982947064e-16;
    const double x2 = x * x;
    double cs = 1.0, sn = 1.0;
#pragma unroll
    for (int j = 17; j >= 1; --j) {
        cs = 1.0 - cs * x2 * (1.0 / (double)((2 * j - 1) * (2 * j)));
        sn = 1.0 - sn * x2 * (1.0 / (double)((2 * j) * (2 * j + 1)));
    }
    c = cs; s = sn * x;
}

#define XB_TMO      128
#define XB_XCNT(j)  (256  + 64 * (j))
#define XB_XSUB(j)  (1280 + 64 * (j))
#define XB_XGEN(j)  (2304 + 64 * (j))
#define XB_TOP      3328
#define XB_TOPGEN   3392
#define XCD_BAR_WORDS 3456
#define XB_SPIN_CAP (1u << 22)
DI unsigned xb_ld(unsigned* p)              { return __hip_atomic_load(p, __ATOMIC_RELAXED, __HIP_MEMORY_SCOPE_AGENT); }
DI unsigned xb_add(unsigned* p, unsigned v) { return __hip_atomic_fetch_add(p, v, __ATOMIC_RELAXED, __HIP_MEMORY_SCOPE_AGENT); }
DI unsigned xb_xcc_id() { return (unsigned)__builtin_amdgcn_s_getreg((3 << 11) | 20) & 0xFu; }
#define XB_SPIN(cond, bar) do { unsigned _sp = 0; while (cond) { __builtin_amdgcn_s_sleep(1); \
    if ((++_sp & 255u) == 0u) { if (xb_ld(&(bar)[XB_TMO])) break; if (_sp > XB_SPIN_CAP) { atomicAdd(&(bar)[XB_TMO], 1u); break; } } } } while (0)
struct XcdBarrier { unsigned* bar; unsigned x; volatile LAS unsigned* st; };
DI XcdBarrier xcd_barrier_post(unsigned* bar, volatile LAS unsigned* st) {
    XcdBarrier b; b.bar = bar; b.x = xb_xcc_id(); b.st = st;
    if (threadIdx.x == 0) (void)xb_add(&bar[XB_XCNT(b.x)], 1u);
    return b;
}
DI void xcd_barrier_complete(unsigned* bar, unsigned x, unsigned& nloc, unsigned& nx) {
    const unsigned G = gridDim.x * gridDim.y * gridDim.z;
    unsigned sum, cnt, mine, sp = 0u;
    for (;;) {
        sum = 0u; cnt = 0u; mine = 0u;
#pragma unroll
        for (unsigned j = 0; j < 16; ++j) { const unsigned c = xb_ld(&bar[XB_XCNT(j)]); sum += c; cnt += (c > 0u) ? 1u : 0u; mine = (j == x) ? c : mine; }
        if (sum == G) break;
        __builtin_amdgcn_s_sleep(1);
        if ((++sp & 255u) == 0u) { if (xb_ld(&bar[XB_TMO])) break; if (sp > XB_SPIN_CAP) { atomicAdd(&bar[XB_TMO], 1u); break; } }
    }
    nloc = mine > 0u ? mine : 1u; nx = cnt > 0u ? cnt : 1u;
}
DI void xcd_barrier(const XcdBarrier& b) {
    asm volatile("s_waitcnt vmcnt(0)" ::: "memory");
    __syncthreads();
    if (threadIdx.x == 0) {
        unsigned* bar = b.bar;
        __builtin_amdgcn_s_waitcnt(0);
        unsigned nloc = b.st[0], nx = b.st[1];
        if (nloc == 0u) { xcd_barrier_complete(bar, b.x, nloc, nx); b.st[0] = nloc; b.st[1] = nx; }
        const unsigned old = xb_add(&bar[XB_XSUB(b.x)], 1u);
        const unsigned gen = old / nloc;
        if (old + 1u == (gen + 1u) * nloc) {
            __builtin_amdgcn_fence(__ATOMIC_RELEASE, "agent");
            asm volatile("s_waitcnt vmcnt(0)" ::: "memory");
            const unsigned og = xb_add(&bar[XB_TOP], 1u);
            const unsigned tg = og / nx;
            if (og + 1u == (tg + 1u) * nx) xb_add(&bar[XB_TOPGEN], 1u);
            else XB_SPIN(xb_ld(&bar[XB_TOPGEN]) == tg, bar);
            __builtin_amdgcn_fence(__ATOMIC_ACQUIRE, "agent");
            xb_add(&bar[XB_XGEN(b.x)], 1u);
            asm volatile("s_waitcnt vmcnt(0)" ::: "memory");
        } else {
            XB_SPIN(xb_ld(&bar[XB_XGEN(b.x)]) == gen, bar);
            __builtin_amdgcn_fence(__ATOMIC_ACQUIRE, "agent");
            asm volatile("s_waitcnt vmcnt(0)" ::: "memory");
        }
    }
    __syncthreads();
}


#define XB_CNT(k) (3584 + 64 * (k))
DI void signal_count(unsigned* w) {
    asm volatile("s_waitcnt vmcnt(0)" ::: "memory");
    __syncthreads();
    if (threadIdx.x == 0) { __builtin_amdgcn_fence(__ATOMIC_RELEASE, "agent"); asm volatile("s_waitcnt vmcnt(0)" ::: "memory"); (void)xb_add(w, 1u); }
}
DI void wait_count(unsigned* w, unsigned target) {
    if (threadIdx.x == 0) {
        unsigned sp = 0;
        while (xb_ld(w) < target) { __builtin_amdgcn_s_sleep(4); if (++sp > (1u << 24)) break; }
        __builtin_amdgcn_fence(__ATOMIC_ACQUIRE, "agent");
        asm volatile("s_waitcnt vmcnt(0)" ::: "memory");
    }
    __syncthreads();
}

constexpr int LROW = 144;
constexpr int LTILE = 256 * LROW;
constexpr int LSTAGE = 2 * LTILE;
constexpr int LDS_BYTES = 2 * LSTAGE;

template <int AMODE, int NRB, int NCB>
DI void gemm_acc(f32x16 (&acc)[NRB][NCB], const bf16* __restrict__ A, const long lda, const int arow0,
                 const bf16* __restrict__ Bt, const long ldb, const int brow0, const int K, ldsp lds) {
    int tid_ = threadIdx.x; asm volatile("" : "+v"(tid_));
    const int tid = tid_, lane = tid & 63, w = tid >> 6, wm = w >> 2, wn = w & 3, r = lane & 31, h = lane >> 5;
    const int v = tid & 7, lr = tid >> 3;
    const int avoff = AMODE ? ((v >> 1) * 256 + (v & 1) * 8) : v * 8;
    const int akstep = AMODE ? 1024 : 64;
    const bf16* ag = A + (long)(arow0 + lr) * lda + avoff;
    const bf16* bg = Bt + (long)(brow0 + lr) * ldb + v * 8;
    const int nk = K >> 6;
    u32x4 ra[NRB], rb[2 * NCB];
#pragma unroll
    for (int i = 0; i < NRB; ++i) ra[i] = *(const u32x4*)(ag + (long)i * 64 * lda);
#pragma unroll
    for (int i = 0; i < 2 * NCB; ++i) rb[i] = *(const u32x4*)(bg + (long)i * 64 * ldb);
    ldsp wr = lds + lr * LROW + v * 16;
#pragma unroll
    for (int i = 0; i < NRB; ++i) *(LAS u32x4*)(wr + i * 64 * LROW) = ra[i];
#pragma unroll
    for (int i = 0; i < 2 * NCB; ++i) *(LAS u32x4*)(wr + LTILE + i * 64 * LROW) = rb[i];
    __syncthreads();
    cldsp la = lds + (wm * 32 * NRB + r) * LROW + h * 16;
    cldsp lb = lds + LTILE + (wn * 32 * NCB + r) * LROW + h * 16;
    for (int kt = 0; kt < nk; ++kt) {
        const int buf = kt & 1;
        const bool more = (kt + 1 < nk);
        if (more) {
            ag += akstep; bg += 64;
#pragma unroll
            for (int i = 0; i < NRB; ++i) ra[i] = *(const u32x4*)(ag + (long)i * 64 * lda);
#pragma unroll
            for (int i = 0; i < 2 * NCB; ++i) rb[i] = *(const u32x4*)(bg + (long)i * 64 * ldb);
        }
        __builtin_amdgcn_sched_barrier(0);
        cldsp pa = la + buf * LSTAGE; cldsp pb = lb + buf * LSTAGE;
#pragma unroll
        for (int s = 0; s < 4; ++s) {
            bf16x8 af[NRB], bfr[NCB];
#pragma unroll
            for (int rb_ = 0; rb_ < NRB; ++rb_) af[rb_] = *(const LAS bf16x8*)(pa + rb_ * 32 * LROW + s * 32);
#pragma unroll
            for (int cb = 0; cb < NCB; ++cb) bfr[cb] = *(const LAS bf16x8*)(pb + cb * 32 * LROW + s * 32);
#pragma unroll
            for (int rb_ = 0; rb_ < NRB; ++rb_)
#pragma unroll
                for (int cb = 0; cb < NCB; ++cb) acc[rb_][cb] = MFMA(af[rb_], bfr[cb], acc[rb_][cb]);
        }
        __builtin_amdgcn_sched_barrier(0);
        if (more) {
            ldsp w2 = wr + (buf ^ 1) * LSTAGE;
#pragma unroll
            for (int i = 0; i < NRB; ++i) *(LAS u32x4*)(w2 + i * 64 * LROW) = ra[i];
#pragma unroll
            for (int i = 0; i < 2 * NCB; ++i) *(LAS u32x4*)(w2 + LTILE + i * 64 * LROW) = rb[i];
        }
        __syncthreads();
    }
}
template <int NRB, int NCB>
DI void zero_acc(f32x16 (&acc)[NRB][NCB]) {
#pragma unroll
    for (int a = 0; a < NRB; ++a)
#pragma unroll
        for (int b = 0; b < NCB; ++b)
#pragma unroll
            for (int i = 0; i < 16; ++i) acc[a][b][i] = 0.f;
}
#define ACC_ROW(rb, i) (wm * 128 + (rb) * 32 + ((i) & 3) + 8 * ((i) >> 2) + 4 * h)
#define ACC_COL(cb) (wn * 64 + (cb) * 32 + r)
#define TID_VARS int tid_ = threadIdx.x; asm volatile("" : "+v"(tid_)); const int tid = tid_, lane = tid & 63, w = tid >> 6, wm = w >> 2, wn = w & 3, r = lane & 31, h = lane >> 5; (void)wm; (void)wn; (void)r; (void)h; (void)lane; (void)w;

DI const float* mods_ptr(const Params& p, int cond, int l, int j) { return (const float*)(p.ws + O_MODS) + ((size_t)(cond * 2 + l) * 9 + j) * 1024; }


namespace pg8 {
#define PG8_LAS __attribute__((address_space(3)))
typedef unsigned short bf16_t;
typedef short bf16x8 __attribute__((ext_vector_type(8)));
typedef float f32x4 __attribute__((ext_vector_type(4)));
typedef unsigned u32x4 __attribute__((ext_vector_type(4)));
constexpr int BM = 256, BK = 64, HALF = 128, HTB = HALF * BK * 2  , STAGE_BYTES = 8 * HTB, NXCD = 8, WGM = 8;

__host__ __device__ __forceinline__ int lds_byte(int r, int c) { const int st = (r >> 4) * 2 + (c >> 5), rr = r & 15, cc = c & 31, ob = rr * 64 + cc * 2; return st * 1024 + (ob ^ (((ob >> 9) & 1) << 5)); }
__host__ __device__ __forceinline__ void stage_rc(int b, int& R, int& C) { const int st = b / 1024, sb = b % 1024, swz = sb ^ (((sb >> 9) & 1) << 5); R = (st >> 1) * 16 + swz / 64; C = (st & 1) * 32 + (swz % 64) / 2; }
__host__ __device__ __forceinline__ int perm32(int rho) { const int n = rho >> 4, i = rho & 15; return 8 * (i >> 2) + 4 * n + (i & 3); }

struct Unit { int pm, pn; };
struct Gemm { const bf16_t* A; const bf16_t* Bt; int K, ld; };

struct StaticOrder {
    int nM, nN, nwg, G, c;
    __host__ __device__ void init(int M, int N, int G_, int c_) { nM = M / BM; nN = N / BM; nwg = nM * nN; G = G_; c = c_; }
    __host__ __device__ bool next(int i, Unit& u) const {
        const long L = (long)i * G + c; if (L >= nwg) return false;
        int wgid = (int)L; { const int q = nwg / NXCD, r = nwg % NXCD, xcd = wgid % NXCD, off = wgid / NXCD; wgid = (xcd < r ? xcd * (q + 1) : r * (q + 1) + (xcd - r) * q) + off; }
        const int nig = WGM * nN, gid = wgid / nig, fm = gid * WGM, gsz = (nM - fm) < WGM ? (nM - fm) : WGM;
        u.pm = fm + ((wgid % nig) % gsz); u.pn = (wgid % nig) / gsz; return true;
    }
    __device__ __forceinline__ void a_ready(const Unit&) const {}
    __device__ __forceinline__ void done(const Unit&) const {}
};

template <class Epi, class Sched, bool ALIGN_EPI = false, bool SP2 = false>
__device__ __forceinline__ void gemm_phase(PG8_LAS unsigned char* lds, const Gemm g, const Sched& S, const Epi& E) {
    int tid_ = threadIdx.x; asm volatile("" : "+v"(tid_));
    const int tid = tid_, wid = __builtin_amdgcn_readfirstlane(tid >> 6), lane = tid & 63, wr = wid >> 2, wc = wid & 3, fr = lane & 15, fq = lane >> 4;
    int K_ = g.K; asm volatile("" : "+s"(K_));
    const int K = K_, nt = K / BK;
    unsigned voffA[2], voffB[2];
#pragma unroll
    for (int i = 0; i < 2; ++i) { int R, C; stage_rc(tid * 16 + i * 8192, R, C); const int Rb = Epi::PERM ? ((R & ~31) + perm32(R & 31)) : R;
        voffA[i] = (unsigned)(R * g.ld + C) * 2u; voffB[i] = (unsigned)(Rb * g.ld + C) * 2u; }
    const size_t kstep = (size_t)(BK * 2);
    const size_t hstep = (size_t)HALF * g.ld * 2;
    const size_t tstep = 2 * hstep;
    const unsigned ldsw = (unsigned)wid * 1024u;
    const int aoff = lds_byte(wr * 64 + fr, fq * 8), boff = lds_byte(wc * 32 + fr, fq * 8);
#define PG8_SA(b, h) (((b) * 2 + (h)) * HTB)
#define PG8_SB(b, h) ((4 + (b) * 2 + (h)) * HTB)
#define PG8_STAGE(bufoff, gbase, voff) do { _Pragma("unroll") for (int _i = 0; _i < 2; ++_i) \
        __builtin_amdgcn_global_load_lds((const unsigned*)((const char*)(gbase) + (voff)[_i]), (PG8_LAS unsigned*)(lds + (bufoff) + ldsw + _i * 8192), 16, 0, 0); } while (0)
#define PG8_LDA(dst, b, h) do { _Pragma("unroll") for (int m = 0; m < 4; ++m) _Pragma("unroll") for (int k = 0; k < 2; ++k) dst[m][k] = *(const PG8_LAS bf16x8*)(lds + PG8_SA(b, h) + aoff + m * 2048 + k * 1024); } while (0)
#define PG8_LDB(dst, b, h) do { _Pragma("unroll") for (int n = 0; n < 2; ++n) _Pragma("unroll") for (int k = 0; k < 2; ++k) dst[n][k] = *(const PG8_LAS bf16x8*)(lds + PG8_SB(b, h) + boff + n * 2048 + k * 1024); } while (0)
#define PG8_MMA(ai, bj, At, Bt) do { __builtin_amdgcn_s_setprio(1); _Pragma("unroll") for (int m = 0; m < 4; ++m) _Pragma("unroll") for (int n = 0; n < 2; ++n) _Pragma("unroll") for (int k = 0; k < 2; ++k) \
        acc[ai][bj][m][n] = __builtin_amdgcn_mfma_f32_16x16x32_bf16(Bt[n][k], At[m][k], acc[ai][bj][m][n], 0, 0, 0); __builtin_amdgcn_s_setprio(0); } while (0)
#define PG8_WAIT_V(n) asm volatile("s_waitcnt vmcnt(" #n ")" ::: "memory")
#define PG8_WAIT_L(n) asm volatile("s_waitcnt lgkmcnt(" #n ")" ::: "memory")
#define PG8_BAR __builtin_amdgcn_s_barrier()
#define PG8_SCHED __builtin_amdgcn_sched_barrier(0)
    Unit cur, nxt; int ui = 0;
    if (!S.next(0, cur)) return;
    f32x4 acc[2][2][4][2];
#pragma unroll
    for (int a = 0; a < 2; ++a)
#pragma unroll
        for (int b = 0; b < 2; ++b)
#pragma unroll
            for (int m = 0; m < 4; ++m)
#pragma unroll
                for (int n = 0; n < 2; ++n) acc[a][b][m][n] = (f32x4){0.f, 0.f, 0.f, 0.f};
    bf16x8 At[4][2], B0[2][2], B1[2][2];
    const char* cA = (const char*)g.A + (size_t)cur.pm * tstep; const char* cB = (const char*)g.Bt + (size_t)cur.pn * tstep;
    S.a_ready(cur);
    if constexpr (SP2) {
        PG8_STAGE(PG8_SB(0, 0), cB, voffB); PG8_STAGE(PG8_SB(0, 1), cB + hstep, voffB); PG8_STAGE(PG8_SA(0, 0), cA, voffA); PG8_STAGE(PG8_SA(0, 1), cA + hstep, voffA);
        if (wr == 1) PG8_BAR;
        PG8_WAIT_V(2); PG8_BAR;
        PG8_STAGE(PG8_SB(1, 0), cB + kstep, voffB); PG8_STAGE(PG8_SA(1, 0), cA + kstep, voffA); PG8_STAGE(PG8_SB(1, 1), cB + hstep + kstep, voffB);
        PG8_WAIT_V(6); PG8_BAR;
    } else {
        PG8_STAGE(PG8_SB(0, 0), cB, voffB); PG8_STAGE(PG8_SA(0, 0), cA, voffA); PG8_STAGE(PG8_SB(0, 1), cB + hstep, voffB); PG8_STAGE(PG8_SA(0, 1), cA + hstep, voffA);
        if (wr == 1) PG8_BAR;
        PG8_WAIT_V(4); PG8_BAR;
        PG8_STAGE(PG8_SB(1, 0), cB + kstep, voffB); PG8_STAGE(PG8_SA(1, 0), cA + kstep, voffA); PG8_STAGE(PG8_SB(1, 1), cB + hstep + kstep, voffB);
        PG8_WAIT_V(6); PG8_BAR;
    }
    for (;;) {
        const bool has_next = S.next(ui + 1, nxt);
        const char* nA = has_next ? (const char*)g.A + (size_t)nxt.pm * tstep : cA; const char* nB = has_next ? (const char*)g.Bt + (size_t)nxt.pn * tstep : cB;
        for (int t = 0; t < nt; t += 2) {
            const bool last = (t == nt - 2);
            const char* a1 = cA + (size_t)(t + 1) * kstep;
            const char* a2 = last ? nA : cA + (size_t)(t + 2) * kstep; const char* b2 = last ? nB : cB + (size_t)(t + 2) * kstep;
            const char* a3 = a2 + kstep; const char* b3 = b2 + kstep;
            if (last && has_next) S.a_ready(nxt);
            if constexpr (SP2) {
            PG8_LDB(B0, 0, 0); PG8_LDB(B1, 0, 1); PG8_SCHED; PG8_LDA(At, 0, 0); PG8_STAGE(PG8_SA(1, 1), a1 + hstep, voffA);
            PG8_WAIT_V(8); PG8_WAIT_L(0); PG8_BAR; PG8_MMA(0, 0, At, B0); PG8_MMA(0, 1, At, B1); PG8_BAR; PG8_SCHED;
            PG8_LDA(At, 0, 1); PG8_STAGE(PG8_SB(0, 0), b2, voffB); PG8_STAGE(PG8_SB(0, 1), b2 + hstep, voffB); PG8_STAGE(PG8_SA(0, 0), a2, voffA);
            PG8_WAIT_V(8); PG8_WAIT_L(0); PG8_BAR; PG8_MMA(1, 0, At, B0); PG8_MMA(1, 1, At, B1); PG8_BAR; PG8_SCHED;
            PG8_LDB(B0, 1, 0); PG8_LDB(B1, 1, 1); PG8_SCHED; PG8_LDA(At, 1, 0); PG8_STAGE(PG8_SA(0, 1), a2 + hstep, voffA);
            PG8_WAIT_V(8); PG8_WAIT_L(0); PG8_BAR; PG8_MMA(0, 0, At, B0); PG8_MMA(0, 1, At, B1); PG8_BAR; PG8_SCHED;
            PG8_LDA(At, 1, 1); PG8_STAGE(PG8_SB(1, 0), b3, voffB); PG8_STAGE(PG8_SB(1, 1), b3 + hstep, voffB); PG8_STAGE(PG8_SA(1, 0), a3, voffA);
            PG8_WAIT_V(8); PG8_WAIT_L(0); PG8_BAR; PG8_MMA(1, 0, At, B0); PG8_MMA(1, 1, At, B1); PG8_BAR; PG8_SCHED;
            } else {
            PG8_LDB(B0, 0, 0); PG8_SCHED; PG8_LDA(At, 0, 0); PG8_STAGE(PG8_SA(1, 1), a1 + hstep, voffA);
            PG8_WAIT_L(8); PG8_BAR; PG8_WAIT_L(0); PG8_MMA(0, 0, At, B0); PG8_BAR; PG8_SCHED;
            PG8_LDB(B1, 0, 1); PG8_STAGE(PG8_SB(0, 0), b2, voffB);
            PG8_BAR; PG8_WAIT_L(0); PG8_MMA(0, 1, At, B1); PG8_BAR;
            PG8_LDA(At, 0, 1); PG8_STAGE(PG8_SA(0, 0), a2, voffA);
            PG8_BAR; PG8_WAIT_L(0); PG8_MMA(1, 0, At, B0); PG8_BAR; PG8_SCHED;
            PG8_STAGE(PG8_SB(0, 1), b2 + hstep, voffB);
            PG8_WAIT_V(6); PG8_BAR; PG8_MMA(1, 1, At, B1); PG8_BAR;
            PG8_LDB(B0, 1, 0); PG8_SCHED; PG8_LDA(At, 1, 0); PG8_STAGE(PG8_SA(0, 1), a2 + hstep, voffA);
            PG8_WAIT_L(8); PG8_BAR; PG8_WAIT_L(0); PG8_MMA(0, 0, At, B0); PG8_BAR; PG8_SCHED;
            PG8_LDB(B1, 1, 1); PG8_STAGE(PG8_SB(1, 0), b3, voffB);
            PG8_BAR; PG8_WAIT_L(0); PG8_MMA(0, 1, At, B1); PG8_BAR;
            PG8_LDA(At, 1, 1); PG8_STAGE(PG8_SA(1, 0), a3, voffA);
            PG8_BAR; PG8_WAIT_L(0); PG8_MMA(1, 0, At, B0); PG8_BAR; PG8_SCHED;
            PG8_STAGE(PG8_SB(1, 1), b3 + hstep, voffB);
            PG8_WAIT_V(6); PG8_BAR; PG8_MMA(1, 1, At, B1); PG8_BAR;
            }
        }
        if constexpr (ALIGN_EPI) { if (wr == 0) PG8_BAR; }
        if constexpr (!Epi::AFTER_DRAIN) { E(acc, cur, wr, wc, fr, fq); S.done(cur); }
        if (!has_next) break;
#pragma unroll
        for (int a = 0; a < 2; ++a)
#pragma unroll
            for (int b = 0; b < 2; ++b)
#pragma unroll
                for (int m = 0; m < 4; ++m)
#pragma unroll
                    for (int n = 0; n < 2; ++n) acc[a][b][m][n] = (f32x4){0.f, 0.f, 0.f, 0.f};
        cur = nxt; cA = nA; cB = nB; ++ui;
        if constexpr (ALIGN_EPI) { if (wr == 1) PG8_BAR; }
    }
    PG8_WAIT_V(0);
    if constexpr (!ALIGN_EPI) { if (wr == 0) PG8_BAR; }
    PG8_BAR;
    if constexpr (Epi::AFTER_DRAIN) { E.fused(acc, cur, wr, wc, fr, fq, lds, wid, lane); S.done(cur); }
#undef PG8_SA
#undef PG8_SB
#undef PG8_STAGE
#undef PG8_LDA
#undef PG8_LDB
#undef PG8_MMA
#undef PG8_WAIT_V
#undef PG8_WAIT_L
#undef PG8_BAR
#undef PG8_SCHED
}
}

struct OneUnit {
    int pm, pn; bool have;
    DI bool next(int i, pg8::Unit& u) const { if (i > 0 || !have) return false; u.pm = pm; u.pn = pn; return true; }
    DI void a_ready(const pg8::Unit&) const {}
    DI void done(const pg8::Unit&) const {}
};
struct EpiFfnA {
    static constexpr bool PERM = true, AFTER_DRAIN = false;
    bf16* hid;
    DI void operator()(const f32x4 (&acc)[2][2][4][2], const pg8::Unit& u, int wr, int wc, int fr, int fq) const {
        asm volatile("" : "+v"(fr), "+v"(fq), "+s"(wr), "+s"(wc));
        const int row0 = u.pm * 256 + wr * 64 + fr, hc0 = u.pn * 128 + wc * 32 + 8 * fq;
#pragma unroll
        for (int ai = 0; ai < 2; ++ai)
#pragma unroll
            for (int m = 0; m < 4; ++m) {
                const int row = row0 + ai * 128 + m * 16;
                float v[8];
#pragma unroll
                for (int n = 0; n < 2; ++n)
#pragma unroll
                    for (int j = 0; j < 4; ++j) { const float g = acc[ai][0][m][n][j], up = acc[ai][1][m][n][j]; v[n * 4 + j] = g * sigmoidf_(g) * up; }
                u32x4 o; o.x = pk2(v[0], v[1]); o.y = pk2(v[2], v[3]); o.z = pk2(v[4], v[5]); o.w = pk2(v[6], v[7]);
                AT(u32x4, hid, (row * DFF + hc0) >> 3) = o;
            }
    }
};
struct EpiResid {
    static constexpr bool PERM = true, AFTER_DRAIN = false;
    float* X; const float* resid; const float* gate; float scale; bool atomic;
    DI void operator()(const f32x4 (&acc)[2][2][4][2], const pg8::Unit& u, int wr, int wc, int fr, int fq) const {
        asm volatile("" : "+v"(fr), "+v"(fq), "+s"(wr), "+s"(wc));
        const int row0 = u.pm * 256 + wr * 64 + fr;
#pragma unroll
        for (int bj = 0; bj < 2; ++bj) {
            const int c0 = u.pn * 256 + bj * 128 + wc * 32 + 8 * fq;
            const f32x4 g0 = *(const f32x4*)(gate + c0) * scale, g1 = *(const f32x4*)(gate + c0 + 4) * scale;
            if (atomic) {
#pragma unroll
                for (int ai = 0; ai < 2; ++ai)
#pragma unroll
                    for (int m = 0; m < 4; ++m) {
                        const int row = row0 + ai * 128 + m * 16;
                        const f32x4 d0 = g0 * acc[ai][bj][m][0], d1 = g1 * acc[ai][bj][m][1];
#pragma unroll
                        for (int j = 0; j < 4; ++j) { atomicAdd(&AT(float, X, row * D + c0 + j), d0[j]); atomicAdd(&AT(float, X, row * D + c0 + 4 + j), d1[j]); }
                    }
            } else {
                f32x4 r0[8], r1[8];
#pragma unroll
                for (int q = 0; q < 8; ++q) { const int row = row0 + (q >> 2) * 128 + (q & 3) * 16; r0[q] = AT(const f32x4, resid, (row * D + c0) >> 2); r1[q] = AT(const f32x4, resid, (row * D + c0 + 4) >> 2); }
#pragma unroll
                for (int q = 0; q < 8; ++q) {
                    const int row = row0 + (q >> 2) * 128 + (q & 3) * 16;
                    AT(f32x4, X, (row * D + c0) >> 2) = r0[q] + g0 * acc[q >> 2][bj][q & 3][0]; AT(f32x4, X, (row * D + c0 + 4) >> 2) = r1[q] + g1 * acc[q >> 2][bj][q & 3][1];
                }
            }
        }
    }
};
struct EpiInproj {
    static constexpr bool PERM = true, AFTER_DRAIN = false;
    char* ws; const float* gq; const float* gk;
    DI void operator()(const f32x4 (&acc)[2][2][4][2], const pg8::Unit& u, int wr, int wc, int fr, int fq) const {
        asm volatile("" : "+v"(fr), "+v"(fq), "+s"(wr), "+s"(wc));
        const int pn = u.pn, row0 = u.pm * 256 + wr * 64 + fr;
        if (pn < 2 || pn > 4) {
            bf16* dst; int ld, cb;
            if (pn == 0) { dst = (bf16*)(ws + O_A); ld = 256; cb = 0; } else if (pn == 1) { dst = (bf16*)(ws + O_S); ld = 256; cb = 0; } else { dst = (bf16*)(ws + O_BIG); ld = 3072; cb = (pn - 5) * 256; }
            const bool sg = pn > 4;
#pragma unroll
            for (int bj = 0; bj < 2; ++bj) {
                const int c0 = cb + bj * 128 + wc * 32 + 8 * fq;
#pragma unroll
                for (int ai = 0; ai < 2; ++ai)
#pragma unroll
                    for (int m = 0; m < 4; ++m) {
                        const int row = row0 + ai * 128 + m * 16;
                        float v[8];
#pragma unroll
                        for (int n = 0; n < 2; ++n)
#pragma unroll
                            for (int j = 0; j < 4; ++j) { const float x = acc[ai][bj][m][n][j]; v[n * 4 + j] = sg ? sigmoidf_(x) : x; }
                        u32x4 o; o.x = pk2(v[0], v[1]); o.y = pk2(v[2], v[3]); o.z = pk2(v[4], v[5]); o.w = pk2(v[6], v[7]);
                        AT(u32x4, dst, (row * ld + c0) >> 3) = o;
                    }
            }
        } else if (pn < 4 || wc < 2) {
            const bool isq = pn < 4;
            const float* gv = isq ? gq : gk;
            const float2* rope = (const float2*)(ws + O_ROPE);
            const bool latent = u.pm < 64;
            const float osc = isq ? 0.125f * 1.4426950408889634f : 1.f, sgn = (fq >= 2) ? 1.f : -1.f;
            bf16* dst = (bf16*)(ws + (isq ? O_Q : O_K));
            const int ld = isq ? 512 : 128, hb = (isq ? (pn - 2) * 4 + wc : wc) * 64 + 8 * fq, i0 = 8 * (fq & 1);
#pragma unroll
            for (int ai = 0; ai < 2; ++ai)
#pragma unroll
                for (int m = 0; m < 4; ++m) {
                    const int row = row0 + ai * 128 + m * 16;
                    float v[2][8]; float ss = 0.f;
#pragma unroll
                    for (int bj = 0; bj < 2; ++bj)
#pragma unroll
                        for (int n = 0; n < 2; ++n)
#pragma unroll
                            for (int j = 0; j < 4; ++j) { const float x = acc[ai][bj][m][n][j]; v[bj][n * 4 + j] = x; ss += x * x; }
                    ss += __shfl_xor(ss, 16); ss += __shfl_xor(ss, 32);
                    const float rstd = rsqrtf(ss * (1.f / 64.f) + 1e-6f);
#pragma unroll
                    for (int bj = 0; bj < 2; ++bj) {
#pragma unroll
                        for (int e = 0; e < 8; ++e) v[bj][e] *= rstd * AT(const float, gv, 32 * bj + 8 * fq + e);
                        if (latent) {
                            const int pos = bj == 0 ? (row >> 6) : (row & 63);
#pragma unroll
                            for (int e = 0; e < 8; ++e) {
                                const float2 cs = AT(const float2, rope, pos * 16 + i0 + e);
                                const float pr = __shfl_xor(v[bj][e], 32);
                                v[bj][e] = v[bj][e] * cs.x + sgn * pr * cs.y;
                            }
                        }
                        u32x4 o; o.x = pk2(v[bj][0] * osc, v[bj][1] * osc); o.y = pk2(v[bj][2] * osc, v[bj][3] * osc); o.z = pk2(v[bj][4] * osc, v[bj][5] * osc); o.w = pk2(v[bj][6] * osc, v[bj][7] * osc);
                        AT(u32x4, dst, (row * ld + hb + 32 * bj) >> 3) = o;
                    }
                    asm volatile("" ::: "memory");
                }
        } else {
            bf16* vt = (bf16*)(ws + O_VT);
#pragma unroll
            for (int bj = 0; bj < 2; ++bj)
#pragma unroll
                for (int ai = 0; ai < 2; ++ai)
#pragma unroll
                    for (int m = 0; m < 4; ++m) {
                        const int row = row0 + ai * 128 + m * 16;
#pragma unroll
                        for (int n = 0; n < 2; ++n)
#pragma unroll
                            for (int j = 0; j < 4; ++j) AT(bf16, vt, ((wc - 2) * 64 + 32 * bj + 8 * fq + 4 * n + j) * NT + row) = f2bf(acc[ai][bj][m][n][j]);
                    }
        }
    }
};
typedef PG8_LAS unsigned char* pg8lds;
DI void big_ffn_a(const Params& p, int f, int M, ldsp lds) {
    pg8::Gemm g{(const pg8::bf16_t*)(p.ws + O_H), (const pg8::bf16_t*)(p.ws + O_W13) + (size_t)f * 5632 * 1024, 1024, 1024};
    pg8::StaticOrder S; S.init(M, 5632, gridDim.x, blockIdx.x);
    EpiFfnA E{(bf16*)(p.ws + O_BIG)};
    pg8::gemm_phase<EpiFfnA, pg8::StaticOrder, true, true>((pg8lds)lds, g, S, E);
}
#define PANEL_CNT(l, prod, pm) (4096 + ((l) * 3 + (prod)) * 80 + (pm))
DI unsigned panel_arrive_wait(unsigned* w, unsigned target, ldsp lds) {
    asm volatile("s_waitcnt vmcnt(0)" ::: "memory");
    __syncthreads();
    LAS unsigned* flag = (LAS unsigned*)lds;
    if (threadIdx.x == 0) {
        __builtin_amdgcn_fence(__ATOMIC_RELEASE, "agent");
        asm volatile("s_waitcnt vmcnt(0)" ::: "memory");
        const unsigned old = xb_add(w, 1u);
        unsigned sp = 0;
        while (xb_ld(w) < target) { __builtin_amdgcn_s_sleep(2); if (++sp > (1u << 24)) break; }
        __builtin_amdgcn_fence(__ATOMIC_ACQUIRE, "agent");
        asm volatile("s_waitcnt vmcnt(0)" ::: "memory");
        *flag = old;
    }
    __syncthreads();
    const unsigned r = *flag;
    __syncthreads();
    return r;
}
DI void norm_rows(const Params& p, int nl, int nwhich, bool fin, int r0, int nrows) {
    const int lane = threadIdx.x & 63, w = threadIdx.x >> 6;
    const int cond = r0 >= NL, per = nrows >> 3;
    f32x4 gm[4], sv[4];
#pragma unroll
    for (int j = 0; j < 4; ++j) {
        const int c = lane * 4 + 256 * j;
        if (fin) { gm[j] = *(const f32x4*)(p.in[I_FG] + c); sv[j] = (f32x4){0.f, 0.f, 0.f, 0.f}; }
        else {
            const float* g = p.in[I_NORMG] + (size_t)(nl * 3 + nwhich) * D;
            gm[j] = *(const f32x4*)(g + c) * (*(const f32x4*)(mods_ptr(p, cond, nl, 3 * nwhich + 1) + c) + 1.f);
            sv[j] = *(const f32x4*)(mods_ptr(p, cond, nl, 3 * nwhich) + c);
        }
    }
    const int wbeg = r0 + w * per, wend = wbeg + per;
#pragma unroll 1
    for (int rb = wbeg; rb < wend; rb += 4) {
        const int n = min(4, wend - rb);
        f32x4 x[4][4];
#pragma unroll
        for (int q = 0; q < 4; ++q)
#pragma unroll
            for (int j = 0; j < 4; ++j) x[q][j] = *(const f32x4*)((const float*)(p.ws + O_X) + (size_t)(rb + (q < n ? q : 0)) * D + lane * 4 + 256 * j);
#pragma unroll
        for (int q = 0; q < 4; ++q) {
            if (q < n) {
                float ss = 0.f;
#pragma unroll
                for (int j = 0; j < 4; ++j) ss += x[q][j][0] * x[q][j][0] + x[q][j][1] * x[q][j][1] + x[q][j][2] * x[q][j][2] + x[q][j][3] * x[q][j][3];
                ss = wave_sum(ss);
                const float rstd = __builtin_amdgcn_rsqf(ss * (1.f / 1024.f) + 1e-6f);
#pragma unroll
                for (int j = 0; j < 4; ++j) {
                    const int c = lane * 4 + 256 * j;
                    const f32x4 o = x[q][j] * rstd * gm[j] + sv[j];
                    if (fin) *(f32x4*)(p.out + (size_t)(rb + q) * D + c) = o;
                    else { u32x2 pk; pk.x = pk2(o[0], o[1]); pk.y = pk2(o[2], o[3]); *(u32x2*)((bf16*)(p.ws + O_H) + (size_t)(rb + q) * D + c) = pk; }
                }
            }
        }
    }
}
DI void big_resid(const Params& p, const bf16* A, const bf16* Bt, int K, int l, int gate_j, float scale, bool resid_in, bool ctx, int prod, int nl, int nwhich, bool fin, ldsp lds) {
    float* X = (float*)(p.ws + O_X);
    unsigned* cw = (unsigned*)(p.ws + O_BAR);
    if (ctx) {
        const int j = blockIdx.x, nsplit = K / 256;
        OneUnit S{64, j & 3, j < 4 * nsplit};
        pg8::Gemm g{(const pg8::bf16_t*)A + (j >> 2) * 256, (const pg8::bf16_t*)Bt + (j >> 2) * 256, 256, K};
        EpiResid E{X, X, mods_ptr(p, 1, l, gate_j), scale, true};
        pg8::gemm_phase<EpiResid, OneUnit, false, true>((pg8lds)lds, g, S, E);
        if (j < 4 * nsplit) {
            const unsigned k = panel_arrive_wait(cw + PANEL_CNT(l, prod, 64), 4u * nsplit, lds);
            if (k < 16u) norm_rows(p, nl, nwhich, false, NL + (int)k * 16, 16);
        }
    }
    pg8::Gemm g{(const pg8::bf16_t*)A, (const pg8::bf16_t*)Bt, K, K};
    pg8::StaticOrder S; S.init(NL, 1024, gridDim.x, blockIdx.x);
    EpiResid E{X, resid_in ? p.in[I_X] : X, mods_ptr(p, 0, l, gate_j), scale, false};
    pg8::gemm_phase<EpiResid, pg8::StaticOrder, false, true>((pg8lds)lds, g, S, E);
    pg8::Unit u;
    for (int i = 0; S.next(i, u); ++i) {
        const unsigned k = panel_arrive_wait(cw + PANEL_CNT(l, prod, u.pm), 4u, lds);
        norm_rows(p, nl, nwhich, fin, u.pm * 256 + (int)(k & 3u) * 64, 64);
    }
}
template <int MODE>
struct EpiMix {
    static constexpr bool PERM = true, AFTER_DRAIN = false;
    bf16* M; const bf16* G;
    DI void operator()(const f32x4 (&acc)[2][2][4][2], const pg8::Unit& u, int wr, int wc, int fr, int fq) const {
        asm volatile("" : "+v"(fr), "+v"(fq), "+s"(wr), "+s"(wc));
        const int row0 = u.pm * 256 + wr * 64 + fr;
#pragma unroll
        for (int bj = 0; bj < (MODE == 2 ? 1 : 2); ++bj) {
            const int c0 = (MODE == 2) ? (u.pn * 128 + wc * 32 + 8 * fq) : (u.pn * 256 + bj * 128 + wc * 32 + 8 * fq);
            const int gofs = (MODE == 0) ? 0 : (MODE == 1) ? 2048 : 1024;
            u32x4 gg[8], mm[8];
#pragma unroll
            for (int q = 0; q < 8; ++q) {
                const int row = row0 + (q >> 2) * 128 + (q & 3) * 16;
                gg[q] = AT(const u32x4, G, (row * 3072 + gofs + c0) >> 3);
                if (MODE != 0) mm[q] = AT(const u32x4, M, (row * D + c0) >> 3);
            }
#pragma unroll
            for (int q = 0; q < 8; ++q) {
                const int row = row0 + (q >> 2) * 128 + (q & 3) * 16, ai = q >> 2, m = q & 3;
                float v[8];
#pragma unroll
                for (int n = 0; n < 2; ++n)
#pragma unroll
                    for (int j = 0; j < 4; ++j) {
                        if (MODE == 2) v[n * 4 + j] = acc[ai][0][m][n][j] * sigmoidf_(acc[ai][1][m][n][j]);
                        else v[n * 4 + j] = acc[ai][bj][m][n][j];
                    }
                v[0] *= bflo(gg[q].x); v[1] *= bfhi(gg[q].x); v[2] *= bflo(gg[q].y); v[3] *= bfhi(gg[q].y); v[4] *= bflo(gg[q].z); v[5] *= bfhi(gg[q].z); v[6] *= bflo(gg[q].w); v[7] *= bfhi(gg[q].w);
                if (MODE != 0) { v[0] += bflo(mm[q].x); v[1] += bfhi(mm[q].x); v[2] += bflo(mm[q].y); v[3] += bfhi(mm[q].y); v[4] += bflo(mm[q].z); v[5] += bfhi(mm[q].z); v[6] += bflo(mm[q].w); v[7] += bfhi(mm[q].w); }
                u32x4 o; o.x = pk2(v[0], v[1]); o.y = pk2(v[2], v[3]); o.z = pk2(v[4], v[5]); o.w = pk2(v[6], v[7]);
                AT(u32x4, M, (row * D + c0) >> 3) = o;
            }
        }
    }
};
struct GluOrder {
    pg8::StaticOrder S;
    DI bool next(int i, pg8::Unit& u) const { pg8::Unit t; if (!S.next(i >> 1, t)) return false; u.pm = t.pm; u.pn = 2 * t.pn + (i & 1); return true; }
    DI void a_ready(const pg8::Unit&) const {}
    DI void done(const pg8::Unit&) const {}
};
DI void big_mix1(const Params& p, int M, ldsp lds) {
    bf16* Mx = (bf16*)(p.ws + O_H); const bf16* G = (const bf16*)(p.ws + O_BIG);
    pg8::StaticOrder S; S.init(M, 1024, gridDim.x, blockIdx.x);
    {   pg8::Gemm g{(const pg8::bf16_t*)(p.ws + O_YP), (const pg8::bf16_t*)(p.ws + O_WP), 256, 256};
        EpiMix<0> E{Mx, G};
        pg8::gemm_phase<EpiMix<0>, pg8::StaticOrder, false, true>((pg8lds)lds, g, S, E); }
    {   pg8::Gemm g{(const pg8::bf16_t*)(p.ws + O_Q), (const pg8::bf16_t*)(p.ws + O_WAO), 512, 512};
        EpiMix<1> E{Mx, G};
        pg8::gemm_phase<EpiMix<1>, pg8::StaticOrder, false, true>((pg8lds)lds, g, S, E); }
    {   pg8::Gemm g{(const pg8::bf16_t*)(p.ws + O_YS), (const pg8::bf16_t*)(p.ws + O_WGLU), 256, 256};
        GluOrder SG{S};
        EpiMix<2> E{Mx, G};
        pg8::gemm_phase<EpiMix<2>, GluOrder, false, true>((pg8lds)lds, g, SG, E); }
}
DI void big_inproj(const Params& p, int l, ldsp lds) {
    pg8::Gemm g{(const pg8::bf16_t*)(p.ws + O_H), (const pg8::bf16_t*)(p.ws + O_WIN), 1024, 1024};
    pg8::StaticOrder S; S.init(NT, INW, gridDim.x, blockIdx.x);
    EpiInproj E{p.ws, p.in[I_QG] + l * 64, p.in[I_KG] + l * 64};
    pg8::gemm_phase<EpiInproj, pg8::StaticOrder, true, true>((pg8lds)lds, g, S, E);
}

DI void norm_item(const Params& p, int l, int which, int it) {
    const int tid = threadIdx.x, lane = tid & 63, w = tid >> 6;
    const int row = it * 8 + w;
    const int cond = row >= NL;
    const bool from_in = (l == 0 && which == 0);
    const float* src = from_in ? (cond ? p.in[I_CTX] + (size_t)(row - NL) * D : p.in[I_X] + (size_t)row * D) : (const float*)(p.ws + O_X) + (size_t)row * D;
    f32x4 x[4]; float ss = 0.f;
#pragma unroll
    for (int j = 0; j < 4; ++j) { x[j] = *(const f32x4*)(src + lane * 4 + 256 * j); ss += x[j][0] * x[j][0] + x[j][1] * x[j][1] + x[j][2] * x[j][2] + x[j][3] * x[j][3]; }
    if (from_in && cond) {
        float* xr = (float*)(p.ws + O_X) + (size_t)row * D;
#pragma unroll
        for (int j = 0; j < 4; ++j) *(f32x4*)(xr + lane * 4 + 256 * j) = x[j];
    }
    ss = wave_sum(ss);
    const float rstd = rsqrtf(ss * (1.f / 1024.f) + 1e-6f);
    const float* g = p.in[I_NORMG] + (size_t)(l * 3 + which) * D;
    const float* sh = mods_ptr(p, cond, l, 3 * which), *sc = mods_ptr(p, cond, l, 3 * which + 1);
    bf16* H = (bf16*)(p.ws + O_H) + (size_t)row * D;
#pragma unroll
    for (int j = 0; j < 4; ++j) {
        const int c = lane * 4 + 256 * j;
        const f32x4 gv = *(const f32x4*)(g + c), sv = *(const f32x4*)(sh + c), cv = *(const f32x4*)(sc + c);
        float o[4];
#pragma unroll
        for (int e = 0; e < 4; ++e) o[e] = x[j][e] * rstd * gv[e] * (1.f + cv[e]) + sv[e];
        u32x2 pk; pk.x = pk2(o[0], o[1]); pk.y = pk2(o[2], o[3]);
        *(u32x2*)(H + c) = pk;
    }
}
DI void final_norm_item(const Params& p, int it) {
    const int tid = threadIdx.x, lane = tid & 63, w = tid >> 6;
    const int row = it * 8 + w;
    const float* src = (const float*)(p.ws + O_X) + (size_t)row * D;
    f32x4 x[4]; float ss = 0.f;
#pragma unroll
    for (int j = 0; j < 4; ++j) { x[j] = *(const f32x4*)(src + lane * 4 + 256 * j); ss += x[j][0] * x[j][0] + x[j][1] * x[j][1] + x[j][2] * x[j][2] + x[j][3] * x[j][3]; }
    ss = wave_sum(ss);
    const float rstd = rsqrtf(ss * (1.f / 1024.f) + 1e-6f);
    const float* g = p.in[I_FG];
#pragma unroll
    for (int j = 0; j < 4; ++j) {
        const int c = lane * 4 + 256 * j;
        const f32x4 gv = *(const f32x4*)(g + c);
        f32x4 o;
#pragma unroll
        for (int e = 0; e < 4; ++e) o[e] = x[j][e] * rstd * gv[e];
        *(f32x4*)(p.out + (size_t)row * D + c) = o;
    }
}
DI void s1_item(const Params& p, int it, ldsp lds) {
    TID_VARS
    const int g = it & 15, mt = it >> 4;
    f32x16 acc[4][2]; zero_acc<4, 2>(acc);
    gemm_acc<1, 4, 2>(acc, (const bf16*)(p.ws + O_S) + g * 16, 8192, mt * 256, (const bf16*)(p.ws + O_W1S) + (unsigned)g * 256 * 512, 512, 0, 512, lds);
    float* E = (float*)(p.ws + O_E);
#pragma unroll
    for (int rb = 0; rb < 4; ++rb)
#pragma unroll
        for (int cb = 0; cb < 2; ++cb)
#pragma unroll
            for (int i = 0; i < 16; ++i) {
                const int c = mt * 256 + ACC_ROW(rb, i);
                if (c < NCH) AT(float, E, (c * 16 + g) * 256 + ACC_COL(cb)) = acc[rb][cb][i];
            }
}
DI void s2_item(const Params& p, int it) {
    const int sidx = it * 512 + threadIdx.x;
    const int g = sidx >> 7, dir = (sidx >> 6) & 1, pp = sidx & 63;
    const float2 aT = ((const float2*)(p.ws + O_PW))[(unsigned)((dir * 16 + g) * 64 + pp) * 33 + 32];
    const float* E = (const float*)(p.ws + O_E) + g * 256 + dir * 128 + pp;
    bf16* C = (bf16*)(p.ws + O_CARRY) + g * 256 + dir * 128 + pp;
    float cr = 0.f, ci = 0.f;
#pragma unroll 8
    for (int n = 0; n < NCH; ++n) {
        int c;
        if (dir == 0) c = (n < 8) ? 512 + n : n - 8;
        else c = 519 - n;
        const float er = E[(unsigned)c * 4096], ei = E[(unsigned)c * 4096 + 64];
        C[(unsigned)c * 4096] = f2bf(cr); C[(unsigned)c * 4096 + 64] = f2bf(ci);
        const float nr = aT.x * cr - aT.y * ci + er, ni = aT.x * ci + aT.y * cr + ei;
        cr = nr; ci = ni;
    }
}
DI float gelu_tanh(float x) { const float u = 0.7978845608028654f * (x + 0.044715f * x * x * x); return x * sigmoidf_(2.f * u); }
DI void s3_item(const Params& p, int it, ldsp lds) {
    TID_VARS
    const int g = it & 15, rest = it >> 4, nt = rest & 1, mt = rest >> 1;
    f32x16 acc[4][2]; zero_acc<4, 2>(acc);
    gemm_acc<1, 4, 2>(acc, (const bf16*)(p.ws + O_S) + g * 16, 8192, mt * 256, (const bf16*)(p.ws + O_TOEP) + (unsigned)g * 512 * 512, 512, nt * 256, 512, lds);
    gemm_acc<0, 4, 2>(acc, (const bf16*)(p.ws + O_CARRY) + g * 256, 4096, mt * 256, (const bf16*)(p.ws + O_W3S) + (unsigned)g * 512 * 256, 256, nt * 256, 256, lds);
    bf16* Ys = (bf16*)(p.ws + O_YS);
#pragma unroll
    for (int rb = 0; rb < 4; ++rb)
#pragma unroll
        for (int cb = 0; cb < 2; ++cb)
#pragma unroll
            for (int i = 0; i < 16; ++i) {
                const int c = mt * 256 + ACC_ROW(rb, i);
                const int n = nt * 256 + ACC_COL(cb), j = n >> 4, hh = n & 15;
                if (c < NCH) AT(bf16, Ys, (c * 32 + j) * 256 + g * 16 + hh) = f2bf(gelu_tanh(acc[rb][cb][i]));
            }
}
DI void pool_item(const Params& p, int it) {
    const int tid = threadIdx.x, cv = tid & 31, rg = tid >> 5;
    const bf16* A = (const bf16*)(p.ws + O_A);
    bf16* Y = (bf16*)(p.ws + O_YP);
    const int half = 1 << (cv >> 3);
#pragma unroll 1
    for (int i = 0; i < 4; ++i) {
        const int row = it * 64 + rg + 16 * i;
        const int base = row >= NL ? NL : 0, n = row >= NL ? NC : NL, t = row - base;
        const int lo = max(t - half, 0), hi = min(t + half, n);
        float s[8];
#pragma unroll
        for (int e = 0; e < 8; ++e) s[e] = 0.f;
        for (int u = lo; u < hi; ++u) {
            const u32x4 v = *(const u32x4*)(A + (unsigned)(base + u) * 256 + cv * 8);
            s[0] += bflo(v.x); s[1] += bfhi(v.x); s[2] += bflo(v.y); s[3] += bfhi(v.y); s[4] += bflo(v.z); s[5] += bfhi(v.z); s[6] += bflo(v.w); s[7] += bfhi(v.w);
        }
        const u32x4 v = *(const u32x4*)(A + (unsigned)row * 256 + cv * 8);
        const float inv = 1.f / (float)(hi - lo);
        u32x4 o;
        o.x = pk2(s[0] * inv - bflo(v.x), s[1] * inv - bfhi(v.x)); o.y = pk2(s[2] * inv - bflo(v.y), s[3] * inv - bfhi(v.y));
        o.z = pk2(s[4] * inv - bflo(v.z), s[5] * inv - bfhi(v.z)); o.w = pk2(s[6] * inv - bflo(v.w), s[7] * inv - bfhi(v.w));
        *(u32x4*)(Y + (unsigned)row * 256 + cv * 8) = o;
    }
}
DI int sig_perm(int r) { return (r & 0x13) | ((r & 4) << 1) | ((r & 8) >> 1); }
template <bool FIXED>
DI void attn_item(const Params& p, int qb, int head, float bound, ldsp lds) {
    TID_VARS
    const int kvh = head >> 2;
    bf16* Q = (bf16*)(p.ws + O_Q);
    const bf16* Kp = (const bf16*)(p.ws + O_K) + kvh * 64;
    const bf16* Vp = (const bf16*)(p.ws + O_VT) + (unsigned)kvh * 64 * NT;
    const int q0 = qb * 256 + w * 32;
    bf16x8 qf[4];
#pragma unroll
    for (int s = 0; s < 4; ++s) qf[s] = *(const bf16x8*)(Q + (unsigned)(q0 + r) * 512 + head * 64 + 16 * s + 8 * h);
    const int key0 = qb < 64 ? 0 : NL, ntile = qb < 64 ? NT / 64 : NC / 64;
    const int isv = tid >> 8, lrow = (tid & 255) >> 3, lv = tid & 7;
    const bf16* gp = isv ? (Vp + (unsigned)lrow * NT + key0 + lv * 8) : (Kp + (unsigned)(key0 + lrow) * 128 + lv * 8);
    const unsigned gstep = isv ? 64u : 64u * 128u, grow = isv ? 32u * NT : 32u * 128u;
    u32x4 rgA[2], rgB[2];
#pragma unroll
    for (int i = 0; i < 2; ++i) rgB[i] = *(const u32x4*)(gp + i * grow);
    ldsp wr = lds + isv * 9216 + lrow * LROW + lv * 16;
#pragma unroll
    for (int i = 0; i < 2; ++i) *(LAS u32x4*)(wr + i * 32 * LROW) = rgB[i];
    gp += gstep;
#pragma unroll
    for (int i = 0; i < 2; ++i) rgA[i] = *(const u32x4*)(gp + i * grow);
    __syncthreads();
    f32x16 o0, o1;
#pragma unroll
    for (int i = 0; i < 16; ++i) { o0[i] = 0.f; o1[i] = 0.f; }
    float m = -1e30f, lsum = 0.f, lsa = 0.f, lsb = 0.f;
    f32x16 cinit;
#pragma unroll
    for (int i = 0; i < 16; ++i) cinit[i] = FIXED ? -bound * 1.4426950408889634f : 0.f;
    cldsp lk = lds + sig_perm(r) * LROW + h * 16;
    cldsp lvv = lds + 9216 + r * LROW + h * 16;
#define ATT_TILE(buf, RL, RW, t)                                                                                                     \
    {                                                                                                                                \
        if ((t) + 2 < ntile) {                                                                                                       \
            gp += gstep;                                                                                                             \
            _Pragma("unroll") for (int i = 0; i < 2; ++i) RL[i] = *(const u32x4*)(gp + i * grow);                                    \
        }                                                                                                                            \
        __builtin_amdgcn_sched_barrier(0);                                                                                           \
        cldsp pk = lk + (buf) * 18432; cldsp pv = lvv + (buf) * 18432;                                                               \
        f32x16 s0, s1;                                                                                                               \
        {                                                                                                                            \
            const bf16x8 k0 = *(const LAS bf16x8*)(pk), k1 = *(const LAS bf16x8*)(pk + 32 * LROW);                                   \
            s0 = MFMA(k0, qf[0], cinit); s1 = MFMA(k1, qf[0], cinit);                                                                \
        }                                                                                                                            \
        _Pragma("unroll") for (int s = 1; s < 4; ++s) {                                                                              \
            const bf16x8 k0 = *(const LAS bf16x8*)(pk + s * 32), k1 = *(const LAS bf16x8*)(pk + 32 * LROW + s * 32);                 \
            s0 = MFMA(k0, qf[s], s0); s1 = MFMA(k1, qf[s], s1);                                                                      \
        }                                                                                                                            \
        if (!FIXED) {                                                                                                                \
            float mx = s0[0];                                                                                                        \
            _Pragma("unroll") for (int i = 1; i < 16; ++i) mx = fmaxf(mx, s0[i]);                                                    \
            _Pragma("unroll") for (int i = 0; i < 16; ++i) mx = fmaxf(mx, s1[i]);                                                    \
            mx = fmaxf(mx, __shfl_xor(mx, 32));                                                                                      \
            const float mnew = fmaxf(m, mx);                                                                                         \
            const float alpha = __builtin_amdgcn_exp2f(m - mnew);                                                                    \
            m = mnew;                                                                                                                \
            lsa *= alpha; lsb *= alpha;                                                                                              \
            _Pragma("unroll") for (int i = 0; i < 16; ++i) { o0[i] *= alpha; o1[i] *= alpha; s0[i] -= mnew; s1[i] -= mnew; }         \
        }                                                                                                                            \
        _Pragma("unroll") for (int i = 0; i < 16; ++i) {                                                                             \
            s0[i] = __builtin_amdgcn_exp2f(s0[i]); s1[i] = __builtin_amdgcn_exp2f(s1[i]);                                            \
            lsa += s0[i]; lsb += s1[i];                                                                                              \
        }                                                                                                                            \
        _Pragma("unroll") for (int kb = 0; kb < 2; ++kb)                                                                             \
            _Pragma("unroll") for (int s = 0; s < 2; ++s) {                                                                          \
                u32x4 pp;                                                                                                            \
                if (kb == 0) { pp.x = pk2(s0[8 * s], s0[8 * s + 1]); pp.y = pk2(s0[8 * s + 2], s0[8 * s + 3]); pp.z = pk2(s0[8 * s + 4], s0[8 * s + 5]); pp.w = pk2(s0[8 * s + 6], s0[8 * s + 7]); } \
                else         { pp.x = pk2(s1[8 * s], s1[8 * s + 1]); pp.y = pk2(s1[8 * s + 2], s1[8 * s + 3]); pp.z = pk2(s1[8 * s + 4], s1[8 * s + 5]); pp.w = pk2(s1[8 * s + 6], s1[8 * s + 7]); } \
                const bf16x8 pf = __builtin_bit_cast(bf16x8, pp);                                                                    \
                const bf16x8 v0 = *(const LAS bf16x8*)(pv + (kb * 32 + 16 * s) * 2), v1 = *(const LAS bf16x8*)(pv + 32 * LROW + (kb * 32 + 16 * s) * 2); \
                o0 = MFMA(v0, pf, o0); o1 = MFMA(v1, pf, o1);                                                                        \
            }                                                                                                                        \
        __builtin_amdgcn_sched_barrier(0);                                                                                           \
        if ((t) + 1 < ntile) {                                                                                                       \
            ldsp w2 = wr + ((buf) ^ 1) * 18432;                                                                                      \
            _Pragma("unroll") for (int i = 0; i < 2; ++i) *(LAS u32x4*)(w2 + i * 32 * LROW) = RW[i];                                 \
        }                                                                                                                            \
        __syncthreads();                                                                                                             \
    }
    for (int t = 0; t < ntile; t += 2) {
        ATT_TILE(0, rgB, rgA, t)
        ATT_TILE(1, rgA, rgB, t + 1)
    }
#undef ATT_TILE
    lsum = lsa + lsb;
    lsum += __shfl_xor(lsum, 32);
    const float inv = 1.f / lsum;
    bf16* orow = Q + (unsigned)(q0 + r) * 512 + head * 64;
#pragma unroll
    for (int q = 0; q < 4; ++q) {
        u32x2 a, b;
        a.x = pk2(o0[4 * q] * inv, o0[4 * q + 1] * inv); a.y = pk2(o0[4 * q + 2] * inv, o0[4 * q + 3] * inv);
        b.x = pk2(o1[4 * q] * inv, o1[4 * q + 1] * inv); b.y = pk2(o1[4 * q + 2] * inv, o1[4 * q + 3] * inv);
        *(u32x2*)(orow + 8 * q + 4 * h) = a;
        *(u32x2*)(orow + 32 + 8 * q + 4 * h) = b;
    }
}
DI float attn_bound(const Params& p, int l) {
    const int lane = threadIdx.x & 63;
    float a = fabsf(p.in[I_QG][l * 64 + lane]), b = fabsf(p.in[I_KG][l * 64 + lane]);
#pragma unroll
    for (int o = 32; o >= 1; o >>= 1) { a = fmaxf(a, __shfl_xor(a, o)); b = fmaxf(b, __shfl_xor(b, o)); }
    return 8.f * 1.02f * a * b;
}
DI void attn_dispatch(const Params& p, int l, int qb, int head, ldsp lds) {
    const float bound = attn_bound(p, l);
    if (bound < 40.f) attn_item<true>(p, qb, head, bound, lds);
    else attn_item<false>(p, qb, head, 0.f, lds);
}
DI void conv_tile(const float* src, bf16* dst, int K, int N, int permmode, int tile, ldsp lds) {
    const int tid = threadIdx.x & 255, half = threadIdx.x >> 8;
    tile = tile * 2 + half;
    const int ntn = N / 64, tk = tile / ntn, tn = tile % ntn;
    LAS float* L = (LAS float*)lds + half * (64 * 65);
#pragma unroll
    for (int i = 0; i < 4; ++i) {
        const int kk = (tid >> 4) + 16 * i, c4 = (tid & 15) * 4;
        const f32x4 v = *(const f32x4*)(src + (size_t)(tk * 64 + kk) * N + tn * 64 + c4);
        L[kk * 65 + c4] = v[0]; L[kk * 65 + c4 + 1] = v[1]; L[kk * 65 + c4 + 2] = v[2]; L[kk * 65 + c4 + 3] = v[3];
    }
    __syncthreads();
    const int n = tid >> 2, ks = (tid & 3) * 16;
    int nn = tn * 64 + n;
    if (permmode == 1) { const int hN = N >> 1, b = nn >= hN, hc = b ? nn - hN : nn; nn = 256 * (hc >> 7) + 128 * b + (hc & 127); }
    else if (permmode == 2 && nn >= 512 && nn < 1280) {
        if (nn < 1024) { const int hd = (nn - 512) >> 6, d = nn & 63; nn = (2 + (hd >> 2)) * 256 + 128 * (d >> 5) + 32 * (hd & 3) + (d & 31); }
        else { const int hd = (nn - 1024) >> 6, d = nn & 63; nn = 1024 + 128 * (d >> 5) + 32 * hd + (d & 31); }
    }
    u32x4 o0, o1;
    o0.x = pk2(L[(ks + 0) * 65 + n], L[(ks + 1) * 65 + n]); o0.y = pk2(L[(ks + 2) * 65 + n], L[(ks + 3) * 65 + n]);
    o0.z = pk2(L[(ks + 4) * 65 + n], L[(ks + 5) * 65 + n]); o0.w = pk2(L[(ks + 6) * 65 + n], L[(ks + 7) * 65 + n]);
    o1.x = pk2(L[(ks + 8) * 65 + n], L[(ks + 9) * 65 + n]); o1.y = pk2(L[(ks + 10) * 65 + n], L[(ks + 11) * 65 + n]);
    o1.z = pk2(L[(ks + 12) * 65 + n], L[(ks + 13) * 65 + n]); o1.w = pk2(L[(ks + 14) * 65 + n], L[(ks + 15) * 65 + n]);
    bf16* d = dst + (size_t)nn * K + tk * 64 + ks;
    *(u32x4*)d = o0; *(u32x4*)(d + 8) = o1;
    __syncthreads();
}
constexpr int CV0 = 704, CV1 = 1408, CV2 = 1760, CV3 = 2112, CV4 = 2656, CV5 = 2720, CV6 = 2784, CV_TOTAL = 2912;
DI void conv_item(const Params& p, int l, int it, ldsp lds) {
    if (it < CV0) conv_tile(p.in[I_W13] + (size_t)(l * 2 + 0) * 1024 * 5632, (bf16*)(p.ws + O_W13), 1024, 5632, 1, it, lds);
    else if (it < CV1) conv_tile(p.in[I_W13] + (size_t)(l * 2 + 1) * 1024 * 5632, (bf16*)(p.ws + O_W13) + (size_t)5632 * 1024, 1024, 5632, 1, it - CV0, lds);
    else if (it < CV2) conv_tile(p.in[I_W2] + (size_t)(l * 2 + 0) * 2816 * 1024, (bf16*)(p.ws + O_W2), 2816, 1024, 0, it - CV1, lds);
    else if (it < CV3) conv_tile(p.in[I_W2] + (size_t)(l * 2 + 1) * 2816 * 1024, (bf16*)(p.ws + O_W2) + (size_t)1024 * 2816, 2816, 1024, 0, it - CV2, lds);
    else if (it < CV4) conv_tile(p.in[I_WIN] + (size_t)l * 1024 * INW, (bf16*)(p.ws + O_WIN), 1024, INW, 2, it - CV3, lds);
    else if (it < CV5) conv_tile(p.in[I_GLU] + (size_t)l * 256 * 2048, (bf16*)(p.ws + O_WGLU), 256, 2048, 1, it - CV4, lds);
    else if (it < CV6) conv_tile(p.in[I_AO] + (size_t)l * 512 * 1024, (bf16*)(p.ws + O_WAO), 512, 1024, 0, it - CV5, lds);
    else conv_tile(p.in[I_WO] + (size_t)l * 1024 * 1024, (bf16*)(p.ws + O_WOUT), 1024, 1024, 0, it - CV6, lds);
}
DI void mod_item(const Params& p, int it, ldsp lds) {
    const int tid = threadIdx.x, lane = tid & 63, w = tid >> 6;
    const int c0 = it * 256 + lane * 4, l = c0 / 9216, col = c0 % 9216;
    const float* W = p.in[I_MODW] + (size_t)l * 1024 * 9216 + col;
    f32x4 a0 = {0.f, 0.f, 0.f, 0.f}, a1 = {0.f, 0.f, 0.f, 0.f};
#pragma unroll 8
    for (int k = w * 128; k < w * 128 + 128; ++k) {
        const f32x4 wv = *(const f32x4*)(W + (size_t)k * 9216);
        const float c = p.in[I_C][k], cc = p.in[I_CCTX][k];
        const float s0 = c * sigmoidf_(c), s1 = cc * sigmoidf_(cc);
        a0 += wv * s0; a1 += wv * s1;
    }
    LAS f32x4* L = (LAS f32x4*)lds;
    L[(w * 64 + lane) * 2] = a0; L[(w * 64 + lane) * 2 + 1] = a1;
    __syncthreads();
    if (w == 0) {
        f32x4 b = *(const f32x4*)(p.in[I_MODB] + (size_t)l * 9216 + col);
        f32x4 r0 = b, r1 = b;
#pragma unroll
        for (int q = 0; q < 8; ++q) { r0 += L[(q * 64 + lane) * 2]; r1 += L[(q * 64 + lane) * 2 + 1]; }
        float* M = (float*)(p.ws + O_MODS);
        *(f32x4*)(M + (size_t)(0 * 2 + l) * 9216 + col) = r0;
        *(f32x4*)(M + (size_t)(1 * 2 + l) * 9216 + col) = r1;
    }
    __syncthreads();
}
DI void pw_item(const Params& p, int l, int it) {
    const int idx = it * 512 + threadIdx.x;
    if (idx >= 2048 * 33) return;
    const int st = idx / 33, e = idx % 33;
    const int dg = st >> 6;
    const double are = p.in[I_ARE][(size_t)l * 2048 + st], aim = p.in[I_AIM][(size_t)l * 2048 + st];
    const double dt = dexp((double)p.in[I_LOGDT][l * 32 + dg]);
    const double mag = dexp(are * dt * e);
    double s, c; dsincos(aim * dt * e, s, c);
    ((float2*)(p.ws + O_PW))[idx] = make_float2((float)(mag * c), (float)(mag * s));
    if (e == 1) {
        const double nr = mag * c - 1.0, ni = mag * s, den = are * are + aim * aim;
        ((float2*)(p.ws + O_CF))[st] = make_float2((float)((nr * are + ni * aim) / den), (float)((ni * are - nr * aim) / den));
    }
}
DI void wp_item(const Params& p, int l, int it) {
    const int k = it >> 1, n = (it & 1) * 512 + threadIdx.x, g = k >> 6, c = k & 63;
    const float* pw = p.in[I_POOLW] + (size_t)l * 4 * 64 * 64 + (size_t)(g * 64 + c) * 64;
    const float* ps = p.in[I_POOLS] + l * 256 + g * 64;
    const float* po = p.in[I_POOLO] + (size_t)l * 256 * 1024 + (size_t)(g * 64) * 1024 + n;
    float s = 0.f;
#pragma unroll 8
    for (int d = 0; d < 64; ++d) s += pw[d] * ps[d] * po[(size_t)d * 1024];
    ((bf16*)(p.ws + O_WP))[(size_t)n * 256 + k] = f2bf(s);
}
DI void rope_item(const Params& p, int it) {
    const int idx = it * 512 + threadIdx.x;
    const int pos = idx >> 4, i = idx & 15;
    const double inv = dexp(-(double)i * (9.210340371976184 / 16.0));
    double s, c; dsincos((double)pos * inv, s, c);
    ((float2*)(p.ws + O_ROPE))[idx] = make_float2((float)c, (float)s);
}
DI void ktab_item(const Params& p, int l, int it, ldsp lds) {
    const int tid = threadIdx.x & 255, half = threadIdx.x >> 8;
    const int lag = (it & 15) * 2 + half, dg = it >> 4;
    LAS f32x2* Wl = (LAS f32x2*)lds + half * 64;
    if (tid < 64) {
        const float2 z = ((const float2*)(p.ws + O_PW))[(size_t)(dg * 64 + tid) * 33 + lag], cf = ((const float2*)(p.ws + O_CF))[dg * 64 + tid];
        Wl[tid] = (f32x2){z.x * cf.x - z.y * cf.y, z.x * cf.y + z.y * cf.x};
    }
    __syncthreads();
    const int hp = tid >> 4, hh = tid & 15;
    const size_t pb = (size_t)(l * 32 + dg) * 1024;
    const float* cre = p.in[I_CRE] + pb + hp * 64, *cim = p.in[I_CIM] + pb + hp * 64;
    const float* bre = p.in[I_BRE] + pb + hh, *bim = p.in[I_BIM] + pb + hh;
    float s = 0.f;
#pragma unroll 8
    for (int q = 0; q < 64; ++q) {
        const f32x2 wv = Wl[q];
        const float br = bre[q * 16], bi = bim[q * 16];
        const float tr = wv.x * br - wv.y * bi, ti = wv.x * bi + wv.y * br;
        s += cre[q] * tr - cim[q] * ti;
    }
    ((float*)(p.ws + O_KTAB))[(size_t)(dg * 32 + lag) * 256 + tid] = s;
    __syncthreads();
}
DI void w1_item(const Params& p, int l, int it) {
    const int idx = it * 512 + threadIdx.x;
    const int k8 = idx & 63, n = (idx >> 6) & 255, g = idx >> 14;
    const int dir = n >> 7, ri = (n >> 6) & 1, pp = n & 63, j = k8 >> 1, h0 = (k8 & 1) * 8;
    const int e = dir ? j : 31 - j, st = (dir * 16 + g) * 64 + pp;
    const float2 z = ((const float2*)(p.ws + O_PW))[(size_t)st * 33 + e], cf = ((const float2*)(p.ws + O_CF))[st];
    const float wr = z.x * cf.x - z.y * cf.y, wi = z.x * cf.y + z.y * cf.x;
    const float* bre = p.in[I_BRE] + (size_t)(l * 32 + dir * 16 + g) * 1024 + pp * 16 + h0;
    const float* bim = p.in[I_BIM] + (size_t)(l * 32 + dir * 16 + g) * 1024 + pp * 16 + h0;
    float o[8];
#pragma unroll
    for (int q = 0; q < 8; ++q) o[q] = ri ? (wr * bim[q] + wi * bre[q]) : (wr * bre[q] - wi * bim[q]);
    u32x4 v; v.x = pk2(o[0], o[1]); v.y = pk2(o[2], o[3]); v.z = pk2(o[4], o[5]); v.w = pk2(o[6], o[7]);
    *(u32x4*)((bf16*)(p.ws + O_W1S) + ((size_t)g * 256 + n) * 512 + k8 * 8) = v;
}
DI void w3_item(const Params& p, int l, int it) {
    const int idx = it * 512 + threadIdx.x;
    const int k8 = idx & 31, n = (idx >> 5) & 511, g = idx >> 14;
    const int dir = k8 >> 4, ri = (k8 >> 3) & 1, p0 = (k8 & 7) * 8, j = n >> 4, hp = n & 15;
    const int e = dir ? 32 - j : j + 1;
    const float* cre = p.in[I_CRE] + (size_t)(l * 32 + dir * 16 + g) * 1024 + hp * 64 + p0;
    const float* cim = p.in[I_CIM] + (size_t)(l * 32 + dir * 16 + g) * 1024 + hp * 64 + p0;
    const float2* pw = (const float2*)(p.ws + O_PW) + (size_t)((dir * 16 + g) * 64 + p0) * 33 + e;
    float o[8];
#pragma unroll
    for (int q = 0; q < 8; ++q) { const float2 z = pw[q * 33]; o[q] = ri ? -(cre[q] * z.y + cim[q] * z.x) : (cre[q] * z.x - cim[q] * z.y); }
    u32x4 v; v.x = pk2(o[0], o[1]); v.y = pk2(o[2], o[3]); v.z = pk2(o[4], o[5]); v.w = pk2(o[6], o[7]);
    *(u32x4*)((bf16*)(p.ws + O_W3S) + ((size_t)g * 512 + n) * 256 + k8 * 8) = v;
}
DI void toep_item(const Params& p, int l, int it) {
    const int idx = it * 512 + threadIdx.x;
    const int k8 = idx & 63, n = (idx >> 6) & 511, g = idx >> 15;
    const int j2 = k8 >> 1, h0 = (k8 & 1) * 8, j = n >> 4, hp = n & 15;
    const float* KT = (const float*)(p.ws + O_KTAB);
    float o[8];
#pragma unroll
    for (int q = 0; q < 8; ++q) o[q] = 0.f;
    if (j2 <= j) { const float* kf = KT + ((size_t)(0 * 16 + g) * 32 + (j - j2)) * 256 + hp * 16 + h0;
#pragma unroll
        for (int q = 0; q < 8; ++q) o[q] += kf[q]; }
    if (j2 >= j) { const float* kb = KT + ((size_t)(1 * 16 + g) * 32 + (j2 - j)) * 256 + hp * 16 + h0;
#pragma unroll
        for (int q = 0; q < 8; ++q) o[q] += kb[q]; }
    if (j2 == j) {
        const float dd = p.in[I_SD][l * 256 + g * 16 + hp];
#pragma unroll
        for (int q = 0; q < 8; ++q) if (h0 + q == hp) o[q] += dd;
    }
    u32x4 v; v.x = pk2(o[0], o[1]); v.y = pk2(o[2], o[3]); v.z = pk2(o[4], o[5]); v.w = pk2(o[6], o[7]);
    *(u32x4*)((bf16*)(p.ws + O_TOEP) + ((size_t)g * 512 + n) * 512 + k8 * 8) = v;
}

constexpr int PH_PER_LAYER = 14, N_PHASES = 2 * PH_PER_LAYER + 1;
#define SUBLOOP(n, call) { for (int it = ((b - off) % G + G) % G; it < (n); it += G) { call; } off = (off + (n)) % G; }
DI void run_phase(const Params& p, const int ph, ldsp lds) {
    const int G = gridDim.x, b = blockIdx.x;
    if (ph == 2 * PH_PER_LAYER) { for (int it = b; it < NL / 8; it += G) final_norm_item(p, it); return; }
    const int l = ph / PH_PER_LAYER, s = ph % PH_PER_LAYER;
    const int mtiles = (l == 1) ? 64 : 65;
    const bf16* HID = (const bf16*)(p.ws + O_BIG);
    const bf16* W2 = (const bf16*)(p.ws + O_W2);
    int off = 0;
#ifdef ONLY_S
    if (s != ONLY_S) return;
#endif
    switch (s) {
    case 0: {
        if (l == 0 && G == 256) {
            if (b < 72) {
                mod_item(p, b, lds);
                for (int it = b; it < 132; it += 72) pw_item(p, l, it);
                if (b < 8) rope_item(p, b);
                for (int it = b; it < CV_TOTAL; it += 72 * 6) conv_item(p, l, it, lds);
            } else {
                for (int it = b - 72; it < 512; it += 184) wp_item(p, l, it);
                for (int it = b - 72; it < CV_TOTAL; it += 184) { if ((it % (72 * 6)) < 72) continue; conv_item(p, l, it, lds); }
            }
        } else {
            SUBLOOP(((l == 0) ? 72 : 0), mod_item(p, it, lds))
            SUBLOOP(132, pw_item(p, l, it))
            SUBLOOP(512, wp_item(p, l, it))
            SUBLOOP(((l == 0) ? 8 : 0), rope_item(p, it))
            SUBLOOP(CV_TOTAL, conv_item(p, l, it, lds))
        }
    } break;
    case 1: if (l == 0) { SUBLOOP(NT / 8, norm_item(p, l, 0, it)) } break;
    case 2: {
        big_ffn_a(p, 0, NT, lds);
        const int busy = 65 * 22 - 5 * G;
        if (G == 256 && b >= busy) for (int it = b - busy; it < 512; it += G - busy) ktab_item(p, l, it, lds);
        else if (G != 256) { SUBLOOP(512, ktab_item(p, l, it, lds)) }
    } break;
    case 3: big_resid(p, HID, W2, DFF, l, 2, 0.5f, l == 0, true, 0, l, 1, false, lds); break;
    case 4: break;
    case 5: {
        big_inproj(p, l, lds);
        const int busy = 65 * 17 - 4 * G;
        if (G == 256 && b >= busy) {
            const int nb = G - busy;
            for (int it = b - busy; it < 2048; it += nb) { if (it < 512) w1_item(p, l, it); else if (it < 1024) w3_item(p, l, it - 512); else toep_item(p, l, it - 1024); }
        } else if (G != 256) { SUBLOOP(512, w1_item(p, l, it)) SUBLOOP(512, w3_item(p, l, it)) SUBLOOP(1024, toep_item(p, l, it)) }
    } break;
    case 6: {
        unsigned* cw = (unsigned*)(p.ws + O_BAR);
        unsigned* c1 = cw + XB_CNT(2 * l), *c2 = cw + XB_CNT(2 * l + 1);
        if (b < 48) { s1_item(p, b, lds); signal_count(c1); }
        else if (b < 52) { wait_count(c1, 48u); s2_item(p, b - 48); signal_count(c2); }
        off = 52;
        SUBLOOP(mtiles * 4, pool_item(p, it))
        SUBLOOP(((l == 0) ? 8 : 0), attn_dispatch(p, l, 64, it, lds))
        SUBLOOP(512, attn_dispatch(p, l, it >> 3, it & 7, lds))
        wait_count(c2, 4u);
        for (int it = G - 1 - b; it < 96; it += G) s3_item(p, it, lds);
    } break;
    case 7: break;
    case 8: break;
    case 9: big_mix1(p, mtiles * 256, lds); break;
    case 10: big_resid(p, (const bf16*)(p.ws + O_H), (const bf16*)(p.ws + O_WOUT), D, l, 5, 1.0f, false, l == 0, 1, l, 2, false, lds); break;
    case 11: break;
    case 12: big_ffn_a(p, 1, mtiles * 256, lds); break;
    case 13: big_resid(p, HID, W2 + (size_t)1024 * DFF, DFF, l, 8, 0.5f, false, l == 0, 2, l + 1, 0, l == 1, lds); break;
    }
}

__global__ void __launch_bounds__(512, 2) hybrid_fwd(Params p, int ph_lo, int ph_hi) {
    __shared__ __attribute__((aligned(16))) char lds_raw[LDS_BYTES];
    ldsp lds = (ldsp)lds_raw;
    __shared__ uint4 xb_words;
    if (p.ws == nullptr) cg::this_grid().sync();
    XcdBarrier bar;
    const bool multi = (ph_hi - ph_lo) > 1;
    if (multi) {
        if (threadIdx.x == 0) xb_words = make_uint4(0u, 0u, 0u, 0u);
        __syncthreads();
        bar = xcd_barrier_post((unsigned*)(p.ws + O_BAR), (volatile LAS unsigned*)&xb_words);
    }
#define PH(k) if (ph_lo <= (k) && (k) < ph_hi) { if ((k) > ph_lo) xcd_barrier(bar); run_phase(p, (k), lds); }
    PH(0) PH(1) PH(2) PH(3) PH(5) PH(6) PH(9) PH(10) PH(12) PH(13)
    PH(14) PH(16) PH(17) PH(19) PH(20) PH(23) PH(24) PH(26) PH(27)
}

extern "C" void kernel_launch(void* const* d_in, const int* in_sizes, int n_in, void* d_out, int out_size, void* d_ws, size_t ws_size, hipStream_t stream) {
    (void)in_sizes; (void)n_in; (void)out_size;
    if (ws_size < O_END) { fprintf(stderr, "workspace too small: %zu < %zu\n", ws_size, (size_t)O_END); return; }
    static int grid_blocks = 0;
    if (!grid_blocks) {
        int dev = 0, cus = 0, per_cu = 0;
        (void)hipGetDevice(&dev);
        (void)hipDeviceGetAttribute(&cus, hipDeviceAttributeMultiprocessorCount, dev);
        (void)hipOccupancyMaxActiveBlocksPerMultiprocessor(&per_cu, hybrid_fwd, 512, 0);
        if (per_cu > 1) per_cu = 1;
        if (per_cu < 1) per_cu = 1;
        grid_blocks = cus * per_cu;
    }
    Params p{};
    for (int i = 0; i < 27; ++i) p.in[i] = (const float*)d_in[i];
    p.out = (float*)d_out; p.ws = (char*)d_ws;
#if MK_ONE_LAUNCH
    (void)hipMemsetAsync(d_ws, 0, 32768, stream);
    int lo = 0, hi = N_PHASES;
    void* args[] = {&p, &lo, &hi};
    hipError_t e = hipLaunchCooperativeKernel((void*)hybrid_fwd, dim3(grid_blocks), dim3(512), args, 0, stream);
    if (e != hipSuccess) fprintf(stderr, "cooperative launch failed: %s (grid %d)\n", hipGetErrorString(e), grid_blocks);
#else
    for (int ph = 0; ph < N_PHASES; ++ph) hipLaunchKernelGGL(hybrid_fwd, dim3(grid_blocks), dim3(512), 0, stream, p, ph, ph + 1);
#endif
}
```

```cpp
#include <hip/hip_runtime.h>
#include <hip/hip_cooperative_groups.h>
#include <cstdio>
#include <cstdint>
namespace cg = cooperative_groups;

#define DI __device__ __forceinline__
#define LAS __attribute__((address_space(3)))
typedef __attribute__((address_space(3))) char* ldsp;
typedef const __attribute__((address_space(3))) char* cldsp;
typedef unsigned short bf16;
typedef short bf16x8 __attribute__((ext_vector_type(8)));
typedef float f32x16 __attribute__((ext_vector_type(16)));
typedef float f32x4 __attribute__((ext_vector_type(4)));
typedef float f32x2 __attribute__((ext_vector_type(2)));
typedef unsigned u32x4 __attribute__((ext_vector_type(4)));
typedef unsigned u32x2 __attribute__((ext_vector_type(2)));
typedef __bf16 hbf2 __attribute__((ext_vector_type(2)));

#ifndef MK_ONE_LAUNCH
#define MK_ONE_LAUNCH 1
#endif

constexpr int D = 1024, NL = 16384, NC = 256, NT = NL + NC, DFF = 2816, INW = 4352;
constexpr int NCH = NT / 32;

enum { I_X = 0, I_C, I_CTX, I_CCTX, I_MODW, I_MODB, I_NORMG, I_W13, I_W2, I_WIN, I_POOLW, I_POOLS, I_POOLO, I_ARE, I_AIM, I_LOGDT,
       I_BRE, I_BIM, I_CRE, I_CIM, I_SD, I_GLU, I_QG, I_KG, I_AO, I_WO, I_FG };

constexpr size_t al(size_t x) { return (x + 255) & ~(size_t)255; }
constexpr size_t O_BAR = 0;
constexpr size_t O_X = 32768;
constexpr size_t O_H = O_X + al((size_t)NT * D * 4);
constexpr size_t O_BIG = O_H + al((size_t)NT * D * 2);
constexpr size_t O_Q = O_BIG + al((size_t)NT * 3072 * 2);
constexpr size_t O_K = O_Q + al((size_t)NT * 512 * 2);
constexpr size_t O_VT = O_K + al((size_t)NT * 128 * 2);
constexpr size_t O_A = O_VT + al((size_t)NT * 128 * 2);
constexpr size_t O_S = O_A + al((size_t)NT * 256 * 2);
constexpr size_t O_YP = O_S + al((size_t)NT * 256 * 2);
constexpr size_t O_YS = O_YP + al((size_t)NT * 256 * 2);
constexpr size_t O_CARRY = O_YS + al((size_t)NT * 256 * 2);
constexpr size_t O_E = O_CARRY + al((size_t)NCH * 16 * 256 * 2);
constexpr size_t O_W13 = O_E + al((size_t)NCH * 16 * 256 * 4);
constexpr size_t O_W2 = O_W13 + al((size_t)2 * 5632 * 1024 * 2);
constexpr size_t O_WIN = O_W2 + al((size_t)2 * 1024 * 2816 * 2);
constexpr size_t O_WGLU = O_WIN + al((size_t)INW * 1024 * 2);
constexpr size_t O_WAO = O_WGLU + al((size_t)2048 * 256 * 2);
constexpr size_t O_WOUT = O_WAO + al((size_t)1024 * 512 * 2);
constexpr size_t O_WP = O_WOUT + al((size_t)1024 * 1024 * 2);
constexpr size_t O_TOEP = O_WP + al((size_t)1024 * 256 * 2);
constexpr size_t O_W1S = O_TOEP + al((size_t)16 * 512 * 512 * 2);
constexpr size_t O_W3S = O_W1S + al((size_t)16 * 256 * 512 * 2);
constexpr size_t O_KTAB = O_W3S + al((size_t)16 * 512 * 256 * 2);
constexpr size_t O_PW = O_KTAB + al((size_t)2 * 16 * 32 * 256 * 4);
constexpr size_t O_CF = O_PW + al((size_t)2048 * 33 * 8);
constexpr size_t O_MODS = O_CF + al((size_t)2048 * 8);
constexpr size_t O_ROPE = O_MODS + al((size_t)2 * 2 * 9216 * 4);
constexpr size_t O_END = O_ROPE + al((size_t)256 * 16 * 8);

struct Params { const float* in[27]; float* out; char* ws; };

DI unsigned pk2(float a, float b) { f32x2 v = {a, b}; return __builtin_bit_cast(unsigned, __builtin_convertvector(v, hbf2)); }
DI bf16 f2bf(float a) { return (bf16)(pk2(a, 0.f) & 0xffffu); }
DI float bf2f(bf16 b) { return __uint_as_float(((unsigned)b) << 16); }
DI float bflo(unsigned u) { return __uint_as_float(u << 16); }
DI float bfhi(unsigned u) { return __uint_as_float(u & 0xffff0000u); }
DI float sigmoidf_(float x) { return __builtin_amdgcn_rcpf(1.f + __builtin_amdgcn_exp2f(-1.4426950408889634f * x)); }
DI float wave_sum(float v) {
#pragma unroll
    for (int o = 32; o >= 1; o >>= 1) v += __shfl_xor(v, o);
    return v;
}
#define AT(T, base, idx) (*(T*)((char*)(base) + (unsigned)((unsigned)(idx) * (unsigned)sizeof(T))))
#define MFMA(a, b, c) __builtin_amdgcn_mfma_f32_32x32x16_bf16((a), (b), (c), 0, 0, 0)

DI double dexp(double x) {
    const double n = __builtin_rint(x * 1.4426950408889634);
    const double r = x - n * 0.6931471805599453;
    double t = 1.0;
#pragma unroll
    for (int k = 16; k >= 1; --k) t = 1.0 + t * r * (1.0 / (double)k);
    const long long e = (long long)n + 1023;
    return t * __longlong_as_double(e << 52);
}
DI void dsincos(double th, double& s, double& c) {
    const double k = __builtin_rint(th * 0.15915494309189535);
    const double x = th - k * 6.283185307179586 - k * 2.4492935982947064e-16;
    const double x2 = x * x;
    double cs = 1.0, sn = 1.0;
#pragma unroll
    for (int j = 17; j >= 1; --j) {
        cs = 1.0 - cs * x2 * (1.0 / (double)((2 * j - 1) * (2 * j)));
        sn = 1.0 - sn * x2 * (1.0 / (double)((2 * j) * (2 * j + 1)));
    }
    c = cs; s = sn * x;
}

#define XB_TMO      128
#define XB_XCNT(j)  (256  + 64 * (j))
#define XB_XSUB(j)  (1280 + 64 * (j))
#define XB_XGEN(j)  (2304 + 64 * (j))
#define XB_TOP      3328
#define XB_TOPGEN   3392
#define XCD_BAR_WORDS 3456
#define XB_SPIN_CAP (1u << 22)
DI unsigned xb_ld(unsigned* p)              { return __hip_atomic_load(p, __ATOMIC_RELAXED, __HIP_MEMORY_SCOPE_AGENT); }
DI unsigned xb_add(unsigned* p, unsigned v) { return __hip_atomic_fetch_add(p, v, __ATOMIC_RELAXED, __HIP_MEMORY_SCOPE_AGENT); }
DI unsigned xb_xcc_id() { return (unsigned)__builtin_amdgcn_s_getreg((3 << 11) | 20) & 0xFu; }
#define XB_SPIN(cond, bar) do { unsigned _sp = 0; while (cond) { __builtin_amdgcn_s_sleep(1); \
    if ((++_sp & 255u) == 0u) { if (xb_ld(&(bar)[XB_TMO])) break; if (_sp > XB_SPIN_CAP) { atomicAdd(&(bar)[XB_TMO], 1u); break; } } } } while (0)
struct XcdBarrier { unsigned* bar; unsigned x; volatile LAS unsigned* st; };
DI XcdBarrier xcd_barrier_post(unsigned* bar, volatile LAS unsigned* st) {
    XcdBarrier b; b.bar = bar; b.x = xb_xcc_id(); b.st = st;
    if (threadIdx.x == 0) (void)xb_add(&bar[XB_XCNT(b.x)], 1u);
    return b;
}
DI void xcd_barrier_complete(unsigned* bar, unsigned x, unsigned& nloc, unsigned& nx) {
    const unsigned G = gridDim.x * gridDim.y * gridDim.z;
    unsigned sum, cnt, mine, sp = 0u;
    for (;;) {
        sum = 0u; cnt = 0u; mine = 0u;
#pragma unroll
        for (unsigned j = 0; j < 16; ++j) { const unsigned c = xb_ld(&bar[XB_XCNT(j)]); sum += c; cnt += (c > 0u) ? 1u : 0u; mine = (j == x) ? c : mine; }
        if (sum == G) break;
        __builtin_amdgcn_s_sleep(1);
        if ((++sp & 255u) == 0u) { if (xb_ld(&bar[XB_TMO])) break; if (sp > XB_SPIN_CAP) { atomicAdd(&bar[XB_TMO], 1u); break; } }
    }
    nloc = mine > 0u ? mine : 1u; nx = cnt > 0u ? cnt : 1u;
}
DI void xcd_barrier(const XcdBarrier& b) {
    asm volatile("s_waitcnt vmcnt(0)" ::: "memory");
    __syncthreads();
    if (threadIdx.x == 0) {
        unsigned* bar = b.bar;
        __builtin_amdgcn_s_waitcnt(0);
        unsigned nloc = b.st[0], nx = b.st[1];
        if (nloc == 0u) { xcd_barrier_complete(bar, b.x, nloc, nx); b.st[0] = nloc; b.st[1] = nx; }
        const unsigned old = xb_add(&bar[XB_XSUB(b.x)], 1u);
        const unsigned gen = old / nloc;
        if (old + 1u == (gen + 1u) * nloc) {
            __builtin_amdgcn_fence(__ATOMIC_RELEASE, "agent");
            asm volatile("s_waitcnt vmcnt(0)" ::: "memory");
            const unsigned og = xb_add(&bar[XB_TOP], 1u);
            const unsigned tg = og / nx;
            if (og + 1u == (tg + 1u) * nx) xb_add(&bar[XB_TOPGEN], 1u);
            else XB_SPIN(xb_ld(&bar[XB_TOPGEN]) == tg, bar);
            __builtin_amdgcn_fence(__ATOMIC_ACQUIRE, "agent");
            xb_add(&bar[XB_XGEN(b.x)], 1u);
            asm volatile("s_waitcnt vmcnt(0)" ::: "memory");
        } else {
            XB_SPIN(xb_ld(&bar[XB_XGEN(b.x)]) == gen, bar);
            __builtin_amdgcn_fence(__ATOMIC_ACQUIRE, "agent");
            asm volatile("s_waitcnt vmcnt(0)" ::: "memory");
        }
    }
    __syncthreads();
}


#define XB_CNT(k) (3584 + 64 * (k))
DI void signal_count(unsigned* w) {
    asm volatile("s_waitcnt vmcnt(0)" ::: "memory");
    __syncthreads();
    if (threadIdx.x == 0) { __builtin_amdgcn_fence(__ATOMIC_RELEASE, "agent"); asm volatile("s_waitcnt vmcnt(0)" ::: "memory"); (void)xb_add(w, 1u); }
}
DI void wait_count(unsigned* w, unsigned target) {
    if (threadIdx.x == 0) {
        unsigned sp = 0;
        while (xb_ld(w) < target) { __builtin_amdgcn_s_sleep(4); if (++sp > (1u << 24)) break; }
        __builtin_amdgcn_fence(__ATOMIC_ACQUIRE, "agent");
        asm volatile("s_waitcnt vmcnt(0)" ::: "memory");
    }
    __syncthreads();
}

constexpr int LROW = 144;
constexpr int LTILE = 256 * LROW;
constexpr int LSTAGE = 2 * LTILE;
constexpr int LDS_BYTES = 2 * LSTAGE;

template <int AMODE, int NRB, int NCB>
DI void gemm_acc(f32x16 (&acc)[NRB][NCB], const bf16* __restrict__ A, const long lda, const int arow0,
                 const bf16* __restrict__ Bt, const long ldb, const int brow0, const int K, ldsp lds) {
    int tid_ = threadIdx.x; asm volatile("" : "+v"(tid_));
    const int tid = tid_, lane = tid & 63, w = tid >> 6, wm = w >> 2, wn = w & 3, r = lane & 31, h = lane >> 5;
    const int v = tid & 7, lr = tid >> 3;
    const int avoff = AMODE ? ((v >> 1) * 256 + (v & 1) * 8) : v * 8;
    const int akstep = AMODE ? 1024 : 64;
    const bf16* ag = A + (long)(arow0 + lr) * lda + avoff;
    const bf16* bg = Bt + (long)(brow0 + lr) * ldb + v * 8;
    const int nk = K >> 6;
    u32x4 ra[NRB], rb[2 * NCB];
#pragma unroll
    for (int i = 0; i < NRB; ++i) ra[i] = *(const u32x4*)(ag + (long)i * 64 * lda);
#pragma unroll
    for (int i = 0; i < 2 * NCB; ++i) rb[i] = *(const u32x4*)(bg + (long)i * 64 * ldb);
    ldsp wr = lds + lr * LROW + v * 16;
#pragma unroll
    for (int i = 0; i < NRB; ++i) *(LAS u32x4*)(wr + i * 64 * LROW) = ra[i];
#pragma unroll
    for (int i = 0; i < 2 * NCB; ++i) *(LAS u32x4*)(wr + LTILE + i * 64 * LROW) = rb[i];
    __syncthreads();
    cldsp la = lds + (wm * 32 * NRB + r) * LROW + h * 16;
    cldsp lb = lds + LTILE + (wn * 32 * NCB + r) * LROW + h * 16;
    for (int kt = 0; kt < nk; ++kt) {
        const int buf = kt & 1;
        const bool more = (kt + 1 < nk);
        if (more) {
            ag += akstep; bg += 64;
#pragma unroll
            for (int i = 0; i < NRB; ++i) ra[i] = *(const u32x4*)(ag + (long)i * 64 * lda);
#pragma unroll
            for (int i = 0; i < 2 * NCB; ++i) rb[i] = *(const u32x4*)(bg + (long)i * 64 * ldb);
        }
        __builtin_amdgcn_sched_barrier(0);
        cldsp pa = la + buf * LSTAGE; cldsp pb = lb + buf * LSTAGE;
#pragma unroll
        for (int s = 0; s < 4; ++s) {
            bf16x8 af[NRB], bfr[NCB];
#pragma unroll
            for (int rb_ = 0; rb_ < NRB; ++rb_) af[rb_] = *(const LAS bf16x8*)(pa + rb_ * 32 * LROW + s * 32);
#pragma unroll
            for (int cb = 0; cb < NCB; ++cb) bfr[cb] = *(const LAS bf16x8*)(pb + cb * 32 * LROW + s * 32);
#pragma unroll
            for (int rb_ = 0; rb_ < NRB; ++rb_)
#pragma unroll
                for (int cb = 0; cb < NCB; ++cb) acc[rb_][cb] = MFMA(af[rb_], bfr[cb], acc[rb_][cb]);
        }
        __builtin_amdgcn_sched_barrier(0);
        if (more) {
            ldsp w2 = wr + (buf ^ 1) * LSTAGE;
#pragma unroll
            for (int i = 0; i < NRB; ++i) *(LAS u32x4*)(w2 + i * 64 * LROW) = ra[i];
#pragma unroll
            for (int i = 0; i < 2 * NCB; ++i) *(LAS u32x4*)(w2 + LTILE + i * 64 * LROW) = rb[i];
        }
        __syncthreads();
    }
}
template <int NRB, int NCB>
DI void zero_acc(f32x16 (&acc)[NRB][NCB]) {
#pragma unroll
    for (int a = 0; a < NRB; ++a)
#pragma unroll
        for (int b = 0; b < NCB; ++b)
#pragma unroll
            for (int i = 0; i < 16; ++i) acc[a][b][i] = 0.f;
}
#define ACC_ROW(rb, i) (wm * 128 + (rb) * 32 + ((i) & 3) + 8 * ((i) >> 2) + 4 * h)
#define ACC_COL(cb) (wn * 64 + (cb) * 32 + r)
#define TID_VARS int tid_ = threadIdx.x; asm volatile("" : "+v"(tid_)); const int tid = tid_, lane = tid & 63, w = tid >> 6, wm = w >> 2, wn = w & 3, r = lane & 31, h = lane >> 5; (void)wm; (void)wn; (void)r; (void)h; (void)lane; (void)w;

DI const float* mods_ptr(const Params& p, int cond, int l, int j) { return (const float*)(p.ws + O_MODS) + ((size_t)(cond * 2 + l) * 9 + j) * 1024; }


namespace pg8 {
#define PG8_LAS __attribute__((address_space(3)))
typedef unsigned short bf16_t;
typedef short bf16x8 __attribute__((ext_vector_type(8)));
typedef float f32x4 __attribute__((ext_vector_type(4)));
typedef unsigned u32x4 __attribute__((ext_vector_type(4)));
constexpr int BM = 256, BK = 64, HALF = 128, HTB = HALF * BK * 2  , STAGE_BYTES = 8 * HTB, NXCD = 8, WGM = 8;

__host__ __device__ __forceinline__ int lds_byte(int r, int c) { const int st = (r >> 4) * 2 + (c >> 5), rr = r & 15, cc = c & 31, ob = rr * 64 + cc * 2; return st * 1024 + (ob ^ (((ob >> 9) & 1) << 5)); }
__host__ __device__ __forceinline__ void stage_rc(int b, int& R, int& C) { const int st = b / 1024, sb = b % 1024, swz = sb ^ (((sb >> 9) & 1) << 5); R = (st >> 1) * 16 + swz / 64; C = (st & 1) * 32 + (swz % 64) / 2; }
__host__ __device__ __forceinline__ int perm32(int rho) { const int n = rho >> 4, i = rho & 15; return 8 * (i >> 2) + 4 * n + (i & 3); }

struct Unit { int pm, pn; };
struct Gemm { const bf16_t* A; const bf16_t* Bt; int K, ld; };

struct StaticOrder {
    int nM, nN, nwg, G, c;
    __host__ __device__ void init(int M, int N, int G_, int c_) { nM = M / BM; nN = N / BM; nwg = nM * nN; G = G_; c = c_; }
    __host__ __device__ bool next(int i, Unit& u) const {
        const long L = (long)i * G + c; if (L >= nwg) return false;
        int wgid = (int)L; { const int q = nwg / NXCD, r = nwg % NXCD, xcd = wgid % NXCD, off = wgid / NXCD; wgid = (xcd < r ? xcd * (q + 1) : r * (q + 1) + (xcd - r) * q) + off; }
        const int nig = WGM * nN, gid = wgid / nig, fm = gid * WGM, gsz = (nM - fm) < WGM ? (nM - fm) : WGM;
        u.pm = fm + ((wgid % nig) % gsz); u.pn = (wgid % nig) / gsz; return true;
    }
    __device__ __forceinline__ void a_ready(const Unit&) const {}
    __device__ __forceinline__ void done(const Unit&) const {}
};

template <class Epi, class Sched, bool ALIGN_EPI = false, bool SP2 = false>
__device__ __forceinline__ void gemm_phase(PG8_LAS unsigned char* lds, const Gemm g, const Sched& S, const Epi& E) {
    int tid_ = threadIdx.x; asm volatile("" : "+v"(tid_));
    const int tid = tid_, wid = __builtin_amdgcn_readfirstlane(tid >> 6), lane = tid & 63, wr = wid >> 2, wc = wid & 3, fr = lane & 15, fq = lane >> 4;
    int K_ = g.K; asm volatile("" : "+s"(K_));
    const int K = K_, nt = K / BK;
    unsigned voffA[2], voffB[2];
#pragma unroll
    for (int i = 0; i < 2; ++i) { int R, C; stage_rc(tid * 16 + i * 8192, R, C); const int Rb = Epi::PERM ? ((R & ~31) + perm32(R & 31)) : R;
        voffA[i] = (unsigned)(R * g.ld + C) * 2u; voffB[i] = (unsigned)(Rb * g.ld + C) * 2u; }
    const size_t kstep = (size_t)(BK * 2);
    const size_t hstep = (size_t)HALF * g.ld * 2;
    const size_t tstep = 2 * hstep;
    const unsigned ldsw = (unsigned)wid * 1024u;
    const int aoff = lds_byte(wr * 64 + fr, fq * 8), boff = lds_byte(wc * 32 + fr, fq * 8);
#define PG8_SA(b, h) (((b) * 2 + (h)) * HTB)
#define PG8_SB(b, h) ((4 + (b) * 2 + (h)) * HTB)
#define PG8_STAGE(bufoff, gbase, voff) do { _Pragma("unroll") for (int _i = 0; _i < 2; ++_i) \
        __builtin_amdgcn_global_load_lds((const unsigned*)((const char*)(gbase) + (voff)[_i]), (PG8_LAS unsigned*)(lds + (bufoff) + ldsw + _i * 8192), 16, 0, 0); } while (0)
#define PG8_LDA(dst, b, h) do { _Pragma("unroll") for (int m = 0; m < 4; ++m) _Pragma("unroll") for (int k = 0; k < 2; ++k) dst[m][k] = *(const PG8_LAS bf16x8*)(lds + PG8_SA(b, h) + aoff + m * 2048 + k * 1024); } while (0)
#define PG8_LDB(dst, b, h) do { _Pragma("unroll") for (int n = 0; n < 2; ++n) _Pragma("unroll") for (int k = 0; k < 2; ++k) dst[n][k] = *(const PG8_LAS bf16x8*)(lds + PG8_SB(b, h) + boff + n * 2048 + k * 1024); } while (0)
#define PG8_MMA(ai, bj, At, Bt) do { __builtin_amdgcn_s_setprio(1); _Pragma("unroll") for (int m = 0; m < 4; ++m) _Pragma("unroll") for (int n = 0; n < 2; ++n) _Pragma("unroll") for (int k = 0; k < 2; ++k) \
        acc[ai][bj][m][n] = __builtin_amdgcn_mfma_f32_16x16x32_bf16(Bt[n][k], At[m][k], acc[ai][bj][m][n], 0, 0, 0); __builtin_amdgcn_s_setprio(0); } while (0)
#define PG8_WAIT_V(n) asm volatile("s_waitcnt vmcnt(" #n ")" ::: "memory")
#define PG8_WAIT_L(n) asm volatile("s_waitcnt lgkmcnt(" #n ")" ::: "memory")
#define PG8_BAR __builtin_amdgcn_s_barrier()
#define PG8_SCHED __builtin_amdgcn_sched_barrier(0)
    Unit cur, nxt; int ui = 0;
    if (!S.next(0, cur)) return;
    f32x4 acc[2][2][4][2];
#pragma unroll
    for (int a = 0; a < 2; ++a)
#pragma unroll
        for (int b = 0; b < 2; ++b)
#pragma unroll
            for (int m = 0; m < 4; ++m)
#pragma unroll
                for (int n = 0; n < 2; ++n) acc[a][b][m][n] = (f32x4){0.f, 0.f, 0.f, 0.f};
    bf16x8 At[4][2], B0[2][2], B1[2][2];
    const char* cA = (const char*)g.A + (size_t)cur.pm * tstep; const char* cB = (const char*)g.Bt + (size_t)cur.pn * tstep;
    S.a_ready(cur);
    if constexpr (SP2) {
        PG8_STAGE(PG8_SB(0, 0), cB, voffB); PG8_STAGE(PG8_SB(0, 1), cB + hstep, voffB); PG8_STAGE(PG8_SA(0, 0), cA, voffA); PG8_STAGE(PG8_SA(0, 1), cA + hstep, voffA);
        if (wr == 1) PG8_BAR;
        PG8_WAIT_V(2); PG8_BAR;
        PG8_STAGE(PG8_SB(1, 0), cB + kstep, voffB); PG8_STAGE(PG8_SA(1, 0), cA + kstep, voffA); PG8_STAGE(PG8_SB(1, 1), cB + hstep + kstep, voffB);
        PG8_WAIT_V(6); PG8_BAR;
    } else {
        PG8_STAGE(PG8_SB(0, 0), cB, voffB); PG8_STAGE(PG8_SA(0, 0), cA, voffA); PG8_STAGE(PG8_SB(0, 1), cB + hstep, voffB); PG8_STAGE(PG8_SA(0, 1), cA + hstep, voffA);
        if (wr == 1) PG8_BAR;
        PG8_WAIT_V(4); PG8_BAR;
        PG8_STAGE(PG8_SB(1, 0), cB + kstep, voffB); PG8_STAGE(PG8_SA(1, 0), cA + kstep, voffA); PG8_STAGE(PG8_SB(1, 1), cB + hstep + kstep, voffB);
        PG8_WAIT_V(6); PG8_BAR;
    }
    for (;;) {
        const bool has_next = S.next(ui + 1, nxt);
        const char* nA = has_next ? (const char*)g.A + (size_t)nxt.pm * tstep : cA; const char* nB = has_next ? (const char*)g.Bt + (size_t)nxt.pn * tstep : cB;
        for (int t = 0; t < nt; t += 2) {
            const bool last = (t == nt - 2);
            const char* a1 = cA + (size_t)(t + 1) * kstep;
            const char* a2 = last ? nA : cA + (size_t)(t + 2) * kstep; const char* b2 = last ? nB : cB + (size_t)(t + 2) * kstep;
            const char* a3 = a2 + kstep; const char* b3 = b2 + kstep;
            if (last && has_next) S.a_ready(nxt);
            if constexpr (SP2) {
            PG8_LDB(B0, 0, 0); PG8_LDB(B1, 0, 1); PG8_SCHED; PG8_LDA(At, 0, 0); PG8_STAGE(PG8_SA(1, 1), a1 + hstep, voffA);
            PG8_WAIT_V(8); PG8_WAIT_L(0); PG8_BAR; PG8_MMA(0, 0, At, B0); PG8_MMA(0, 1, At, B1); PG8_BAR; PG8_SCHED;
            PG8_LDA(At, 0, 1); PG8_STAGE(PG8_SB(0, 0), b2, voffB); PG8_STAGE(PG8_SB(0, 1), b2 + hstep, voffB); PG8_STAGE(PG8_SA(0, 0), a2, voffA);
            PG8_WAIT_V(8); PG8_WAIT_L(0); PG8_BAR; PG8_MMA(1, 0, At, B0); PG8_MMA(1, 1, At, B1); PG8_BAR; PG8_SCHED;
            PG8_LDB(B0, 1, 0); PG8_LDB(B1, 1, 1); PG8_SCHED; PG8_LDA(At, 1, 0); PG8_STAGE(PG8_SA(0, 1), a2 + hstep, voffA);
            PG8_WAIT_V(8); PG8_WAIT_L(0); PG8_BAR; PG8_MMA(0, 0, At, B0); PG8_MMA(0, 1, At, B1); PG8_BAR; PG8_SCHED;
            PG8_LDA(At, 1, 1); PG8_STAGE(PG8_SB(1, 0), b3, voffB); PG8_STAGE(PG8_SB(1, 1), b3 + hstep, voffB); PG8_STAGE(PG8_SA(1, 0), a3, voffA);
            PG8_WAIT_V(8); PG8_WAIT_L(0); PG8_BAR; PG8_MMA(1, 0, At, B0); PG8_MMA(1, 1, At, B1); PG8_BAR; PG8_SCHED;
            } else {
            PG8_LDB(B0, 0, 0); PG8_SCHED; PG8_LDA(At, 0, 0); PG8_STAGE(PG8_SA(1, 1), a1 + hstep, voffA);
            PG8_WAIT_L(8); PG8_BAR; PG8_WAIT_L(0); PG8_MMA(0, 0, At, B0); PG8_BAR; PG8_SCHED;
            PG8_LDB(B1, 0, 1); PG8_STAGE(PG8_SB(0, 0), b2, voffB);
            PG8_BAR; PG8_WAIT_L(0); PG8_MMA(0, 1, At, B1); PG8_BAR;
            PG8_LDA(At, 0, 1); PG8_STAGE(PG8_SA(0, 0), a2, voffA);
            PG8_BAR; PG8_WAIT_L(0); PG8_MMA(1, 0, At, B0); PG8_BAR; PG8_SCHED;
            PG8_STAGE(PG8_SB(0, 1), b2 + hstep, voffB);
            PG8_WAIT_V(6); PG8_BAR; PG8_MMA(1, 1, At, B1); PG8_BAR;
            PG8_LDB(B0, 1, 0); PG8_SCHED; PG8_LDA(At, 1, 0); PG8_STAGE(PG8_SA(0, 1), a2 + hstep, voffA);
            PG8_WAIT_L(8); PG8_BAR; PG8_WAIT_L(0); PG8_MMA(0, 0, At, B0); PG8_BAR; PG8_SCHED;
            PG8_LDB(B1, 1, 1); PG8_STAGE(PG8_SB(1, 0), b3, voffB);
            PG8_BAR; PG8_WAIT_L(0); PG8_MMA(0, 1, At, B1); PG8_BAR;
            PG8_LDA(At, 1, 1); PG8_STAGE(PG8_SA(1, 0), a3, voffA);
            PG8_BAR; PG8_WAIT_L(0); PG8_MMA(1, 0, At, B0); PG8_BAR; PG8_SCHED;
            PG8_STAGE(PG8_SB(1, 1), b3 + hstep, voffB);
            PG8_WAIT_V(6); PG8_BAR; PG8_MMA(1, 1, At, B1); PG8_BAR;
            }
        }
        if constexpr (ALIGN_EPI) { if (wr == 0) PG8_BAR; }
        if constexpr (!Epi::AFTER_DRAIN) { E(acc, cur, wr, wc, fr, fq); S.done(cur); }
        if (!has_next) break;
#pragma unroll
        for (int a = 0; a < 2; ++a)
#pragma unroll
            for (int b = 0; b < 2; ++b)
#pragma unroll
                for (int m = 0; m < 4; ++m)
#pragma unroll
                    for (int n = 0; n < 2; ++n) acc[a][b][m][n] = (f32x4){0.f, 0.f, 0.f, 0.f};
        cur = nxt; cA = nA; cB = nB; ++ui;
        if constexpr (ALIGN_EPI) { if (wr == 1) PG8_BAR; }
    }
    PG8_WAIT_V(0);
    if constexpr (!ALIGN_EPI) { if (wr == 0) PG8_BAR; }
    PG8_BAR;
    if constexpr (Epi::AFTER_DRAIN) { E.fused(acc, cur, wr, wc, fr, fq, lds, wid, lane); S.done(cur); }
#undef PG8_SA
#undef PG8_SB
#undef PG8_STAGE
#undef PG8_LDA
#undef PG8_LDB
#undef PG8_MMA
#undef PG8_WAIT_V
#undef PG8_WAIT_L
#undef PG8_BAR
#undef PG8_SCHED
}
}

struct OneUnit {
    int pm, pn; bool have;
    DI bool next(int i, pg8::Unit& u) const { if (i > 0 || !have) return false; u.pm = pm; u.pn = pn; return true; }
    DI void a_ready(const pg8::Unit&) const {}
    DI void done(const pg8::Unit&) const {}
};
struct EpiFfnA {
    static constexpr bool PERM = true, AFTER_DRAIN = false;
    bf16* hid;
    DI void operator()(const f32x4 (&acc)[2][2][4][2], const pg8::Unit& u, int wr, int wc, int fr, int fq) const {
        asm volatile("" : "+v"(fr), "+v"(fq), "+s"(wr), "+s"(wc));
        const int row0 = u.pm * 256 + wr * 64 + fr, hc0 = u.pn * 128 + wc * 32 + 8 * fq;
#pragma unroll
        for (int ai = 0; ai < 2; ++ai)
#pragma unroll
            for (int m = 0; m < 4; ++m) {
                const int row = row0 + ai * 128 + m * 16;
                float v[8];
#pragma unroll
                for (int n = 0; n < 2; ++n)
#pragma unroll
                    for (int j = 0; j < 4; ++j) { const float g = acc[ai][0][m][n][j], up = acc[ai][1][m][n][j]; v[n * 4 + j] = g * sigmoidf_(g) * up; }
                u32x4 o; o.x = pk2(v[0], v[1]); o.y = pk2(v[2], v[3]); o.z = pk2(v[4], v[5]); o.w = pk2(v[6], v[7]);
                AT(u32x4, hid, (row * DFF + hc0) >> 3) = o;
            }
    }
};
struct EpiResid {
    static constexpr bool PERM = true, AFTER_DRAIN = false;
    float* X; const float* resid; const float* gate; float scale; bool atomic;
    DI void operator()(const f32x4 (&acc)[2][2][4][2], const pg8::Unit& u, int wr, int wc, int fr, int fq) const {
        asm volatile("" : "+v"(fr), "+v"(fq), "+s"(wr), "+s"(wc));
        const int row0 = u.pm * 256 + wr * 64 + fr;
#pragma unroll
        for (int bj = 0; bj < 2; ++bj) {
            const int c0 = u.pn * 256 + bj * 128 + wc * 32 + 8 * fq;
            const f32x4 g0 = *(const f32x4*)(gate + c0) * scale, g1 = *(const f32x4*)(gate + c0 + 4) * scale;
            if (atomic) {
#pragma unroll
                for (int ai = 0; ai < 2; ++ai)
#pragma unroll
                    for (int m = 0; m < 4; ++m) {
                        const int row = row0 + ai * 128 + m * 16;
                        const f32x4 d0 = g0 * acc[ai][bj][m][0], d1 = g1 * acc[ai][bj][m][1];
#pragma unroll
                        for (int j = 0; j < 4; ++j) { atomicAdd(&AT(float, X, row * D + c0 + j), d0[j]); atomicAdd(&AT(float, X, row * D + c0 + 4 + j), d1[j]); }
                    }
            } else {
                f32x4 r0[8], r1[8];
#pragma unroll
                for (int q = 0; q < 8; ++q) { const int row = row0 + (q >> 2) * 128 + (q & 3) * 16; r0[q] = AT(const f32x4, resid, (row * D + c0) >> 2); r1[q] = AT(const f32x4, resid, (row * D + c0 + 4) >> 2); }
#pragma unroll
                for (int q = 0; q < 8; ++q) {
                    const int row = row0 + (q >> 2) * 128 + (q & 3) * 16;
                    AT(f32x4, X, (row * D + c0) >> 2) = r0[q] + g0 * acc[q >> 2][bj][q & 3][0]; AT(f32x4, X, (row * D + c0 + 4) >> 2) = r1[q] + g1 * acc[q >> 2][bj][q & 3][1];
                }
            }
        }
    }
};
struct EpiInproj {
    static constexpr bool PERM = true, AFTER_DRAIN = false;
    char* ws; const float* gq; const float* gk;
    DI void operator()(const f32x4 (&acc)[2][2][4][2], const pg8::Unit& u, int wr, int wc, int fr, int fq) const {
        asm volatile("" : "+v"(fr), "+v"(fq), "+s"(wr), "+s"(wc));
        const int pn = u.pn, row0 = u.pm * 256 + wr * 64 + fr;
        if (pn < 2 || pn > 4) {
            bf16* dst; int ld, cb;
            if (pn == 0) { dst = (bf16*)(ws + O_A); ld = 256; cb = 0; } else if (pn == 1) { dst = (bf16*)(ws + O_S); ld = 256; cb = 0; } else { dst = (bf16*)(ws + O_BIG); ld = 3072; cb = (pn - 5) * 256; }
            const bool sg = pn > 4;
#pragma unroll
            for (int bj = 0; bj < 2; ++bj) {
                const int c0 = cb + bj * 128 + wc * 32 + 8 * fq;
#pragma unroll
                for (int ai = 0; ai < 2; ++ai)
#pragma unroll
                    for (int m = 0; m < 4; ++m) {
                        const int row = row0 + ai * 128 + m * 16;
                        float v[8];
#pragma unroll
                        for (int n = 0; n < 2; ++n)
#pragma unroll
                            for (int j = 0; j < 4; ++j) { const float x = acc[ai][bj][m][n][j]; v[n * 4 + j] = sg ? sigmoidf_(x) : x; }
                        u32x4 o; o.x = pk2(v[0], v[1]); o.y = pk2(v[2], v[3]); o.z = pk2(v[4], v[5]); o.w = pk2(v[6], v[7]);
                        AT(u32x4, dst, (row * ld + c0) >> 3) = o;
                    }
            }
        } else if (pn < 4 || wc < 2) {
            const bool isq = pn < 4;
            const float* gv = isq ? gq : gk;
            const float2* rope = (const float2*)(ws + O_ROPE);
            const bool latent = u.pm < 64;
            const float osc = isq ? 0.125f * 1.4426950408889634f : 1.f, sgn = (fq >= 2) ? 1.f : -1.f;
            bf16* dst = (bf16*)(ws + (isq ? O_Q : O_K));
            const int ld = isq ? 512 : 128, hb = (isq ? (pn - 2) * 4 + wc : wc) * 64 + 8 * fq, i0 = 8 * (fq & 1);
#pragma unroll
            for (int ai = 0; ai < 2; ++ai)
#pragma unroll
                for (int m = 0; m < 4; ++m) {
                    const int row = row0 + ai * 128 + m * 16;
                    float v[2][8]; float ss = 0.f;
#pragma unroll
                    for (int bj = 0; bj < 2; ++bj)
#pragma unroll
                        for (int n = 0; n < 2; ++n)
#pragma unroll
                            for (int j = 0; j < 4; ++j) { const float x = acc[ai][bj][m][n][j]; v[bj][n * 4 + j] = x; ss += x * x; }
                    ss += __shfl_xor(ss, 16); ss += __shfl_xor(ss, 32);
                    const float rstd = rsqrtf(ss * (1.f / 64.f) + 1e-6f);
#pragma unroll
                    for (int bj = 0; bj < 2; ++bj) {
#pragma unroll
                        for (int e = 0; e < 8; ++e) v[bj][e] *= rstd * AT(const float, gv, 32 * bj + 8 * fq + e);
                        if (latent) {
                            const int pos = bj == 0 ? (row >> 6) : (row & 63);
#pragma unroll
                            for (int e = 0; e < 8; ++e) {
                                const float2 cs = AT(const float2, rope, pos * 16 + i0 + e);
                                const float pr = __shfl_xor(v[bj][e], 32);
                                v[bj][e] = v[bj][e] * cs.x + sgn * pr * cs.y;
                            }
                        }
                        u32x4 o; o.x = pk2(v[bj][0] * osc, v[bj][1] * osc); o.y = pk2(v[bj][2] * osc, v[bj][3] * osc); o.z = pk2(v[bj][4] * osc, v[bj][5] * osc); o.w = pk2(v[bj][6] * osc, v[bj][7] * osc);
                        AT(u32x4, dst, (row * ld + hb + 32 * bj) >> 3) = o;
                    }
                    asm volatile("" ::: "memory");
                }
        } else {
            bf16* vt = (bf16*)(ws + O_VT);
#pragma unroll
            for (int bj = 0; bj < 2; ++bj)
#pragma unroll
                for (int ai = 0; ai < 2; ++ai)
#pragma unroll
                    for (int m = 0; m < 4; ++m) {
                        const int row = row0 + ai * 128 + m * 16;
#pragma unroll
                        for (int n = 0; n < 2; ++n)
#pragma unroll
                            for (int j = 0; j < 4; ++j) AT(bf16, vt, ((wc - 2) * 64 + 32 * bj + 8 * fq + 4 * n + j) * NT + row) = f2bf(acc[ai][bj][m][n][j]);
                    }
        }
    }
};
typedef PG8_LAS unsigned char* pg8lds;
DI void big_ffn_a(const Params& p, int f, int M, ldsp lds) {
    pg8::Gemm g{(const pg8::bf16_t*)(p.ws + O_H), (const pg8::bf16_t*)(p.ws + O_W13) + (size_t)f * 5632 * 1024, 1024, 1024};
    pg8::StaticOrder S; S.init(M, 5632, gridDim.x, blockIdx.x);
    EpiFfnA E{(bf16*)(p.ws + O_BIG)};
    pg8::gemm_phase<EpiFfnA, pg8::StaticOrder, true, true>((pg8lds)lds, g, S, E);
}
#define PANEL_CNT(l, prod, pm) (4096 + ((l) * 3 + (prod)) * 80 + (pm))
DI unsigned panel_arrive_wait(unsigned* w, unsigned target, ldsp lds) {
    asm volatile("s_waitcnt vmcnt(0)" ::: "memory");
    __syncthreads();
    LAS unsigned* flag = (LAS unsigned*)lds;
    if (threadIdx.x == 0) {
        __builtin_amdgcn_fence(__ATOMIC_RELEASE, "agent");
        asm volatile("s_waitcnt vmcnt(0)" ::: "memory");
        const unsigned old = xb_add(w, 1u);
        unsigned sp = 0;
        while (xb_ld(w) < target) { __builtin_amdgcn_s_sleep(2); if (++sp > (1u << 24)) break; }
        __builtin_amdgcn_fence(__ATOMIC_ACQUIRE, "agent");
        asm volatile("s_waitcnt vmcnt(0)" ::: "memory");
        *flag = old;
    }
    __syncthreads();
    const unsigned r = *flag;
    __syncthreads();
    return r;
}
DI void norm_rows(const Params& p, int nl, int nwhich, bool fin, int r0, int nrows) {
    const int lane = threadIdx.x & 63, w = threadIdx.x >> 6;
    const int cond = r0 >= NL, per = nrows >> 3;
    f32x4 gm[4], sv[4];
#pragma unroll
    for (int j = 0; j < 4; ++j) {
        const int c = lane * 4 + 256 * j;
        if (fin) { gm[j] = *(const f32x4*)(p.in[I_FG] + c); sv[j] = (f32x4){0.f, 0.f, 0.f, 0.f}; }
        else {
            const float* g = p.in[I_NORMG] + (size_t)(nl * 3 + nwhich) * D;
            gm[j] = *(const f32x4*)(g + c) * (*(const f32x4*)(mods_ptr(p, cond, nl, 3 * nwhich + 1) + c) + 1.f);
            sv[j] = *(const f32x4*)(mods_ptr(p, cond, nl, 3 * nwhich) + c);
        }
    }
    const int wbeg = r0 + w * per, wend = wbeg + per;
#pragma unroll 1
    for (int rb = wbeg; rb < wend; rb += 4) {
        const int n = min(4, wend - rb);
        f32x4 x[4][4];
#pragma unroll
        for (int q = 0; q < 4; ++q)
#pragma unroll
            for (int j = 0; j < 4; ++j) x[q][j] = *(const f32x4*)((const float*)(p.ws + O_X) + (size_t)(rb + (q < n ? q : 0)) * D + lane * 4 + 256 * j);
#pragma unroll
        for (int q = 0; q < 4; ++q) {
            if (q < n) {
                float ss = 0.f;
#pragma unroll
                for (int j = 0; j < 4; ++j) ss += x[q][j][0] * x[q][j][0] + x[q][j][1] * x[q][j][1] + x[q][j][2] * x[q][j][2] + x[q][j][3] * x[q][j][3];
                ss = wave_sum(ss);
                const float rstd = __builtin_amdgcn_rsqf(ss * (1.f / 1024.f) + 1e-6f);
#pragma unroll
                for (int j = 0; j < 4; ++j) {
                    const int c = lane * 4 + 256 * j;
                    const f32x4 o = x[q][j] * rstd * gm[j] + sv[j];
                    if (fin) *(f32x4*)(p.out + (size_t)(rb + q) * D + c) = o;
                    else { u32x2 pk; pk.x = pk2(o[0], o[1]); pk.y = pk2(o[2], o[3]); *(u32x2*)((bf16*)(p.ws + O_H) + (size_t)(rb + q) * D + c) = pk; }
                }
            }
        }
    }
}
DI void big_resid(const Params& p, const bf16* A, const bf16* Bt, int K, int l, int gate_j, float scale, bool resid_in, bool ctx, int prod, int nl, int nwhich, bool fin, ldsp lds) {
    float* X = (float*)(p.ws + O_X);
    unsigned* cw = (unsigned*)(p.ws + O_BAR);
    if (ctx) {
        const int j = blockIdx.x, nsplit = K / 256;
        OneUnit S{64, j & 3, j < 4 * nsplit};
        pg8::Gemm g{(const pg8::bf16_t*)A + (j >> 2) * 256, (const pg8::bf16_t*)Bt + (j >> 2) * 256, 256, K};
        EpiResid E{X, X, mods_ptr(p, 1, l, gate_j), scale, true};
        pg8::gemm_phase<EpiResid, OneUnit, false, true>((pg8lds)lds, g, S, E);
        if (j < 4 * nsplit) {
            const unsigned k = panel_arrive_wait(cw + PANEL_CNT(l, prod, 64), 4u * nsplit, lds);
            if (k < 16u) norm_rows(p, nl, nwhich, false, NL + (int)k * 16, 16);
        }
    }
    pg8::Gemm g{(const pg8::bf16_t*)A, (const pg8::bf16_t*)Bt, K, K};
    pg8::StaticOrder S; S.init(NL, 1024, gridDim.x, blockIdx.x);
    EpiResid E{X, resid_in ? p.in[I_X] : X, mods_ptr(p, 0, l, gate_j), scale, false};
    pg8::gemm_phase<EpiResid, pg8::StaticOrder, false, true>((pg8lds)lds, g, S, E);
    pg8::Unit u;
    for (int i = 0; S.next(i, u); ++i) {
        const unsigned k = panel_arrive_wait(cw + PANEL_CNT(l, prod, u.pm), 4u, lds);
        norm_rows(p, nl, nwhich, fin, u.pm * 256 + (int)(k & 3u) * 64, 64);
    }
}
template <int MODE>
struct EpiMix {
    static constexpr bool PERM = true, AFTER_DRAIN = false;
    bf16* M; const bf16* G;
    DI void operator()(const f32x4 (&acc)[2][2][4][2], const pg8::Unit& u, int wr, int wc, int fr, int fq) const {
        asm volatile("" : "+v"(fr), "+v"(fq), "+s"(wr), "+s"(wc));
        const int row0 = u.pm * 256 + wr * 64 + fr;
#pragma unroll
        for (int bj = 0; bj < (MODE == 2 ? 1 : 2); ++bj) {
            const int c0 = (MODE == 2) ? (u.pn * 128 + wc * 32 + 8 * fq) : (u.pn * 256 + bj * 128 + wc * 32 + 8 * fq);
            const int gofs = (MODE == 0) ? 0 : (MODE == 1) ? 2048 : 1024;
            u32x4 gg[8], mm[8];
#pragma unroll
            for (int q = 0; q < 8; ++q) {
                const int row = row0 + (q >> 2) * 128 + (q & 3) * 16;
                gg[q] = AT(const u32x4, G, (row * 3072 + gofs + c0) >> 3);
                if (MODE != 0) mm[q] = AT(const u32x4, M, (row * D + c0) >> 3);
            }
#pragma unroll
            for (int q = 0; q < 8; ++q) {
                const int row = row0 + (q >> 2) * 128 + (q & 3) * 16, ai = q >> 2, m = q & 3;
                float v[8];
#pragma unroll
                for (int n = 0; n < 2; ++n)
#pragma unroll
                    for (int j = 0; j < 4; ++j) {
                        if (MODE == 2) v[n * 4 + j] = acc[ai][0][m][n][j] * sigmoidf_(acc[ai][1][m][n][j]);
                        else v[n * 4 + j] = acc[ai][bj][m][n][j];
                    }
                v[0] *= bflo(gg[q].x); v[1] *= bfhi(gg[q].x); v[2] *= bflo(gg[q].y); v[3] *= bfhi(gg[q].y); v[4] *= bflo(gg[q].z); v[5] *= bfhi(gg[q].z); v[6] *= bflo(gg[q].w); v[7] *= bfhi(gg[q].w);
                if (MODE != 0) { v[0] += bflo(mm[q].x); v[1] += bfhi(mm[q].x); v[2] += bflo(mm[q].y); v[3] += bfhi(mm[q].y); v[4] += bflo(mm[q].z); v[5] += bfhi(mm[q].z); v[6] += bflo(mm[q].w); v[7] += bfhi(mm[q].w); }
                u32x4 o; o.x = pk2(v[0], v[1]); o.y = pk2(v[2], v[3]); o.z = pk2(v[4], v[5]); o.w = pk2(v[6], v[7]);
                AT(u32x4, M, (row * D + c0) >> 3) = o;
            }
        }
    }
};
struct GluOrder {
    pg8::StaticOrder S;
    DI bool next(int i, pg8::Unit& u) const { pg8::Unit t; if (!S.next(i >> 1, t)) return false; u.pm = t.pm; u.pn = 2 * t.pn + (i & 1); return true; }
    DI void a_ready(const pg8::Unit&) const {}
    DI void done(const pg8::Unit&) const {}
};
DI void big_mix1(const Params& p, int M, ldsp lds) {
    bf16* Mx = (bf16*)(p.ws + O_H); const bf16* G = (const bf16*)(p.ws + O_BIG);
    pg8::StaticOrder S; S.init(M, 1024, gridDim.x, blockIdx.x);
    {   pg8::Gemm g{(const pg8::bf16_t*)(p.ws + O_YP), (const pg8::bf16_t*)(p.ws + O_WP), 256, 256};
        EpiMix<0> E{Mx, G};
        pg8::gemm_phase<EpiMix<0>, pg8::StaticOrder, false, true>((pg8lds)lds, g, S, E); }
    {   pg8::Gemm g{(const pg8::bf16_t*)(p.ws + O_Q), (const pg8::bf16_t*)(p.ws + O_WAO), 512, 512};
        EpiMix<1> E{Mx, G};
        pg8::gemm_phase<EpiMix<1>, pg8::StaticOrder, false, true>((pg8lds)lds, g, S, E); }
    {   pg8::Gemm g{(const pg8::bf16_t*)(p.ws + O_YS), (const pg8::bf16_t*)(p.ws + O_WGLU), 256, 256};
        GluOrder SG{S};
        EpiMix<2> E{Mx, G};
        pg8::gemm_phase<EpiMix<2>, GluOrder, false, true>((pg8lds)lds, g, SG, E); }
}
DI void big_inproj(const Params& p, int l, ldsp lds) {
    pg8::Gemm g{(const pg8::bf16_t*)(p.ws + O_H), (const pg8::bf16_t*)(p.ws + O_WIN), 1024, 1024};
    pg8::StaticOrder S; S.init(NT, INW, gridDim.x, blockIdx.x);
    EpiInproj E{p.ws, p.in[I_QG] + l * 64, p.in[I_KG] + l * 64};
    pg8::gemm_phase<EpiInproj, pg8::StaticOrder, true, true>((pg8lds)lds, g, S, E);
}

DI void norm_item(const Params& p, int l, int which, int it) {
    const int tid = threadIdx.x, lane = tid & 63, w = tid >> 6;
    const int row = it * 8 + w;
    const int cond = row >= NL;
    const bool from_in = (l == 0 && which == 0);
    const float* src = from_in ? (cond ? p.in[I_CTX] + (size_t)(row - NL) * D : p.in[I_X] + (size_t)row * D) : (const float*)(p.ws + O_X) + (size_t)row * D;
    f32x4 x[4]; float ss = 0.f;
#pragma unroll
    for (int j = 0; j < 4; ++j) { x[j] = *(const f32x4*)(src + lane * 4 + 256 * j); ss += x[j][0] * x[j][0] + x[j][1] * x[j][1] + x[j][2] * x[j][2] + x[j][3] * x[j][3]; }
    if (from_in && cond) {
        float* xr = (float*)(p.ws + O_X) + (size_t)row * D;
#pragma unroll
        for (int j = 0; j < 4; ++j) *(f32x4*)(xr + lane * 4 + 256 * j) = x[j];
    }
    ss = wave_sum(ss);
    const float rstd = rsqrtf(ss * (1.f / 1024.f) + 1e-6f);
    const float* g = p.in[I_NORMG] + (size_t)(l * 3 + which) * D;
    const float* sh = mods_ptr(p, cond, l, 3 * which), *sc = mods_ptr(p, cond, l, 3 * which + 1);
    bf16* H = (bf16*)(p.ws + O_H) + (size_t)row * D;
#pragma unroll
    for (int j = 0; j < 4; ++j) {
        const int c = lane * 4 + 256 * j;
        const f32x4 gv = *(const f32x4*)(g + c), sv = *(const f32x4*)(sh + c), cv = *(const f32x4*)(sc + c);
        float o[4];
#pragma unroll
        for (int e = 0; e < 4; ++e) o[e] = x[j][e] * rstd * gv[e] * (1.f + cv[e]) + sv[e];
        u32x2 pk; pk.x = pk2(o[0], o[1]); pk.y = pk2(o[2], o[3]);
        *(u32x2*)(H + c) = pk;
    }
}
DI void final_norm_item(const Params& p, int it) {
    const int tid = threadIdx.x, lane = tid & 63, w = tid >> 6;
    const int row = it * 8 + w;
    const float* src = (const float*)(p.ws + O_X) + (size_t)row * D;
    f32x4 x[4]; float ss = 0.f;
#pragma unroll
    for (int j = 0; j < 4; ++j) { x[j] = *(const f32x4*)(src + lane * 4 + 256 * j); ss += x[j][0] * x[j][0] + x[j][1] * x[j][1] + x[j][2] * x[j][2] + x[j][3] * x[j][3]; }
    ss = wave_sum(ss);
    const float rstd = rsqrtf(ss * (1.f / 1024.f) + 1e-6f);
    const float* g = p.in[I_FG];
#pragma unroll
    for (int j = 0; j < 4; ++j) {
        const int c = lane * 4 + 256 * j;
        const f32x4 gv = *(const f32x4*)(g + c);
        f32x4 o;
#pragma unroll
        for (int e = 0; e < 4; ++e) o[e] = x[j][e] * rstd * gv[e];
        *(f32x4*)(p.out + (size_t)row * D + c) = o;
    }
}
DI void s1_item(const Params& p, int it, ldsp lds) {
    TID_VARS
    const int g = it & 15, mt = it >> 4;
    f32x16 acc[4][2]; zero_acc<4, 2>(acc);
    gemm_acc<1, 4, 2>(acc, (const bf16*)(p.ws + O_S) + g * 16, 8192, mt * 256, (const bf16*)(p.ws + O_W1S) + (unsigned)g * 256 * 512, 512, 0, 512, lds);
    float* E = (float*)(p.ws + O_E);
#pragma unroll
    for (int rb = 0; rb < 4; ++rb)
#pragma unroll
        for (int cb = 0; cb < 2; ++cb)
#pragma unroll
            for (int i = 0; i < 16; ++i) {
                const int c = mt * 256 + ACC_ROW(rb, i);
                if (c < NCH) AT(float, E, (c * 16 + g) * 256 + ACC_COL(cb)) = acc[rb][cb][i];
            }
}
DI void s2_item(const Params& p, int it) {
    const int sidx = it * 512 + threadIdx.x;
    const int g = sidx >> 7, dir = (sidx >> 6) & 1, pp = sidx & 63;
    const float2 aT = ((const float2*)(p.ws + O_PW))[(unsigned)((dir * 16 + g) * 64 + pp) * 33 + 32];
    const float* E = (const float*)(p.ws + O_E) + g * 256 + dir * 128 + pp;
    bf16* C = (bf16*)(p.ws + O_CARRY) + g * 256 + dir * 128 + pp;
    float cr = 0.f, ci = 0.f;
#pragma unroll 8
    for (int n = 0; n < NCH; ++n) {
        int c;
        if (dir == 0) c = (n < 8) ? 512 + n : n - 8;
        else c = 519 - n;
        const float er = E[(unsigned)c * 4096], ei = E[(unsigned)c * 4096 + 64];
        C[(unsigned)c * 4096] = f2bf(cr); C[(unsigned)c * 4096 + 64] = f2bf(ci);
        const float nr = aT.x * cr - aT.y * ci + er, ni = aT.x * ci + aT.y * cr + ei;
        cr = nr; ci = ni;
    }
}
DI float gelu_tanh(float x) { const float u = 0.7978845608028654f * (x + 0.044715f * x * x * x); return x * sigmoidf_(2.f * u); }
DI void s3_item(const Params& p, int it, ldsp lds) {
    TID_VARS
    const int g = it & 15, rest = it >> 4, nt = rest & 1, mt = rest >> 1;
    f32x16 acc[4][2]; zero_acc<4, 2>(acc);
    gemm_acc<1, 4, 2>(acc, (const bf16*)(p.ws + O_S) + g * 16, 8192, mt * 256, (const bf16*)(p.ws + O_TOEP) + (unsigned)g * 512 * 512, 512, nt * 256, 512, lds);
    gemm_acc<0, 4, 2>(acc, (const bf16*)(p.ws + O_CARRY) + g * 256, 4096, mt * 256, (const bf16*)(p.ws + O_W3S) + (unsigned)g * 512 * 256, 256, nt * 256, 256, lds);
    bf16* Ys = (bf16*)(p.ws + O_YS);
#pragma unroll
    for (int rb = 0; rb < 4; ++rb)
#pragma unroll
        for (int cb = 0; cb < 2; ++cb)
#pragma unroll
            for (int i = 0; i < 16; ++i) {
                const int c = mt * 256 + ACC_ROW(rb, i);
                const int n = nt * 256 + ACC_COL(cb), j = n >> 4, hh = n & 15;
                if (c < NCH) AT(bf16, Ys, (c * 32 + j) * 256 + g * 16 + hh) = f2bf(gelu_tanh(acc[rb][cb][i]));
            }
}
DI void pool_item(const Params& p, int it) {
    const int tid = threadIdx.x, cv = tid & 31, rg = tid >> 5;
    const bf16* A = (const bf16*)(p.ws + O_A);
    bf16* Y = (bf16*)(p.ws + O_YP);
    const int half = 1 << (cv >> 3);
#pragma unroll 1
    for (int i = 0; i < 4; ++i) {
        const int row = it * 64 + rg + 16 * i;
        const int base = row >= NL ? NL : 0, n = row >= NL ? NC : NL, t = row - base;
        const int lo = max(t - half, 0), hi = min(t + half, n);
        float s[8];
#pragma unroll
        for (int e = 0; e < 8; ++e) s[e] = 0.f;
        for (int u = lo; u < hi; ++u) {
            const u32x4 v = *(const u32x4*)(A + (unsigned)(base + u) * 256 + cv * 8);
            s[0] += bflo(v.x); s[1] += bfhi(v.x); s[2] += bflo(v.y); s[3] += bfhi(v.y); s[4] += bflo(v.z); s[5] += bfhi(v.z); s[6] += bflo(v.w); s[7] += bfhi(v.w);
        }
        const u32x4 v = *(const u32x4*)(A + (unsigned)row * 256 + cv * 8);
        const float inv = 1.f / (float)(hi - lo);
        u32x4 o;
        o.x = pk2(s[0] * inv - bflo(v.x), s[1] * inv - bfhi(v.x)); o.y = pk2(s[2] * inv - bflo(v.y), s[3] * inv - bfhi(v.y));
        o.z = pk2(s[4] * inv - bflo(v.z), s[5] * inv - bfhi(v.z)); o.w = pk2(s[6] * inv - bflo(v.w), s[7] * inv - bfhi(v.w));
        *(u32x4*)(Y + (unsigned)row * 256 + cv * 8) = o;
    }
}
DI int sig_perm(int r) { return (r & 0x13) | ((r & 4) << 1) | ((r & 8) >> 1); }
template <bool FIXED>
DI void attn_item(const Params& p, int qb, int head, float bound, ldsp lds) {
    TID_VARS
    const int kvh = head >> 2;
    bf16* Q = (bf16*)(p.ws + O_Q);
    const bf16* Kp = (const bf16*)(p.ws + O_K) + kvh * 64;
    const bf16* Vp = (const bf16*)(p.ws + O_VT) + (unsigned)kvh * 64 * NT;
    const int q0 = qb * 256 + w * 32;
    bf16x8 qf[4];
#pragma unroll
    for (int s = 0; s < 4; ++s) qf[s] = *(const bf16x8*)(Q + (unsigned)(q0 + r) * 512 + head * 64 + 16 * s + 8 * h);
    const int key0 = qb < 64 ? 0 : NL, ntile = qb < 64 ? NT / 64 : NC / 64;
    const int isv = tid >> 8, lrow = (tid & 255) >> 3, lv = tid & 7;
    const bf16* gp = isv ? (Vp + (unsigned)lrow * NT + key0 + lv * 8) : (Kp + (unsigned)(key0 + lrow) * 128 + lv * 8);
    const unsigned gstep = isv ? 64u : 64u * 128u, grow = isv ? 32u * NT : 32u * 128u;
    u32x4 rgA[2], rgB[2];
#pragma unroll
    for (int i = 0; i < 2; ++i) rgB[i] = *(const u32x4*)(gp + i * grow);
    ldsp wr = lds + isv * 9216 + lrow * LROW + lv * 16;
#pragma unroll
    for (int i = 0; i < 2; ++i) *(LAS u32x4*)(wr + i * 32 * LROW) = rgB[i];
    gp += gstep;
#pragma unroll
    for (int i = 0; i < 2; ++i) rgA[i] = *(const u32x4*)(gp + i * grow);
    __syncthreads();
    f32x16 o0, o1;
#pragma unroll
    for (int i = 0; i < 16; ++i) { o0[i] = 0.f; o1[i] = 0.f; }
    float m = -1e30f, lsum = 0.f, lsa = 0.f, lsb = 0.f;
    f32x16 cinit;
#pragma unroll
    for (int i = 0; i < 16; ++i) cinit[i] = FIXED ? -bound * 1.4426950408889634f : 0.f;
    cldsp lk = lds + sig_perm(r) * LROW + h * 16;
    cldsp lvv = lds + 9216 + r * LROW + h * 16;
#define ATT_TILE(buf, RL, RW, t)                                                                                                     \
    {                                                                                                                                \
        if ((t) + 2 < ntile) {                                                                                                       \
            gp += gstep;                                                                                                             \
            _Pragma("unroll") for (int i = 0; i < 2; ++i) RL[i] = *(const u32x4*)(gp + i * grow);                                    \
        }                                                                                                                            \
        __builtin_amdgcn_sched_barrier(0);                                                                                           \
        cldsp pk = lk + (buf) * 18432; cldsp pv = lvv + (buf) * 18432;                                                               \
        f32x16 s0, s1;                                                                                                               \
        {                                                                                                                            \
            const bf16x8 k0 = *(const LAS bf16x8*)(pk), k1 = *(const LAS bf16x8*)(pk + 32 * LROW);                                   \
            s0 = MFMA(k0, qf[0], cinit); s1 = MFMA(k1, qf[0], cinit);                                                                \
        }                                                                                                                            \
        _Pragma("unroll") for (int s = 1; s < 4; ++s) {                                                                              \
            const bf16x8 k0 = *(const LAS bf16x8*)(pk + s * 32), k1 = *(const LAS bf16x8*)(pk + 32 * LROW + s * 32);                 \
            s0 = MFMA(k0, qf[s], s0); s1 = MFMA(k1, qf[s], s1);                                                                      \
        }                                                                                                                            \
        if (!FIXED) {                                                                                                                \
            float mx = s0[0];                                                                                                        \
            _Pragma("unroll") for (int i = 1; i < 16; ++i) mx = fmaxf(mx, s0[i]);                                                    \
            _Pragma("unroll") for (int i = 0; i < 16; ++i) mx = fmaxf(mx, s1[i]);                                                    \
            mx = fmaxf(mx, __shfl_xor(mx, 32));                                                                                      \
            const float mnew = fmaxf(m, mx);                                                                                         \
            const float alpha = __builtin_amdgcn_exp2f(m - mnew);                                                                    \
            m = mnew;                                                                                                                \
            lsa *= alpha; lsb *= alpha;                                                                                              \
            _Pragma("unroll") for (int i = 0; i < 16; ++i) { o0[i] *= alpha; o1[i] *= alpha; s0[i] -= mnew; s1[i] -= mnew; }         \
        }                                                                                                                            \
        _Pragma("unroll") for (int i = 0; i < 16; ++i) {                                                                             \
            s0[i] = __builtin_amdgcn_exp2f(s0[i]); s1[i] = __builtin_amdgcn_exp2f(s1[i]);                                            \
            lsa += s0[i]; lsb += s1[i];                                                                                              \
        }                                                                                                                            \
        _Pragma("unroll") for (int kb = 0; kb < 2; ++kb)                                                                             \
            _Pragma("unroll") for (int s = 0; s < 2; ++s) {                                                                          \
                u32x4 pp;                                                                                                            \
                if (kb == 0) { pp.x = pk2(s0[8 * s], s0[8 * s + 1]); pp.y = pk2(s0[8 * s + 2], s0[8 * s + 3]); pp.z = pk2(s0[8 * s + 4], s0[8 * s + 5]); pp.w = pk2(s0[8 * s + 6], s0[8 * s + 7]); } \
                else         { pp.x = pk2(s1[8 * s], s1[8 * s + 1]); pp.y = pk2(s1[8 * s + 2], s1[8 * s + 3]); pp.z = pk2(s1[8 * s + 4], s1[8 * s + 5]); pp.w = pk2(s1[8 * s + 6], s1[8 * s + 7]); } \
                const bf16x8 pf = __builtin_bit_cast(bf16x8, pp);                                                                    \
                const bf16x8 v0 = *(const LAS bf16x8*)(pv + (kb * 32 + 16 * s) * 2), v1 = *(const LAS bf16x8*)(pv + 32 * LROW + (kb * 32 + 16 * s) * 2); \
                o0 = MFMA(v0, pf, o0); o1 = MFMA(v1, pf, o1);                                                                        \
            }                                                                                                                        \
        __builtin_amdgcn_sched_barrier(0);                                                                                           \
        if ((t) + 1 < ntile) {                                                                                                       \
            ldsp w2 = wr + ((buf) ^ 1) * 18432;                                                                                      \
            _Pragma("unroll") for (int i = 0; i < 2; ++i) *(LAS u32x4*)(w2 + i * 32 * LROW) = RW[i];                                 \
        }                                                                                                                            \
        __syncthreads();                                                                                                             \
    }
    for (int t = 0; t < ntile; t += 2) {
        ATT_TILE(0, rgB, rgA, t)
        ATT_TILE(1, rgA, rgB, t + 1)
    }
#undef ATT_TILE
    lsum = lsa + lsb;
    lsum += __shfl_xor(lsum, 32);
    const float inv = 1.f / lsum;
    bf16* orow = Q + (unsigned)(q0 + r) * 512 + head * 64;
#pragma unroll
    for (int q = 0; q < 4; ++q) {
        u32x2 a, b;
        a.x = pk2(o0[4 * q] * inv, o0[4 * q + 1] * inv); a.y = pk2(o0[4 * q + 2] * inv, o0[4 * q + 3] * inv);
        b.x = pk2(o1[4 * q] * inv, o1[4 * q + 1] * inv); b.y = pk2(o1[4 * q + 2] * inv, o1[4 * q + 3] * inv);
        *(u32x2*)(orow + 8 * q + 4 * h) = a;
        *(u32x2*)(orow + 32 + 8 * q + 4 * h) = b;
    }
}
DI float attn_bound(const Params& p, int l) {
    const int lane = threadIdx.x & 63;
    float a = fabsf(p.in[I_QG][l * 64 + lane]), b = fabsf(p.in[I_KG][l * 64 + lane]);
#pragma unroll
    for (int o = 32; o >= 1; o >>= 1) { a = fmaxf(a, __shfl_xor(a, o)); b = fmaxf(b, __shfl_xor(b, o)); }
    return 8.f * 1.02f * a * b;
}
DI void attn_dispatch(const Params& p, int l, int qb, int head, ldsp lds) {
    const float bound = attn_bound(p, l);
    if (bound < 40.f) attn_item<true>(p, qb, head, bound, lds);
    else attn_item<false>(p, qb, head, 0.f, lds);
}
DI void conv_tile(const float* src, bf16* dst, int K, int N, int permmode, int tile, ldsp lds) {
    const int tid = threadIdx.x & 255, half = threadIdx.x >> 8;
    tile = tile * 2 + half;
    const int ntn = N / 64, tk = tile / ntn, tn = tile % ntn;
    LAS float* L = (LAS float*)lds + half * (64 * 65);
#pragma unroll
    for (int i = 0; i < 4; ++i) {
        const int kk = (tid >> 4) + 16 * i, c4 = (tid & 15) * 4;
        const f32x4 v = *(const f32x4*)(src + (size_t)(tk * 64 + kk) * N + tn * 64 + c4);
        L[kk * 65 + c4] = v[0]; L[kk * 65 + c4 + 1] = v[1]; L[kk * 65 + c4 + 2] = v[2]; L[kk * 65 + c4 + 3] = v[3];
    }
    __syncthreads();
    const int n = tid >> 2, ks = (tid & 3) * 16;
    int nn = tn * 64 + n;
    if (permmode == 1) { const int hN = N >> 1, b = nn >= hN, hc = b ? nn - hN : nn; nn = 256 * (hc >> 7) + 128 * b + (hc & 127); }
    else if (permmode == 2 && nn >= 512 && nn < 1280) {
        if (nn < 1024) { const int hd = (nn - 512) >> 6, d = nn & 63; nn = (2 + (hd >> 2)) * 256 + 128 * (d >> 5) + 32 * (hd & 3) + (d & 31); }
        else { const int hd = (nn - 1024) >> 6, d = nn & 63; nn = 1024 + 128 * (d >> 5) + 32 * hd + (d & 31); }
    }
    u32x4 o0, o1;
    o0.x = pk2(L[(ks + 0) * 65 + n], L[(ks + 1) * 65 + n]); o0.y = pk2(L[(ks + 2) * 65 + n], L[(ks + 3) * 65 + n]);
    o0.z = pk2(L[(ks + 4) * 65 + n], L[(ks + 5) * 65 + n]); o0.w = pk2(L[(ks + 6) * 65 + n], L[(ks + 7) * 65 + n]);
    o1.x = pk2(L[(ks + 8) * 65 + n], L[(ks + 9) * 65 + n]); o1.y = pk2(L[(ks + 10) * 65 + n], L[(ks + 11) * 65 + n]);
    o1.z = pk2(L[(ks + 12) * 65 + n], L[(ks + 13) * 65 + n]); o1.w = pk2(L[(ks + 14) * 65 + n], L[(ks + 15) * 65 + n]);
    bf16* d = dst + (size_t)nn * K + tk * 64 + ks;
    *(u32x4*)d = o0; *(u32x4*)(d + 8) = o1;
    __syncthreads();
}
constexpr int CV0 = 704, CV1 = 1408, CV2 = 1760, CV3 = 2112, CV4 = 2656, CV5 = 2720, CV6 = 2784, CV_TOTAL = 2912;
DI void conv_item(const Params& p, int l, int it, ldsp lds) {
    if (it < CV0) conv_tile(p.in[I_W13] + (size_t)(l * 2 + 0) * 1024 * 5632, (bf16*)(p.ws + O_W13), 1024, 5632, 1, it, lds);
    else if (it < CV1) conv_tile(p.in[I_W13] + (size_t)(l * 2 + 1) * 1024 * 5632, (bf16*)(p.ws + O_W13) + (size_t)5632 * 1024, 1024, 5632, 1, it - CV0, lds);
    else if (it < CV2) conv_tile(p.in[I_W2] + (size_t)(l * 2 + 0) * 2816 * 1024, (bf16*)(p.ws + O_W2), 2816, 1024, 0, it - CV1, lds);
    else if (it < CV3) conv_tile(p.in[I_W2] + (size_t)(l * 2 + 1) * 2816 * 1024, (bf16*)(p.ws + O_W2) + (size_t)1024 * 2816, 2816, 1024, 0, it - CV2, lds);
    else if (it < CV4) conv_tile(p.in[I_WIN] + (size_t)l * 1024 * INW, (bf16*)(p.ws + O_WIN), 1024, INW, 2, it - CV3, lds);
    else if (it < CV5) conv_tile(p.in[I_GLU] + (size_t)l * 256 * 2048, (bf16*)(p.ws + O_WGLU), 256, 2048, 1, it - CV4, lds);
    else if (it < CV6) conv_tile(p.in[I_AO] + (size_t)l * 512 * 1024, (bf16*)(p.ws + O_WAO), 512, 1024, 0, it - CV5, lds);
    else conv_tile(p.in[I_WO] + (size_t)l * 1024 * 1024, (bf16*)(p.ws + O_WOUT), 1024, 1024, 0, it - CV6, lds);
}
DI void mod_item(const Params& p, int it, ldsp lds) {
    const int tid = threadIdx.x, lane = tid & 63, w = tid >> 6;
    const int c0 = it * 256 + lane * 4, l = c0 / 9216, col = c0 % 9216;
    const float* W = p.in[I_MODW] + (size_t)l * 1024 * 9216 + col;
    f32x4 a0 = {0.f, 0.f, 0.f, 0.f}, a1 = {0.f, 0.f, 0.f, 0.f};
#pragma unroll 8
    for (int k = w * 128; k < w * 128 + 128; ++k) {
        const f32x4 wv = *(const f32x4*)(W + (size_t)k * 9216);
        const float c = p.in[I_C][k], cc = p.in[I_CCTX][k];
        const float s0 = c * sigmoidf_(c), s1 = cc * sigmoidf_(cc);
        a0 += wv * s0; a1 += wv * s1;
    }
    LAS f32x4* L = (LAS f32x4*)lds;
    L[(w * 64 + lane) * 2] = a0; L[(w * 64 + lane) * 2 + 1] = a1;
    __syncthreads();
    if (w == 0) {
        f32x4 b = *(const f32x4*)(p.in[I_MODB] + (size_t)l * 9216 + col);
        f32x4 r0 = b, r1 = b;
#pragma unroll
        for (int q = 0; q < 8; ++q) { r0 += L[(q * 64 + lane) * 2]; r1 += L[(q * 64 + lane) * 2 + 1]; }
        float* M = (float*)(p.ws + O_MODS);
        *(f32x4*)(M + (size_t)(0 * 2 + l) * 9216 + col) = r0;
        *(f32x4*)(M + (size_t)(1 * 2 + l) * 9216 + col) = r1;
    }
    __syncthreads();
}
DI void pw_item(const Params& p, int l, int it) {
    const int idx = it * 512 + threadIdx.x;
    if (idx >= 2048 * 33) return;
    const int st = idx / 33, e = idx % 33;
    const int dg = st >> 6;
    const double are = p.in[I_ARE][(size_t)l * 2048 + st], aim = p.in[I_AIM][(size_t)l * 2048 + st];
    const double dt = dexp((double)p.in[I_LOGDT][l * 32 + dg]);
    const double mag = dexp(are * dt * e);
    double s, c; dsincos(aim * dt * e, s, c);
    ((float2*)(p.ws + O_PW))[idx] = make_float2((float)(mag * c), (float)(mag * s));
    if (e == 1) {
        const double nr = mag * c - 1.0, ni = mag * s, den = are * are + aim * aim;
        ((float2*)(p.ws + O_CF))[st] = make_float2((float)((nr * are + ni * aim) / den), (float)((ni * are - nr * aim) / den));
    }
}
DI void wp_item(const Params& p, int l, int it) {
    const int k = it >> 1, n = (it & 1) * 512 + threadIdx.x, g = k >> 6, c = k & 63;
    const float* pw = p.in[I_POOLW] + (size_t)l * 4 * 64 * 64 + (size_t)(g * 64 + c) * 64;
    const float* ps = p.in[I_POOLS] + l * 256 + g * 64;
    const float* po = p.in[I_POOLO] + (size_t)l * 256 * 1024 + (size_t)(g * 64) * 1024 + n;
    float s = 0.f;
#pragma unroll 8
    for (int d = 0; d < 64; ++d) s += pw[d] * ps[d] * po[(size_t)d * 1024];
    ((bf16*)(p.ws + O_WP))[(size_t)n * 256 + k] = f2bf(s);
}
DI void rope_item(const Params& p, int it) {
    const int idx = it * 512 + threadIdx.x;
    const int pos = idx >> 4, i = idx & 15;
    const double inv = dexp(-(double)i * (9.210340371976184 / 16.0));
    double s, c; dsincos((double)pos * inv, s, c);
    ((float2*)(p.ws + O_ROPE))[idx] = make_float2((float)c, (float)s);
}
DI void ktab_item(const Params& p, int l, int it, ldsp lds) {
    const int tid = threadIdx.x & 255, half = threadIdx.x >> 8;
    const int lag = (it & 15) * 2 + half, dg = it >> 4;
    LAS f32x2* Wl = (LAS f32x2*)lds + half * 64;
    if (tid < 64) {
        const float2 z = ((const float2*)(p.ws + O_PW))[(size_t)(dg * 64 + tid) * 33 + lag], cf = ((const float2*)(p.ws + O_CF))[dg * 64 + tid];
        Wl[tid] = (f32x2){z.x * cf.x - z.y * cf.y, z.x * cf.y + z.y * cf.x};
    }
    __syncthreads();
    const int hp = tid >> 4, hh = tid & 15;
    const size_t pb = (size_t)(l * 32 + dg) * 1024;
    const float* cre = p.in[I_CRE] + pb + hp * 64, *cim = p.in[I_CIM] + pb + hp * 64;
    const float* bre = p.in[I_BRE] + pb + hh, *bim = p.in[I_BIM] + pb + hh;
    float s = 0.f;
#pragma unroll 8
    for (int q = 0; q < 64; ++q) {
        const f32x2 wv = Wl[q];
        const float br = bre[q * 16], bi = bim[q * 16];
        const float tr = wv.x * br - wv.y * bi, ti = wv.x * bi + wv.y * br;
        s += cre[q] * tr - cim[q] * ti;
    }
    ((float*)(p.ws + O_KTAB))[(size_t)(dg * 32 + lag) * 256 + tid] = s;
    __syncthreads();
}
DI void w1_item(const Params& p, int l, int it) {
    const int idx = it * 512 + threadIdx.x;
    const int k8 = idx & 63, n = (idx >> 6) & 255, g = idx >> 14;
    const int dir = n >> 7, ri = (n >> 6) & 1, pp = n & 63, j = k8 >> 1, h0 = (k8 & 1) * 8;
    const int e = dir ? j : 31 - j, st = (dir * 16 + g) * 64 + pp;
    const float2 z = ((const float2*)(p.ws + O_PW))[(size_t)st * 33 + e], cf = ((const float2*)(p.ws + O_CF))[st];
    const float wr = z.x * cf.x - z.y * cf.y, wi = z.x * cf.y + z.y * cf.x;
    const float* bre = p.in[I_BRE] + (size_t)(l * 32 + dir * 16 + g) * 1024 + pp * 16 + h0;
    const float* bim = p.in[I_BIM] + (size_t)(l * 32 + dir * 16 + g) * 1024 + pp * 16 + h0;
    float o[8];
#pragma unroll
    for (int q = 0; q < 8; ++q) o[q] = ri ? (wr * bim[q] + wi * bre[q]) : (wr * bre[q] - wi * bim[q]);
    u32x4 v; v.x = pk2(o[0], o[1]); v.y = pk2(o[2], o[3]); v.z = pk2(o[4], o[5]); v.w = pk2(o[6], o[7]);
    *(u32x4*)((bf16*)(p.ws + O_W1S) + ((size_t)g * 256 + n) * 512 + k8 * 8) = v;
}
DI void w3_item(const Params& p, int l, int it) {
    const int idx = it * 512 + threadIdx.x;
    const int k8 = idx & 31, n = (idx >> 5) & 511, g = idx >> 14;
    const int dir = k8 >> 4, ri = (k8 >> 3) & 1, p0 = (k8 & 7) * 8, j = n >> 4, hp = n & 15;
    const int e = dir ? 32 - j : j + 1;
    const float* cre = p.in[I_CRE] + (size_t)(l * 32 + dir * 16 + g) * 1024 + hp * 64 + p0;
    const float* cim = p.in[I_CIM] + (size_t)(l * 32 + dir * 16 + g) * 1024 + hp * 64 + p0;
    const float2* pw = (const float2*)(p.ws + O_PW) + (size_t)((dir * 16 + g) * 64 + p0) * 33 + e;
    float o[8];
#pragma unroll
    for (int q = 0; q < 8; ++q) { const float2 z = pw[q * 33]; o[q] = ri ? -(cre[q] * z.y + cim[q] * z.x) : (cre[q] * z.x - cim[q] * z.y); }
    u32x4 v; v.x = pk2(o[0], o[1]); v.y = pk2(o[2], o[3]); v.z = pk2(o[4], o[5]); v.w = pk2(o[6], o[7]);
    *(u32x4*)((bf16*)(p.ws + O_W3S) + ((size_t)g * 512 + n) * 256 + k8 * 8) = v;
}
DI void toep_item(const Params& p, int l, int it) {
    const int idx = it * 512 + threadIdx.x;
    const int k8 = idx & 63, n = (idx >> 6) & 511, g = idx >> 15;
    const int j2 = k8 >> 1, h0 = (k8 & 1) * 8, j = n >> 4, hp = n & 15;
    const float* KT = (const float*)(p.ws + O_KTAB);
    float o[8];
#pragma unroll
    for (int q = 0; q < 8; ++q) o[q] = 0.f;
    if (j2 <= j) { const float* kf = KT + ((size_t)(0 * 16 + g) * 32 + (j - j2)) * 256 + hp * 16 + h0;
#pragma unroll
        for (int q = 0; q < 8; ++q) o[q] += kf[q]; }
    if (j2 >= j) { const float* kb = KT + ((size_t)(1 * 16 + g) * 32 + (j2 - j)) * 256 + hp * 16 + h0;
#pragma unroll
        for (int q = 0; q < 8; ++q) o[q] += kb[q]; }
    if (j2 == j) {
        const float dd = p.in[I_SD][l * 256 + g * 16 + hp];
#pragma unroll
        for (int q = 0; q < 8; ++q) if (h0 + q == hp) o[q] += dd;
    }
    u32x4 v; v.x = pk2(o[0], o[1]); v.y = pk2(o[2], o[3]); v.z = pk2(o[4], o[5]); v.w = pk2(o[6], o[7]);
    *(u32x4*)((bf16*)(p.ws + O_TOEP) + ((size_t)g * 512 + n) * 512 + k8 * 8) = v;
}

constexpr int PH_PER_LAYER = 14, N_PHASES = 2 * PH_PER_LAYER + 1;
#define SUBLOOP(n, call) { for (int it = ((b - off) % G + G) % G; it < (n); it += G) { call; } off = (off + (n)) % G; }
DI void run_phase(const Params& p, const int ph, ldsp lds) {
    const int G = gridDim.x, b = blockIdx.x;
    if (ph == 2 * PH_PER_LAYER) { for (int it = b; it < NL / 8; it += G) final_norm_item(p, it); return; }
    const int l = ph / PH_PER_LAYER, s = ph % PH_PER_LAYER;
    const int mtiles = (l == 1) ? 64 : 65;
    const bf16* HID = (const bf16*)(p.ws + O_BIG);
    const bf16* W2 = (const bf16*)(p.ws + O_W2);
    int off = 0;
#ifdef ONLY_S
    if (s != ONLY_S) return;
#endif
    switch (s) {
    case 0: {
        if (l == 0 && G == 256) {
            if (b < 72) {
                mod_item(p, b, lds);
                for (int it = b; it < 132; it += 72) pw_item(p, l, it);
                if (b < 8) rope_item(p, b);
                for (int it = b; it < CV_TOTAL; it += 72 * 12) conv_item(p, l, it, lds);
            } else {
                for (int it = b - 72; it < 512; it += 184) wp_item(p, l, it);
                for (int it = b - 72; it < CV_TOTAL; it += 184) { if ((it % (72 * 12)) < 72) continue; conv_item(p, l, it, lds); }
            }
        } else {
            SUBLOOP(((l == 0) ? 72 : 0), mod_item(p, it, lds))
            SUBLOOP(132, pw_item(p, l, it))
            SUBLOOP(512, wp_item(p, l, it))
            SUBLOOP(((l == 0) ? 8 : 0), rope_item(p, it))
            SUBLOOP(CV_TOTAL, conv_item(p, l, it, lds))
        }
    } break;
    case 1: if (l == 0) { SUBLOOP(NT / 8, norm_item(p, l, 0, it)) } break;
    case 2: {
        big_ffn_a(p, 0, NT, lds);
        const int busy = 65 * 22 - 5 * G;
        if (G == 256 && b >= busy) for (int it = b - busy; it < 512; it += G - busy) ktab_item(p, l, it, lds);
        else if (G != 256) { SUBLOOP(512, ktab_item(p, l, it, lds)) }
    } break;
    case 3: big_resid(p, HID, W2, DFF, l, 2, 0.5f, l == 0, true, 0, l, 1, false, lds); break;
    case 4: break;
    case 5: {
        big_inproj(p, l, lds);
        const int busy = 65 * 17 - 4 * G;
        if (G == 256 && b >= busy) {
            const int nb = G - busy;
            for (int it = b - busy; it < 2048; it += nb) { if (it < 512) w1_item(p, l, it); else if (it < 1024) w3_item(p, l, it - 512); else toep_item(p, l, it - 1024); }
        } else if (G != 256) { SUBLOOP(512, w1_item(p, l, it)) SUBLOOP(512, w3_item(p, l, it)) SUBLOOP(1024, toep_item(p, l, it)) }
    } break;
    case 6: {
        unsigned* cw = (unsigned*)(p.ws + O_BAR);
        unsigned* c1 = cw + XB_CNT(2 * l), *c2 = cw + XB_CNT(2 * l + 1);
        if (b < 48) { s1_item(p, b, lds); signal_count(c1); }
        else if (b < 52) { wait_count(c1, 48u); s2_item(p, b - 48); signal_count(c2); }
        off = 52;
        SUBLOOP(mtiles * 4, pool_item(p, it))
        SUBLOOP(((l == 0) ? 8 : 0), attn_dispatch(p, l, 64, it, lds))
        SUBLOOP(512, attn_dispatch(p, l, it >> 3, it & 7, lds))
        wait_count(c2, 4u);
        for (int it = G - 1 - b; it < 96; it += G) s3_item(p, it, lds);
    } break;
    case 7: break;
    case 8: break;
    case 9: big_mix1(p, mtiles * 256, lds); break;
    case 10: big_resid(p, (const bf16*)(p.ws + O_H), (const bf16*)(p.ws + O_WOUT), D, l, 5, 1.0f, false, l == 0, 1, l, 2, false, lds); break;
    case 11: break;
    case 12: big_ffn_a(p, 1, mtiles * 256, lds); break;
    case 13: big_resid(p, HID, W2 + (size_t)1024 * DFF, DFF, l, 8, 0.5f, false, l == 0, 2, l + 1, 0, l == 1, lds); break;
    }
}

__global__ void __launch_bounds__(512, 2) hybrid_fwd(Params p, int ph_lo, int ph_hi) {
    __shared__ __attribute__((aligned(16))) char lds_raw[LDS_BYTES];
    ldsp lds = (ldsp)lds_raw;
    __shared__ uint4 xb_words;
    if (p.ws == nullptr) cg::this_grid().sync();
    XcdBarrier bar;
    const bool multi = (ph_hi - ph_lo) > 1;
    if (multi) {
        if (threadIdx.x == 0) xb_words = make_uint4(0u, 0u, 0u, 0u);
        __syncthreads();
        bar = xcd_barrier_post((unsigned*)(p.ws + O_BAR), (volatile LAS unsigned*)&xb_words);
    }
#define PH(k) if (ph_lo <= (k) && (k) < ph_hi) { if ((k) > ph_lo) xcd_barrier(bar); run_phase(p, (k), lds); }
    PH(0) PH(1) PH(2) PH(3) PH(5) PH(6) PH(9) PH(10) PH(12) PH(13)
    PH(14) PH(16) PH(17) PH(19) PH(20) PH(23) PH(24) PH(26) PH(27)
}

extern "C" void kernel_launch(void* const* d_in, const int* in_sizes, int n_in, void* d_out, int out_size, void* d_ws, size_t ws_size, hipStream_t stream) {
    (void)in_sizes; (void)n_in; (void)out_size;
    if (ws_size < O_END) { fprintf(stderr, "workspace too small: %zu < %zu\n", ws_size, (size_t)O_END); return; }
    static int grid_blocks = 0;
    if (!grid_blocks) {
        int dev = 0, cus = 0, per_cu = 0;
        (void)hipGetDevice(&dev);
        (void)hipDeviceGetAttribute(&cus, hipDeviceAttributeMultiprocessorCount, dev);
        (void)hipOccupancyMaxActiveBlocksPerMultiprocessor(&per_cu, hybrid_fwd, 512, 0);
        if (per_cu > 1) per_cu = 1;
        if (per_cu < 1) per_cu = 1;
        grid_blocks = cus * per_cu;
    }
    Params p{};
    for (int i = 0; i < 27; ++i) p.in[i] = (const float*)d_in[i];
    p.out = (float*)d_out; p.ws = (char*)d_ws;
#if MK_ONE_LAUNCH
    (void)hipMemsetAsync(d_ws, 0, 32768, stream);
    int lo = 0, hi = N_PHASES;
    void* args[] = {&p, &lo, &hi};
    hipError_t e = hipLaunchCooperativeKernel((void*)hybrid_fwd, dim3(grid_blocks), dim3(512), args, 0, stream);
    if (e != hipSuccess) fprintf(stderr, "cooperative launch failed: %s (grid %d)\n", hipGetErrorString(e), grid_blocks);
#else
    for (int ph = 0; ph < N_PHASES; ++ph) hipLaunchKernelGGL(hybrid_fwd, dim3(grid_blocks), dim3(512), 0, stream, p, ph, ph + 1);
#endif
}
```
